# Optimizing an MI355X kernel written in HIP

```python
import jax, jax.numpy as jnp
from jax import lax
import numpy as np

D_MODEL = 1024
BATCH = 2
SEQ = 8192
DEPTH = 2
DEC_BATCH = 32
DEC_SEQ = 32
PAST_LEN = 1024

CHUNK = 64
A_HEADS = 8
A_HEAD_DIM = 64
DA = A_HEADS * A_HEAD_DIM
W_LORA = 64
A_LORA = 64
V_LORA = 32
G_LORA = 160
RWKV_COLS = 3 * DA + W_LORA + A_LORA + G_LORA
B_HEADS = 4
B_KEY_DIM = 128
B_VAL_DIM = 128
BK = B_HEADS * B_KEY_DIM
DB = B_HEADS * B_VAL_DIM
HGRN_COLS = 2 * BK + 2 * DB
GATE_COLS = 2 * D_MODEL
P_TOTAL = RWKV_COLS + HGRN_COLS + GATE_COLS
D_FF = 4 * D_MODEL
HGRN_BLOCK = 16
RMS_EPS = 1e-6
GN_EPS = 64e-5

kernel_name = 'rwkv7_hgrn2_gated_hybrid_step'


def rmsnorm(x, w):
    xf = x.astype(jnp.float32)
    y = xf * lax.rsqrt(jnp.mean(xf * xf, axis=-1, keepdims=True) + RMS_EPS)
    return (y * w.astype(jnp.float32)).astype(x.dtype)


def rwkv7_recurrence(r, w, k, v, a, b, s0):
    f32 = jnp.float32
    xs = tuple(jnp.moveaxis(t.astype(f32), 1, 0) for t in (r, w, k, v, a, b))

    def step(s, inp):
        r_t, w_t, k_t, v_t, a_t, b_t = inp
        sa = jnp.einsum('bhvk,bhk->bhv', s, a_t)
        s = s * w_t[:, :, None, :] + sa[..., None] * b_t[:, :, None, :] + v_t[..., None] * k_t[:, :, None, :]
        return s, jnp.einsum('bhvk,bhk->bhv', s, r_t)

    s, ys = lax.scan(step, s0.astype(f32), xs)
    return jnp.moveaxis(ys, 0, 1), s


def hgrn2_chunked(q, k, v, logf, s0):
    f32 = jnp.float32
    bsz, t_len, n_h, _ = q.shape
    v_dim = v.shape[-1]
    pad = (-t_len) % HGRN_BLOCK

    def prep(t):
        t = jnp.pad(t.astype(f32), ((0, 0), (0, pad), (0, 0), (0, 0)))
        t = t.reshape(bsz, -1, HGRN_BLOCK, n_h, t.shape[-1])
        return jnp.transpose(t, (1, 0, 3, 2, 4))

    mask = jnp.tril(jnp.ones((HGRN_BLOCK, HGRN_BLOCK), dtype=bool))[:, :, None]

    def step(s, inp):
        qc, kc, vc, gc = inp
        g_cum = jnp.cumsum(gc, axis=2)
        diff = g_cum[:, :, :, None, :] - g_cum[:, :, None, :, :]
        decay = jnp.exp(jnp.where(mask, diff, -jnp.inf))
        att = jnp.einsum('bhtk,bhtsk,bhsk->bhts', qc, decay, kc)
        o = jnp.einsum('bhtk,bhkv->bhtv', qc * jnp.exp(g_cum), s) + jnp.einsum('bhts,bhsv->bhtv', att, vc)
        g_last = g_cum[:, :, -1:, :]
        s = jnp.exp(g_last[:, :, 0, :])[..., None] * s + jnp.einsum('bhsk,bhsv->bhkv', kc * jnp.exp(g_last - g_cum), vc)
        return s, o

    s, o = lax.scan(step, s0.astype(f32), (prep(q), prep(k), prep(v), prep(logf)))
    o = jnp.transpose(o, (1, 0, 3, 2, 4)).reshape(bsz, -1, n_h, v_dim)[:, :t_len]
    return o, s


def token_mixer(h, l, lb, shift_prev, s_rwkv, s_hgrn, v_first, p):
    f32 = jnp.float32
    bsz, t_len, _ = h.shape
    proj = h @ p['w_in'][l]
    rw = proj[..., :RWKV_COLS]
    hg = proj[..., RWKV_COLS:RWKV_COLS + HGRN_COLS]
    gates = jax.nn.sigmoid(proj[..., RWKV_COLS + HGRN_COLS:])

    prev = jnp.concatenate([shift_prev[:, None, :].astype(rw.dtype), rw[:, :-1]], axis=1)
    rw_mix = rw + (prev - rw) * p['rwkv_mu'][l]
    r, k, v, wl, al, gl = jnp.split(rw_mix, [DA, 2 * DA, 3 * DA, 3 * DA + W_LORA, 3 * DA + W_LORA + A_LORA], axis=-1)
    w_raw = (p['rwkv_w0'][l] + jnp.tanh(wl) @ p['rwkv_w2'][l]).astype(f32)
    decay = jnp.exp(-jnp.exp(-jax.nn.softplus(-w_raw) - 0.5))
    a = jax.nn.sigmoid((p['rwkv_a0'][l] + al @ p['rwkv_a2'][l]).astype(f32))
    g = jax.nn.sigmoid(gl) @ p['rwkv_g2'][l]
    if l == 0:
        v_first = v
    else:
        vg = jax.nn.sigmoid(p['rwkv_v0'][l - 1] + (v @ p['rwkv_vres_w1'][l - 1]) @ p['rwkv_vres_w2'][l - 1])
        v = v + (v_first - v) * vg

    def heads(t):
        return t.reshape(bsz, t_len, A_HEADS, A_HEAD_DIM).astype(f32)

    r_h, v_h, a_h, w_h = heads(r), heads(v), heads(a), heads(decay)
    kk = heads(k * p['rwkv_k_k'][l])
    kk = kk * lax.rsqrt(jnp.maximum(jnp.sum(kk * kk, axis=-1, keepdims=True), 1e-24))
    k_a = p['rwkv_k_a'][l].astype(f32).reshape(A_HEADS, A_HEAD_DIM)
    k_h = heads(k) * (1.0 + (a_h - 1.0) * k_a)
    y, s_rwkv_new = rwkv7_recurrence(r_h, w_h, k_h, v_h, -kk, kk * a_h, s_rwkv)
    g_mean = jnp.mean(y, axis=-1, keepdims=True)
    g_var = jnp.mean(jnp.square(y - g_mean), axis=-1, keepdims=True)
    y = (y - g_mean) * lax.rsqrt(g_var + GN_EPS) * p['rwkv_ln_w'][l].astype(f32).reshape(A_HEADS, A_HEAD_DIM) \
        + p['rwkv_ln_b'][l].astype(f32).reshape(A_HEADS, A_HEAD_DIM)
    y = y + jnp.sum(r_h * k_h * p['rwkv_r_k'][l].astype(f32), axis=-1, keepdims=True) * v_h
    y_a = (y.reshape(bsz, t_len, DA).astype(h.dtype) * g) @ p['w_out_a'][l]

    q, fz, i_in, og = jnp.split(hg, [BK, 2 * BK, 2 * BK + DB], axis=-1)
    f = lb + (1.0 - lb) * jax.nn.sigmoid(fz.astype(f32))

    def bheads(t, d):
        return t.reshape(bsz, t_len, B_HEADS, d)

    o, s_hgrn_new = hgrn2_chunked(bheads(jax.nn.silu(q), B_KEY_DIM), bheads(1.0 - f, B_KEY_DIM),
                                  bheads(i_in, B_VAL_DIM), bheads(jnp.log(f), B_KEY_DIM), s_hgrn)
    o = o * lax.rsqrt(jnp.mean(o * o, axis=-1, keepdims=True) + RMS_EPS)
    o = o.reshape(bsz, t_len, DB).astype(h.dtype) * p['hgrn_norm_w'][l] * jax.nn.silu(og)
    y_b = o @ p['w_out_b'][l]

    mix = (gates[..., :D_MODEL] * y_a + gates[..., D_MODEL:] * y_b) @ p['w_out'][l]
    return mix, v_first, rw[:, -1], s_rwkv_new.astype(h.dtype), s_hgrn_new.astype(h.dtype)


def trunk(x, state_shift, state_rwkv, state_hgrn, p):
    lb_soft = jax.nn.softmax(p['hgrn_lb_logits'].astype(jnp.float32), axis=0)
    lb_all = jnp.cumsum(lb_soft, axis=0) - lb_soft[0]
    v_first = None
    shifts, rwkv_states, hgrn_states = [], [], []
    for l in range(DEPTH):
        h = rmsnorm(x, p['norm_mix'][l])
        mix, v_first, sh, sa, sb = token_mixer(h, l, lb_all[l], state_shift[l], state_rwkv[l], state_hgrn[l], v_first, p)
        x = x + mix
        h = rmsnorm(x, p['norm_ffn'][l])
        x = x + jnp.square(jax.nn.relu(h @ p['w_ffn_up'][l])) @ p['w_ffn_down'][l]
        shifts.append(sh)
        rwkv_states.append(sa)
        hgrn_states.append(sb)
    y = rmsnorm(x, p['norm_final'])
    return y, jnp.stack(shifts), jnp.stack(rwkv_states), jnp.stack(hgrn_states)


def setup_inputs(seed: int = 0) -> dict:
    key = jax.random.key(seed)
    ks = iter(jax.random.split(key, 40))
    f32 = jnp.float32

    def nrm(shape, scale):
        return jax.random.normal(next(ks), shape, f32) * scale

    def gain(shape):
        return 1.0 + nrm(shape, 0.02)

    return {
        'x_prompt': nrm((BATCH, SEQ, D_MODEL), 1.0),
        'x_sample': nrm((DEC_BATCH, DEC_SEQ, D_MODEL), 1.0),
        'state_shift': nrm((DEPTH, DEC_BATCH, RWKV_COLS), 1.0),
        'state_rwkv': nrm((DEPTH, DEC_BATCH, A_HEADS, A_HEAD_DIM, A_HEAD_DIM), 0.2),
        'state_hgrn': nrm((DEPTH, DEC_BATCH, B_HEADS, B_KEY_DIM, B_VAL_DIM), 0.5),
        'norm_mix': gain((DEPTH, D_MODEL)),
        'w_in': nrm((DEPTH, D_MODEL, P_TOTAL), D_MODEL ** -0.5),
        'rwkv_mu': jax.random.uniform(next(ks), (DEPTH, RWKV_COLS), f32, 0.2, 0.8),
        'rwkv_w0': jax.random.uniform(next(ks), (DEPTH, DA), f32, -6.0, 1.0),
        'rwkv_w2': nrm((DEPTH, W_LORA, DA), 0.1 * W_LORA ** -0.5),
        'rwkv_a0': nrm((DEPTH, DA), 0.1),
        'rwkv_a2': nrm((DEPTH, A_LORA, DA), 0.1 * A_LORA ** -0.5),
        'rwkv_g2': nrm((DEPTH, G_LORA, DA), G_LORA ** -0.5),
        'rwkv_v0': 1.0 + nrm((DEPTH - 1, DA), 0.1),
        'rwkv_vres_w1': nrm((DEPTH - 1, DA, V_LORA), DA ** -0.5),
        'rwkv_vres_w2': nrm((DEPTH - 1, V_LORA, DA), 0.1 * V_LORA ** -0.5),
        'rwkv_k_k': 0.85 + nrm((DEPTH, DA), 0.02),
        'rwkv_k_a': gain((DEPTH, DA)),
        'rwkv_r_k': nrm((DEPTH, A_HEADS, A_HEAD_DIM), 0.1),
        'rwkv_ln_w': gain((DEPTH, DA)),
        'rwkv_ln_b': nrm((DEPTH, DA), 0.02),
        'hgrn_lb_logits': nrm((DEPTH, BK), 0.1),
        'hgrn_norm_w': gain((DEPTH, DB)),
        'w_out_a': nrm((DEPTH, DA, D_MODEL), DA ** -0.5),
        'w_out_b': nrm((DEPTH, DB, D_MODEL), DB ** -0.5),
        'w_out': nrm((DEPTH, D_MODEL, D_MODEL), D_MODEL ** -0.5),
        'norm_ffn': gain((DEPTH, D_MODEL)),
        'w_ffn_up': nrm((DEPTH, D_MODEL, D_FF), D_MODEL ** -0.5),
        'w_ffn_down': nrm((DEPTH, D_FF, D_MODEL), D_FF ** -0.5),
        'norm_final': gain((D_MODEL,)),
    }


def reference(x_prompt, x_sample, state_shift, state_rwkv, state_hgrn, norm_mix, w_in, rwkv_mu, rwkv_w0, rwkv_w2,
              rwkv_a0, rwkv_a2, rwkv_g2, rwkv_v0, rwkv_vres_w1, rwkv_vres_w2, rwkv_k_k, rwkv_k_a, rwkv_r_k,
              rwkv_ln_w, rwkv_ln_b, hgrn_lb_logits, hgrn_norm_w, w_out_a, w_out_b, w_out, norm_ffn, w_ffn_up,
              w_ffn_down, norm_final):
    p = dict(norm_mix=norm_mix, w_in=w_in, rwkv_mu=rwkv_mu, rwkv_w0=rwkv_w0, rwkv_w2=rwkv_w2, rwkv_a0=rwkv_a0,
             rwkv_a2=rwkv_a2, rwkv_g2=rwkv_g2, rwkv_v0=rwkv_v0, rwkv_vres_w1=rwkv_vres_w1,
             rwkv_vres_w2=rwkv_vres_w2, rwkv_k_k=rwkv_k_k, rwkv_k_a=rwkv_k_a, rwkv_r_k=rwkv_r_k,
             rwkv_ln_w=rwkv_ln_w, rwkv_ln_b=rwkv_ln_b, hgrn_lb_logits=hgrn_lb_logits, hgrn_norm_w=hgrn_norm_w,
             w_out_a=w_out_a, w_out_b=w_out_b, w_out=w_out, norm_ffn=norm_ffn, w_ffn_up=w_ffn_up,
             w_ffn_down=w_ffn_down, norm_final=norm_final)
    dt = x_prompt.dtype
    bp = x_prompt.shape[0]
    zero_shift = jnp.zeros((DEPTH, bp, RWKV_COLS), dt)
    zero_rwkv = jnp.zeros((DEPTH, bp, A_HEADS, A_HEAD_DIM, A_HEAD_DIM), dt)
    zero_hgrn = jnp.zeros((DEPTH, bp, B_HEADS, B_KEY_DIM, B_VAL_DIM), dt)
    y_prompt, shift_p, rwkv_p, hgrn_p = trunk(x_prompt, zero_shift, zero_rwkv, zero_hgrn, p)
    y_sample, shift_s, rwkv_s, hgrn_s = trunk(x_sample, state_shift, state_rwkv, state_hgrn, p)
    return (y_prompt, y_sample, shift_p, rwkv_p, hgrn_p, shift_s, rwkv_s, hgrn_s)
```

```cpp
#include <hip/hip_runtime.h>
#include <hip/hip_cooperative_groups.h>
#include <cstdio>
namespace cg = cooperative_groups;
#define VRES 1
namespace pg8 {
#define PG8_LAS __attribute__((address_space(3)))
typedef unsigned short bf16_t;
typedef short bf16x8 __attribute__((ext_vector_type(8)));
typedef float f32x4 __attribute__((ext_vector_type(4)));
typedef unsigned u32x4 __attribute__((ext_vector_type(4)));
constexpr int BM = 256, BK = 64, HALF = 128, HTB = HALF * BK * 2  , STAGE_BYTES = 8 * HTB, NXCD = 8, WGM = 8;

__host__ __device__ __forceinline__ int lds_byte(int r, int c) { const int st = (r >> 4) * 2 + (c >> 5), rr = r & 15, cc = c & 31, ob = rr * 64 + cc * 2; return st * 1024 + (ob ^ (((ob >> 9) & 1) << 5)); }
__host__ __device__ __forceinline__ void stage_rc(int b, int& R, int& C) { const int st = b / 1024, sb = b % 1024, swz = sb ^ (((sb >> 9) & 1) << 5); R = (st >> 1) * 16 + swz / 64; C = (st & 1) * 32 + (swz % 64) / 2; }
__host__ __device__ __forceinline__ int perm32(int rho) { const int n = rho >> 4, i = rho & 15; return 8 * (i >> 2) + 4 * n + (i & 3); }

struct Unit { int pm, pn; };
struct Gemm { const bf16_t* A; const bf16_t* Bt; int M, N, K, ld; };

struct StaticOrder {
    int nM, nN, nwg, G, c;
    __host__ __device__ void init(int M, int N, int G_, int c_) { nM = M / BM; nN = N / BM; nwg = nM * nN; G = G_; c = c_; }
    __host__ __device__ bool next(int i, Unit& u) const {
        const long L = (long)i * G + c; if (L >= nwg) return false;
        int wgid = (int)L; { const int q = nwg / NXCD, r = nwg % NXCD, xcd = wgid % NXCD, off = wgid / NXCD; wgid = (xcd < r ? xcd * (q + 1) : r * (q + 1) + (xcd - r) * q) + off; }
        const int nig = WGM * nN, gid = wgid / nig, fm = gid * WGM, gsz = (nM - fm) < WGM ? (nM - fm) : WGM;
        u.pm = fm + ((wgid % nig) % gsz); u.pn = (wgid % nig) / gsz; return true;
    }
    __device__ __forceinline__ void a_ready(const Unit&) const {}
    __device__ __forceinline__ void done(const Unit&) const {}
};
typedef float f32x2_cv __attribute__((ext_vector_type(2)));
typedef __bf16 bf16x2_cv __attribute__((ext_vector_type(2)));
__device__ __forceinline__ unsigned cvt_pk_bf16(float lo, float hi) { const f32x2_cv v = {lo, hi}; const bf16x2_cv b = __builtin_convertvector(v, bf16x2_cv); return __builtin_bit_cast(unsigned, b); }
template <class Epi, class Sched, bool STAMP = false>
__device__ __forceinline__ void gemm_phase(PG8_LAS unsigned char* lds, const Gemm g, const Sched& S, const Epi& E, unsigned long long* stamps) {
    int tid_ = threadIdx.x; asm volatile("" : "+v"(tid_)); const int tid = tid_, wid = __builtin_amdgcn_readfirstlane(tid >> 6), lane = tid & 63, wr = wid >> 2, wc = wid & 3, fr = lane & 15, fq = lane >> 4;
    const int K = g.K, nt = K / BK, LD = g.ld;
    unsigned voffA[2], voffB[2];
#pragma unroll
    for (int i = 0; i < 2; ++i) { int R, C; stage_rc(tid * 16 + i * 8192, R, C); const int Rb = Epi::PERM ? ((R & ~31) + perm32(R & 31)) : R;
        voffA[i] = (unsigned)(R * LD + C) * 2u; voffB[i] = (unsigned)(Rb * LD + C) * 2u; }
    const size_t kstep = (size_t)(BK * 2);
    const size_t hstep = (size_t)HALF * LD * 2;
    const size_t tstep = 2 * hstep;
    const unsigned ldsw = (unsigned)wid * 1024u;
    const int aoff = lds_byte(wr * 64 + fr, fq * 8), boff = lds_byte(wc * 32 + fr, fq * 8);
#define PG8_SA(b, h) (((b) * 2 + (h)) * HTB)
#define PG8_SB(b, h) ((4 + (b) * 2 + (h)) * HTB)
#define PG8_STAGE(bufoff, gbase, voff) do { _Pragma("unroll") for (int _i = 0; _i < 2; ++_i) \
        __builtin_amdgcn_global_load_lds((const unsigned*)((const char*)(gbase) + (voff)[_i]), (PG8_LAS unsigned*)(lds + (bufoff) + ldsw + _i * 8192), 16, 0, 0); } while (0)
#define PG8_LDA(dst, b, h) do { _Pragma("unroll") for (int m = 0; m < 4; ++m) _Pragma("unroll") for (int k = 0; k < 2; ++k) dst[m][k] = *(const PG8_LAS bf16x8*)(lds + PG8_SA(b, h) + aoff + m * 2048 + k * 1024); } while (0)
#define PG8_LDB(dst, b, h) do { _Pragma("unroll") for (int n = 0; n < 2; ++n) _Pragma("unroll") for (int k = 0; k < 2; ++k) dst[n][k] = *(const PG8_LAS bf16x8*)(lds + PG8_SB(b, h) + boff + n * 2048 + k * 1024); } while (0)
#define PG8_MMA(ai, bj, At, Bt) do { __builtin_amdgcn_s_setprio(1); _Pragma("unroll") for (int m = 0; m < 4; ++m) _Pragma("unroll") for (int n = 0; n < 2; ++n) _Pragma("unroll") for (int k = 0; k < 2; ++k) \
        acc[ai][bj][m][n] = __builtin_amdgcn_mfma_f32_16x16x32_bf16(Bt[n][k], At[m][k], acc[ai][bj][m][n], 0, 0, 0); __builtin_amdgcn_s_setprio(0); } while (0)
#define PG8_WAIT_V(n) asm volatile("s_waitcnt vmcnt(" #n ")" ::: "memory")
#define PG8_WAIT_L(n) asm volatile("s_waitcnt lgkmcnt(" #n ")" ::: "memory")
#define PG8_BAR __builtin_amdgcn_s_barrier()
#define PG8_SCHED __builtin_amdgcn_sched_barrier(0)
    Unit cur, nxt; int ui = 0;
    if (!S.next(0, cur)) return;
    f32x4 acc[2][2][4][2];
#pragma unroll
    for (int a = 0; a < 2; ++a)
#pragma unroll
        for (int b = 0; b < 2; ++b)
#pragma unroll
            for (int m = 0; m < 4; ++m)
#pragma unroll
                for (int n = 0; n < 2; ++n) acc[a][b][m][n] = (f32x4){0.f, 0.f, 0.f, 0.f};
    bf16x8 At[4][2], B0[2][2], B1[2][2];
    const char* cA = (const char*)g.A + (size_t)cur.pm * tstep; const char* cB = (const char*)g.Bt + (size_t)cur.pn * tstep;
    S.a_ready(cur);
    PG8_STAGE(PG8_SB(0, 0), cB, voffB); PG8_STAGE(PG8_SA(0, 0), cA, voffA); PG8_STAGE(PG8_SB(0, 1), cB + hstep, voffB); PG8_STAGE(PG8_SA(0, 1), cA + hstep, voffA);
    if (wr == 1) PG8_BAR;
    PG8_WAIT_V(4); PG8_BAR;
    PG8_STAGE(PG8_SB(1, 0), cB + kstep, voffB); PG8_STAGE(PG8_SA(1, 0), cA + kstep, voffA); PG8_STAGE(PG8_SB(1, 1), cB + hstep + kstep, voffB);
    PG8_WAIT_V(6); PG8_BAR;
    for (;;) {
        const bool has_next = S.next(ui + 1, nxt);
        const char* nA = has_next ? (const char*)g.A + (size_t)nxt.pm * tstep : cA; const char* nB = has_next ? (const char*)g.Bt + (size_t)nxt.pn * tstep : cB;
        for (int t = 0; t < nt; t += 2) {
            const bool last = (t == nt - 2);
            const char* a1 = cA + (size_t)(t + 1) * kstep;
            const char* a2 = last ? nA : cA + (size_t)(t + 2) * kstep; const char* b2 = last ? nB : cB + (size_t)(t + 2) * kstep;
            const char* a3 = a2 + kstep; const char* b3 = b2 + kstep;
            if (last && has_next) S.a_ready(nxt);
            PG8_LDB(B0, 0, 0); PG8_SCHED; PG8_LDA(At, 0, 0); PG8_STAGE(PG8_SA(1, 1), a1 + hstep, voffA);
            PG8_WAIT_L(8); PG8_BAR; PG8_WAIT_L(0); PG8_MMA(0, 0, At, B0); PG8_BAR; PG8_SCHED;
            PG8_LDB(B1, 0, 1); PG8_STAGE(PG8_SB(0, 0), b2, voffB);
            PG8_BAR; PG8_WAIT_L(0); PG8_MMA(0, 1, At, B1); PG8_BAR;
            PG8_LDA(At, 0, 1); PG8_STAGE(PG8_SA(0, 0), a2, voffA);
            PG8_BAR; PG8_WAIT_L(0); PG8_MMA(1, 0, At, B0); PG8_BAR; PG8_SCHED;
            PG8_STAGE(PG8_SB(0, 1), b2 + hstep, voffB);
            PG8_WAIT_V(6); PG8_BAR; PG8_MMA(1, 1, At, B1); PG8_BAR;
            PG8_LDB(B0, 1, 0); PG8_SCHED; PG8_LDA(At, 1, 0); PG8_STAGE(PG8_SA(0, 1), a2 + hstep, voffA);
            PG8_WAIT_L(8); PG8_BAR; PG8_WAIT_L(0); PG8_MMA(0, 0, At, B0); PG8_BAR; PG8_SCHED;
            PG8_LDB(B1, 1, 1); PG8_STAGE(PG8_SB(1, 0), b3, voffB);
            PG8_BAR; PG8_WAIT_L(0); PG8_MMA(0, 1, At, B1); PG8_BAR;
            PG8_LDA(At, 1, 1); PG8_STAGE(PG8_SA(1, 0), a3, voffA);
            PG8_BAR; PG8_WAIT_L(0); PG8_MMA(1, 0, At, B0); PG8_BAR; PG8_SCHED;
            PG8_STAGE(PG8_SB(1, 1), b3 + hstep, voffB);
            PG8_WAIT_V(6); PG8_BAR; PG8_MMA(1, 1, At, B1); PG8_BAR;
        }
        if constexpr (!Epi::AFTER_DRAIN) { E(acc, cur, wr, wc, fr, fq); S.done(cur); }
        if (!has_next) break;
#pragma unroll
        for (int a = 0; a < 2; ++a)
#pragma unroll
            for (int b = 0; b < 2; ++b)
#pragma unroll
                for (int m = 0; m < 4; ++m)
#pragma unroll
                    for (int n = 0; n < 2; ++n) acc[a][b][m][n] = (f32x4){0.f, 0.f, 0.f, 0.f};
        cur = nxt; cA = nA; cB = nB; ++ui;
    }
    PG8_WAIT_V(0);
    if (wr == 0) PG8_BAR;
    PG8_BAR;
    if constexpr (Epi::AFTER_DRAIN) { E.fused(acc, cur, wr, wc, fr, fq, lds, wid, lane); S.done(cur); }
#undef PG8_SA
#undef PG8_SB
#undef PG8_STAGE
#undef PG8_LDA
#undef PG8_LDB
#undef PG8_MMA
#undef PG8_WAIT_V
#undef PG8_WAIT_L
#undef PG8_BAR
#undef PG8_SCHED
}
}
using pg8::bf16_t; using pg8::bf16x8; using pg8::f32x4; using pg8::u32x4; using pg8::cvt_pk_bf16;
typedef unsigned u32x2 __attribute__((ext_vector_type(2)));
#define LAS PG8_LAS

constexpr int T_ALL = 17408, T_P = 16384;
constexpr size_t MiB = (size_t)1 << 20;
constexpr size_t OFF_WRW = 0, OFF_WHG = 4 * MiB, OFF_WGA = 8 * MiB, OFF_WGB = 10 * MiB, OFF_WOA = 12 * MiB, OFF_WOB = 13 * MiB, OFF_WO = 14 * MiB, OFF_WUP = 16 * MiB, OFF_WDN = 24 * MiB;
constexpr size_t OFF_G = 8 * MiB;
constexpr size_t OFF_SM = 32 * MiB;
constexpr size_t SM_W2T = 0, SM_A2T = 65536, SM_G2T = 131072, SM_V1T = 294912, SM_V2T = 327680, SM_ROWSS = 393216, SM_BONUS = 786432, SM_PGH = 1376256;
constexpr size_t OFF_XB = 34 * MiB, OFF_V0 = 68 * MiB, OFF_A = 85 * MiB, OFF_B = 153 * MiB, SLOT = 17 * MiB;
constexpr size_t WS_NEED = 255 * MiB;
constexpr size_t O_SHP = 17825792, O_RWP = 17833088, O_HGP = 17964160, O_SHS = 18226304, O_RWS = 18343040, O_HGS = 20440192;

__device__ __forceinline__ int tidx() { int t = threadIdx.x; asm volatile("" : "+v"(t)); return t; }
__device__ __forceinline__ int bidx() { int b = blockIdx.x; asm volatile("" : "+s"(b)); return b; }
#define GAS __attribute__((address_space(1)))
__device__ __forceinline__ unsigned char* uptr(unsigned char* q) {
    const unsigned long long v = (unsigned long long)q; unsigned lo = __builtin_amdgcn_readfirstlane((unsigned)v), hi = __builtin_amdgcn_readfirstlane((unsigned)(v >> 32));
    asm volatile("" : "+s"(lo), "+s"(hi));
    return (unsigned char*)(GAS unsigned char*)(((unsigned long long)hi << 32) | lo); }
struct Params { const float* in[30]; float* out; unsigned char* ws; };
struct Ctx { unsigned char* ws; float* out; const unsigned long long* tbl; };
__device__ __forceinline__ const float* ldp(const unsigned long long* tbl, int i) {
    const unsigned long long v = *(const volatile unsigned long long*)(tbl + i);
    const unsigned lo = __builtin_amdgcn_readfirstlane((unsigned)v), hi = __builtin_amdgcn_readfirstlane((unsigned)(v >> 32));
    return (const float*)(GAS const float*)(((unsigned long long)hi << 32) | lo); }
#define INP(p, i) ldp((p).tbl, i)
constexpr size_t SM_TBL = 1703936, SM_BAR = 1769472;
#define XB_TMO      128
#define XB_XCNT(j)  (256  + 64 * (j))
#define XB_XSUB(j)  (1280 + 64 * (j))
#define XB_XGEN(j)  (2304 + 64 * (j))
#define XB_TOP      3328
#define XB_TOPGEN   3392
#define XCD_BAR_WORDS 3456
#define XB_SPIN_CAP (1u << 18)

__device__ __forceinline__ unsigned xb_ld(unsigned* p)              { return __hip_atomic_load(p, __ATOMIC_RELAXED, __HIP_MEMORY_SCOPE_AGENT); }
__device__ __forceinline__ unsigned xb_add(unsigned* p, unsigned v) { return __hip_atomic_fetch_add(p, v, __ATOMIC_RELAXED, __HIP_MEMORY_SCOPE_AGENT); }
__device__ __forceinline__ unsigned xb_xcc_id() { return (unsigned)__builtin_amdgcn_s_getreg((3 << 11) | 20) & 0xFu; }
#define XB_SPIN(cond, bar) do { unsigned _sp = 0; while (cond) { __builtin_amdgcn_s_sleep(1); \
    if ((++_sp & 255u) == 0u) { if (xb_ld(&(bar)[XB_TMO])) break; if (_sp > XB_SPIN_CAP) { atomicAdd(&(bar)[XB_TMO], 1u); break; } } } } while (0)

struct XcdBarrier {
    unsigned* bar; unsigned x;
    volatile LAS unsigned* st;
};

__device__ __forceinline__ XcdBarrier xcd_barrier_post(unsigned* bar, volatile LAS unsigned* st) {
    XcdBarrier b; b.bar = bar; b.x = xb_xcc_id(); b.st = st;
    if (threadIdx.x == 0) (void)xb_add(&bar[XB_XCNT(b.x)], 1u);
    return b;
}
__device__ __forceinline__ void xcd_barrier_complete(unsigned* bar, unsigned x, unsigned& nloc, unsigned& nx) {
    const unsigned G = gridDim.x * gridDim.y * gridDim.z;
    unsigned sum, cnt, mine, sp = 0u;
    for (;;) {
        sum = 0u; cnt = 0u; mine = 0u;
#pragma unroll
        for (unsigned j = 0; j < 16; ++j) { const unsigned c = xb_ld(&bar[XB_XCNT(j)]); sum += c; cnt += (c > 0u) ? 1u : 0u; mine = (j == x) ? c : mine; }
        if (sum == G) break;
        __builtin_amdgcn_s_sleep(1);
        if ((++sp & 255u) == 0u) { if (xb_ld(&bar[XB_TMO])) break; if (sp > XB_SPIN_CAP) { atomicAdd(&bar[XB_TMO], 1u); break; } }
    }
    nloc = mine > 0u ? mine : 1u; nx = cnt > 0u ? cnt : 1u;
}

__device__ __forceinline__ void xcd_barrier(const XcdBarrier& b) {
    asm volatile("s_waitcnt vmcnt(0)" ::: "memory");
    __syncthreads();
    if (threadIdx.x == 0) {
        unsigned* bar = b.bar;
        __builtin_amdgcn_s_waitcnt(0);
        unsigned nloc = b.st[0], nx = b.st[1];
        if (nloc == 0u) { xcd_barrier_complete(bar, b.x, nloc, nx); b.st[0] = nloc; b.st[1] = nx; }
        const unsigned old = xb_add(&bar[XB_XSUB(b.x)], 1u);
        const unsigned gen = old / nloc;
        if (old + 1u == (gen + 1u) * nloc) {
            __builtin_amdgcn_fence(__ATOMIC_RELEASE, "agent");
            asm volatile("s_waitcnt vmcnt(0)" ::: "memory");
            const unsigned og = xb_add(&bar[XB_TOP], 1u);
            const unsigned tg = og / nx;
            if (og + 1u == (tg + 1u) * nx) xb_add(&bar[XB_TOPGEN], 1u);
            else XB_SPIN(xb_ld(&bar[XB_TOPGEN]) == tg, bar);
            __builtin_amdgcn_fence(__ATOMIC_ACQUIRE, "agent");
            xb_add(&bar[XB_XGEN(b.x)], 1u);
            asm volatile("s_waitcnt vmcnt(0)" ::: "memory");
        } else {
            XB_SPIN(xb_ld(&bar[XB_XGEN(b.x)]) == gen, bar);
            __builtin_amdgcn_fence(__ATOMIC_ACQUIRE, "agent");
            asm volatile("s_waitcnt vmcnt(0)" ::: "memory");
        }
    }
    __syncthreads();
}


__device__ __forceinline__ float bf2f(unsigned short b) { return __uint_as_float((unsigned)b << 16); }
__device__ __forceinline__ unsigned short f2bf(float f) { unsigned u = __float_as_uint(f); u += 0x7FFFu + ((u >> 16) & 1u); return (unsigned short)(u >> 16); }
__device__ __forceinline__ float sigm(float x) { return __builtin_amdgcn_rcpf(1.0f + __expf(-x)); }
__device__ __forceinline__ float tanh_fast(float x) { return 1.0f - 2.0f * __builtin_amdgcn_rcpf(1.0f + __expf(2.0f * x)); }
__device__ __forceinline__ float rdl(float x, int i) { return __uint_as_float(__builtin_amdgcn_readlane(__float_as_uint(x), i)); }
__device__ __forceinline__ float wsum(float x) {
#pragma unroll
    for (int o = 32; o; o >>= 1) x += __shfl_xor(x, o);
    return x; }
__device__ __forceinline__ float lo16(unsigned w) { return __uint_as_float(w << 16); }
__device__ __forceinline__ float hi16(unsigned w) { return __uint_as_float(w & 0xffff0000u); }
__device__ __forceinline__ float rstd_of(const float* rowss, int row) { return rsqrtf(rowss[row] * (1.0f / 1024.0f) + 1e-6f); }

template <int MODE> struct EpiBf {
    static constexpr bool PERM = true, AFTER_DRAIN = false;
    bf16_t* O; int ldc; const float* rowss;
    __device__ __forceinline__ void operator()(const f32x4 (&acc)[2][2][4][2], const pg8::Unit& u, int wr, int wc, int fr, int fq) const {
        const int row0 = u.pm * 256 + wr * 64 + fr, col0 = u.pn * 256 + wc * 32 + 8 * fq;
#pragma unroll
        for (int ai = 0; ai < 2; ++ai)
#pragma unroll
            for (int m = 0; m < 4; ++m) {
                const int row = row0 + ai * 128 + m * 16;
                const float s = (MODE == 2) ? 1.0f : rstd_of(rowss, row);
                bf16_t* rowp = O + (size_t)row * ldc + col0;
#pragma unroll
                for (int bj = 0; bj < 2; ++bj) {
                    f32x4 v0 = acc[ai][bj][m][0] * s, v1 = acc[ai][bj][m][1] * s;
                    if (MODE == 1) {
#pragma unroll
                        for (int j = 0; j < 4; ++j) { const float a = fmaxf(v0[j], 0.f), b = fmaxf(v1[j], 0.f); v0[j] = a * a; v1[j] = b * b; } }
                    u32x4 w; w.x = cvt_pk_bf16(v0[0], v0[1]); w.y = cvt_pk_bf16(v0[2], v0[3]); w.z = cvt_pk_bf16(v1[0], v1[1]); w.w = cvt_pk_bf16(v1[2], v1[3]);
                    *(u32x4*)(rowp + bj * 128) = w; } }
    }
};
template <int ACC> struct EpiGate {
    static constexpr bool PERM = true, AFTER_DRAIN = false;
    bf16_t* M; const bf16_t* Tm; const float* rowss;
    __device__ __forceinline__ void operator()(const f32x4 (&acc)[2][2][4][2], const pg8::Unit& u, int wr, int wc, int fr, int fq) const {
        const int row0 = u.pm * 256 + wr * 64 + fr, col0 = u.pn * 256 + wc * 32 + 8 * fq;
#pragma unroll
        for (int ai = 0; ai < 2; ++ai)
#pragma unroll
            for (int m = 0; m < 4; ++m) {
                const int row = row0 + ai * 128 + m * 16;
                const float s = rstd_of(rowss, row);
#pragma unroll
                for (int bj = 0; bj < 2; ++bj) {
                    const size_t off = (size_t)row * 1024 + col0 + bj * 128;
                    const u32x4 tv = *(const u32x4*)(Tm + off);
                    u32x4 pv = (u32x4){0u, 0u, 0u, 0u};
                    if (ACC) pv = *(const u32x4*)(M + off);
                    const f32x4 a0 = acc[ai][bj][m][0] * s, a1 = acc[ai][bj][m][1] * s;
                    float o[8];
                    o[0] = sigm(a0[0]) * lo16(tv.x); o[1] = sigm(a0[1]) * hi16(tv.x); o[2] = sigm(a0[2]) * lo16(tv.y); o[3] = sigm(a0[3]) * hi16(tv.y);
                    o[4] = sigm(a1[0]) * lo16(tv.z); o[5] = sigm(a1[1]) * hi16(tv.z); o[6] = sigm(a1[2]) * lo16(tv.w); o[7] = sigm(a1[3]) * hi16(tv.w);
                    if (ACC) { o[0] += lo16(pv.x); o[1] += hi16(pv.x); o[2] += lo16(pv.y); o[3] += hi16(pv.y); o[4] += lo16(pv.z); o[5] += hi16(pv.z); o[6] += lo16(pv.w); o[7] += hi16(pv.w); }
                    u32x4 w; w.x = cvt_pk_bf16(o[0], o[1]); w.y = cvt_pk_bf16(o[2], o[3]); w.z = cvt_pk_bf16(o[4], o[5]); w.w = cvt_pk_bf16(o[6], o[7]);
                    *(u32x4*)(M + off) = w; } }
    }
};
struct EpiResid {
    static constexpr bool PERM = false, AFTER_DRAIN = false;
    float* X; bf16_t* XB; float* rowss_out; const float* Xp0; const float* Xs0;
    __device__ __forceinline__ void operator()(const f32x4 (&acc)[2][2][4][2], const pg8::Unit& u, int wr, int wc, int fr, int fq) const {
        const int row0 = u.pm * 256 + wr * 64 + fr, col0 = u.pn * 256 + wc * 32 + 4 * fq;
#pragma unroll
        for (int ai = 0; ai < 2; ++ai)
#pragma unroll
            for (int m = 0; m < 4; ++m) {
                const int row = row0 + ai * 128 + m * 16;
                float* xp = X + (size_t)row * 1024 + col0; bf16_t* bp = XB + (size_t)row * 1024 + col0;
                const float* xi = Xp0 ? (row < T_P ? Xp0 + (size_t)row * 1024 + col0 : Xs0 + (size_t)(row - T_P) * 1024 + col0) : xp;
                float ss = 0.f;
#pragma unroll
                for (int bj = 0; bj < 2; ++bj)
#pragma unroll
                    for (int n = 0; n < 2; ++n) {
                        f32x4 xv = *(const f32x4*)(xi + bj * 128 + n * 16) + acc[ai][bj][m][n];
                        *(f32x4*)(xp + bj * 128 + n * 16) = xv;
                        ss += (xv[0] * xv[0] + xv[1] * xv[1]) + (xv[2] * xv[2] + xv[3] * xv[3]);
                        u32x2 w; w.x = cvt_pk_bf16(xv[0], xv[1]); w.y = cvt_pk_bf16(xv[2], xv[3]);
                        *(u32x2*)(bp + bj * 128 + n * 16) = w; }
                ss += __shfl_xor(ss, 16); ss += __shfl_xor(ss, 32);
                if (fq == 0) atomicAdd(rowss_out + row, ss); }
    }
};
template <class Epi> __device__ __forceinline__ void run_gemm(LAS unsigned char* lds, const bf16_t* A, const bf16_t* Bt, int N, int K, const Epi& E) {
    pg8::StaticOrder S; S.init(T_ALL, N, (int)gridDim.x, bidx());
    pg8::Gemm g; g.A = A; g.Bt = Bt; g.M = T_ALL; g.N = N; g.K = K; g.ld = K;
    pg8::gemm_phase<Epi, pg8::StaticOrder, false>(lds, g, S, E, nullptr);
}


struct OneUnit { int pm, pn, valid;
    __device__ bool next(int i, pg8::Unit& u) const { if (i != 0 || !valid) return false; u.pm = pm; u.pn = pn; return true; }
    __device__ __forceinline__ void a_ready(const pg8::Unit&) const {}
    __device__ __forceinline__ void done(const pg8::Unit&) const {} };
struct EpiPartial {
    static constexpr bool PERM = false, AFTER_DRAIN = false;
    float* PART;
    __device__ __forceinline__ void operator()(const f32x4 (&acc)[2][2][4][2], const pg8::Unit& u, int wr, int wc, int fr, int fq) const {
        const int row0 = (u.pm - 64) * 256 + wr * 64 + fr, col0 = u.pn * 256 + wc * 32 + 4 * fq;
#pragma unroll
        for (int ai = 0; ai < 2; ++ai)
#pragma unroll
            for (int m = 0; m < 4; ++m) { float* xp = PART + (size_t)(row0 + ai * 128 + m * 16) * 1024 + col0;
#pragma unroll
                for (int bj = 0; bj < 2; ++bj)
#pragma unroll
                    for (int n = 0; n < 2; ++n) *(f32x4*)(xp + bj * 128 + n * 16) = acc[ai][bj][m][n]; }
    }
};
constexpr size_t OFF_PART = OFF_B + 4 * SLOT;
__device__ __forceinline__ void run_ffn_down(LAS unsigned char* lds, const bf16_t* HID, const bf16_t* WDN, const EpiResid& E, float* PART) {
    { pg8::StaticOrder S; S.init(T_P, 1024, (int)gridDim.x, bidx());
      pg8::Gemm g; g.A = HID; g.Bt = WDN; g.M = T_P; g.N = 1024; g.K = 4096; g.ld = 4096;
      pg8::gemm_phase<EpiResid, pg8::StaticOrder, false>(lds, g, S, E, nullptr); }
    { const int t = bidx(); OneUnit S; S.valid = t < 64; const int sl = t & 3, u = (t >> 2) & 15; S.pm = 64 + (u >> 2); S.pn = u & 3;
      pg8::Gemm g; g.A = HID + sl * 1024; g.Bt = WDN + sl * 1024; g.M = T_ALL; g.N = 1024; g.K = 1024; g.ld = 4096;
      EpiPartial EA; EA.PART = PART + (size_t)sl * 1024 * 1024;
      pg8::gemm_phase<EpiPartial, OneUnit, false>(lds, g, S, EA, nullptr); }
}
__device__ void finalize_sample(const Ctx& p, float* rowss_out) {
    unsigned char* ws = uptr(p.ws); bf16_t* XB = (bf16_t*)(ws + OFF_XB); const float* PART = (const float*)(ws + OFF_PART);
    const int tid = tidx(); const int wave = __builtin_amdgcn_readfirstlane(tid >> 6), lane = tid & 63;
    for (int row = T_P + bidx() * 8 + wave; row < T_ALL; row += gridDim.x * 8) {
        float* src = p.out + (size_t)row * 1024; const float* pr = PART + (size_t)(row - T_P) * 1024; float ss = 0.f;
#pragma unroll
        for (int i = 0; i < 4; ++i) { const int c = i * 256 + lane * 4; float4 v = *(const float4*)(src + c);
#pragma unroll
            for (int sl = 0; sl < 4; ++sl) { const float4 q = *(const float4*)(pr + (size_t)sl * 1024 * 1024 + c); v.x += q.x; v.y += q.y; v.z += q.z; v.w += q.w; }
            *(float4*)(src + c) = v;
            ss += v.x * v.x + v.y * v.y + v.z * v.z + v.w * v.w; u32x2 w; w.x = cvt_pk_bf16(v.x, v.y); w.y = cvt_pk_bf16(v.z, v.w); *(u32x2*)(XB + (size_t)row * 1024 + c) = w; }
        ss = wsum(ss); if (lane == 0) rowss_out[row] = ss;
    }
}
__device__ void conv_T(const float* __restrict__ src, int ld, int s0, int cnt, int K, const float* __restrict__ scale, bf16_t* __restrict__ dst, int d0, LAS unsigned char* lds) {
    LAS float* ts = (LAS float*)lds;
    const int tid = tidx(); const int nkt = K / 256, ntile = (cnt / 32) * nkt;
    for (int tile = bidx(); tile < ntile; tile += gridDim.x) {
        const int n0 = (tile / nkt) * 32, k0 = (tile % nkt) * 256;
        { const int kk = tid >> 3, nq = tid & 7; float4 v[4]; float sc[4];
#pragma unroll
          for (int r = 0; r < 4; ++r) { v[r] = *(const float4*)(src + (size_t)(k0 + r * 64 + kk) * ld + s0 + n0 + nq * 4); sc[r] = scale ? scale[k0 + r * 64 + kk] : 1.0f; }
#pragma unroll
          for (int r = 0; r < 4; ++r) { LAS float* q = ts + (nq * 4) * 257 + r * 64 + kk; q[0] = v[r].x * sc[r]; q[257] = v[r].y * sc[r]; q[514] = v[r].z * sc[r]; q[771] = v[r].w * sc[r]; } }
        __syncthreads();
        { const int n = tid >> 4, kq = tid & 15;
#pragma unroll
          for (int r = 0; r < 4; ++r) { const LAS float* q = ts + n * 257 + r * 64 + kq * 4; u32x2 w; w.x = cvt_pk_bf16(q[0], q[1]); w.y = cvt_pk_bf16(q[2], q[3]);
            *(u32x2*)(dst + (size_t)(d0 + n0 + n) * K + k0 + r * 64 + kq * 4) = w; } }
        __syncthreads();
    }
}
__device__ void conv_small(const float* __restrict__ src, int ld, int cnt, int K, bf16_t* __restrict__ dst) {
    for (int i = bidx() * 512 + tidx(); i < cnt * K; i += gridDim.x * 512) { const int c = i / K, j = i % K; dst[i] = f2bf(src[(size_t)j * ld + c]); }
}
__device__ void phase_convert_early(const Ctx& p, int l, LAS unsigned char* lds) {
    unsigned char* ws = uptr(p.ws);
    const float* win = INP(p, 6) + (size_t)l * 1024 * 5920; const float* nm = INP(p, 5) + l * 1024;
    conv_T(win, 5920, 0, 1824, 1024, nm, (bf16_t*)(ws + OFF_WRW), 0, lds);
    { u32x4* z = (u32x4*)(ws + OFF_WRW + (size_t)1824 * 1024 * 2); const int n = 224 * 1024 * 2 / 16;
      unsigned zz = 0u; asm volatile("" : "+v"(zz));
      for (int i = bidx() * 512 + tidx(); i < n; i += gridDim.x * 512) z[i] = (u32x4){zz, zz, zz, zz}; }
    conv_T(win, 5920, 1824, 2048, 1024, nm, (bf16_t*)(ws + OFF_WHG), 0, lds);
    conv_small(INP(p, 9) + (size_t)l * 64 * 512, 512, 512, 64, (bf16_t*)(ws + OFF_SM + SM_W2T));
    conv_small(INP(p, 11) + (size_t)l * 64 * 512, 512, 512, 64, (bf16_t*)(ws + OFF_SM + SM_A2T));
    conv_small(INP(p, 12) + (size_t)l * 160 * 512, 512, 512, 160, (bf16_t*)(ws + OFF_SM + SM_G2T));
    if (l == 1) {
        conv_small(INP(p, 14), 32, 32, 512, (bf16_t*)(ws + OFF_SM + SM_V1T));
        conv_small(INP(p, 15), 512, 512, 32, (bf16_t*)(ws + OFF_SM + SM_V2T));
    }
}
__device__ void phase_convert_late(const Ctx& p, int l, LAS unsigned char* lds) {
    unsigned char* ws = uptr(p.ws);
    const float* win = INP(p, 6) + (size_t)l * 1024 * 5920; const float* nm = INP(p, 5) + l * 1024;
    conv_T(win, 5920, 3872, 1024, 1024, nm, (bf16_t*)(ws + OFF_WGA), 0, lds);
    conv_T(win, 5920, 4896, 1024, 1024, nm, (bf16_t*)(ws + OFF_WGB), 0, lds);
    conv_T(INP(p, 23) + (size_t)l * 512 * 1024, 1024, 0, 1024, 512, nullptr, (bf16_t*)(ws + OFF_WOA), 0, lds);
    conv_T(INP(p, 24) + (size_t)l * 512 * 1024, 1024, 0, 1024, 512, nullptr, (bf16_t*)(ws + OFF_WOB), 0, lds);
    conv_T(INP(p, 25) + (size_t)l * 1024 * 1024, 1024, 0, 1024, 1024, nullptr, (bf16_t*)(ws + OFF_WO), 0, lds);
    conv_T(INP(p, 27) + (size_t)l * 1024 * 4096, 4096, 0, 4096, 1024, INP(p, 26) + l * 1024, (bf16_t*)(ws + OFF_WUP), 0, lds);
    conv_T(INP(p, 28) + (size_t)l * 4096 * 1024, 1024, 0, 1024, 4096, nullptr, (bf16_t*)(ws + OFF_WDN), 0, lds);
}
__device__ void phase_x0(const Ctx& p) {
    const int tid = tidx(); const int wave = __builtin_amdgcn_readfirstlane(tid >> 6), lane = tid & 63;
    unsigned char* ws = uptr(p.ws);
    float* rowss = (float*)(ws + OFF_SM + SM_ROWSS); bf16_t* XB = (bf16_t*)(ws + OFF_XB);
    for (int row = bidx() * 8 + wave; row < T_ALL; row += gridDim.x * 8) {
        const float* src = row < T_P ? INP(p, 0) + (size_t)row * 1024 : INP(p, 1) + (size_t)(row - T_P) * 1024;
        float ss = 0.f;
#pragma unroll
        for (int i = 0; i < 4; ++i) { const int c = i * 256 + lane * 4; const float4 v = *(const float4*)(src + c);
            ss += v.x * v.x + v.y * v.y + v.z * v.z + v.w * v.w; u32x2 w; w.x = cvt_pk_bf16(v.x, v.y); w.y = cvt_pk_bf16(v.z, v.w); *(u32x2*)(XB + (size_t)row * 1024 + c) = w; }
        ss = wsum(ss); if (lane == 0) rowss[row] = ss;
    }
    for (int i = bidx() * 512 + tidx(); i < 4 * T_ALL; i += gridDim.x * 512) rowss[T_ALL + i] = 0.f;
}
__device__ __forceinline__ u32x2 pack4(float a, float b, float c, float d) { u32x2 w; w.x = cvt_pk_bf16(a, b); w.y = cvt_pk_bf16(c, d); return w; }
__device__ void phase_prep(const Ctx& p, int l, LAS unsigned char* lds) {
    constexpr int MXS = 1832, MIDS = 40;
    unsigned char* ws = uptr(p.ws);
    const bf16_t* PR = (const bf16_t*)(ws + OFF_A);
    LAS bf16_t* MX = (LAS bf16_t*)lds; LAS bf16_t* MID = (LAS bf16_t*)(lds + 32 * MXS * 2);
    const int tid = tidx(); const int wave = __builtin_amdgcn_readfirstlane(tid >> 6), lane = tid & 63, fr = lane & 15, fq = lane >> 4;
    const float* mu = INP(p, 7) + l * 1824;
    const bf16_t* w2T = (const bf16_t*)(ws + OFF_SM + SM_W2T); const bf16_t* a2T = (const bf16_t*)(ws + OFF_SM + SM_A2T); const bf16_t* g2T = (const bf16_t*)(ws + OFF_SM + SM_G2T);
    const bf16_t* v1T = (const bf16_t*)(ws + OFF_SM + SM_V1T); const bf16_t* v2T = (const bf16_t*)(ws + OFF_SM + SM_V2T);
    bf16_t* oR = (bf16_t*)(ws + OFF_B); bf16_t* oV = (bf16_t*)(l == 0 ? ws + OFF_V0 : ws + OFF_B + SLOT); bf16_t* oE = (bf16_t*)(ws + OFF_B + 2 * SLOT);
    bf16_t* oK = (bf16_t*)(ws + OFF_B + 3 * SLOT); bf16_t* oA = (bf16_t*)(ws + OFF_B + 4 * SLOT); bf16_t* oB = (bf16_t*)(ws + OFF_B + 5 * SLOT);
    bf16_t* oG = (bf16_t*)(ws + OFF_G); const bf16_t* V0 = (const bf16_t*)(ws + OFF_V0);
    float* bonus = (float*)(ws + OFF_SM + SM_BONUS);
    const float* w0 = INP(p, 8) + l * 512; const float* a0 = INP(p, 10) + l * 512; const float* kkp = INP(p, 16) + l * 512; const float* kap = INP(p, 17) + l * 512; const float* rkp = INP(p, 18) + l * 512;
    const float* v0p = INP(p, 13);
    for (int ti = bidx(); ti < T_ALL / 32; ti += gridDim.x) {
        const int t0 = ti * 32;
        if (tid < 456) {
            const int cgp = tid % 228, rh = tid / 228, c0 = cgp * 8, rstart = rh * 16;
            float prev[8], m8[8];
            { const float4 a = *(const float4*)(mu + c0), b = *(const float4*)(mu + c0 + 4); m8[0] = a.x; m8[1] = a.y; m8[2] = a.z; m8[3] = a.w; m8[4] = b.x; m8[5] = b.y; m8[6] = b.z; m8[7] = b.w; }
            const bool seq_start = (rh == 0) && (t0 >= T_P || (t0 % 8192) == 0);
            if (seq_start) {
                if (t0 >= T_P) { const float* sp = INP(p, 2) + ((size_t)l * 32 + (t0 - T_P) / 32) * 1824 + c0;
#pragma unroll
                    for (int j = 0; j < 8; ++j) prev[j] = sp[j]; }
                else {
#pragma unroll
                    for (int j = 0; j < 8; ++j) prev[j] = 0.f; }
            } else {
                const u32x4 w = *(const u32x4*)(PR + (size_t)(t0 + rstart - 1) * 2048 + c0);
                prev[0] = lo16(w.x); prev[1] = hi16(w.x); prev[2] = lo16(w.y); prev[3] = hi16(w.y); prev[4] = lo16(w.z); prev[5] = hi16(w.z); prev[6] = lo16(w.w); prev[7] = hi16(w.w);
            }
            const int fn = c0 < 1536 ? 0 : (c0 < 1600 ? 1 : (c0 < 1664 ? 0 : 2));
#pragma unroll 1
            for (int r8 = 0; r8 < 16; r8 += 8) {
            u32x4 wrow[8];
#pragma unroll
            for (int r = 0; r < 8; ++r) wrow[r] = *(const u32x4*)(PR + (size_t)(t0 + rstart + r8 + r) * 2048 + c0);
#pragma unroll
            for (int rr = 0; rr < 8; ++rr) {
                const int r = r8 + rr; const u32x4 w = wrow[rr];
                float cur[8], o[8];
                cur[0] = lo16(w.x); cur[1] = hi16(w.x); cur[2] = lo16(w.y); cur[3] = hi16(w.y); cur[4] = lo16(w.z); cur[5] = hi16(w.z); cur[6] = lo16(w.w); cur[7] = hi16(w.w);
#pragma unroll
                for (int j = 0; j < 8; ++j) { float x = cur[j] + (prev[j] - cur[j]) * m8[j]; if (fn == 1) x = tanh_fast(x); else if (fn == 2) x = sigm(x); o[j] = x; prev[j] = cur[j]; }
                u32x4 q; q.x = cvt_pk_bf16(o[0], o[1]); q.y = cvt_pk_bf16(o[2], o[3]); q.z = cvt_pk_bf16(o[4], o[5]); q.w = cvt_pk_bf16(o[6], o[7]);
                *(LAS u32x4*)(MX + (rstart + r) * MXS + c0) = q;
            }
            }
            if (rh == 1) {
                const bool last = t0 >= T_P || ((t0 + 32) % 8192) == 0;
                if (last) { float* dst = t0 >= T_P ? p.out + O_SHS + ((size_t)l * 32 + (t0 - T_P) / 32) * 1824 + c0 : p.out + O_SHP + ((size_t)l * 2 + t0 / 8192) * 1824 + c0;
#pragma unroll
                    for (int j = 0; j < 8; ++j) dst[j] = prev[j]; }
            }
        }
        __syncthreads();
        if (l == 1 && VRES && VRES != 2) {
            if (wave < 4) {
                const int tt = wave & 1, ot = wave >> 1; f32x4 acc = (f32x4){0.f, 0.f, 0.f, 0.f};
#pragma unroll 4
                for (int ks = 0; ks < 16; ++ks) {
                    const bf16x8 X = *(const bf16x8*)(v1T + (ot * 16 + fr) * 512 + ks * 32 + fq * 8);
                    const bf16x8 Y = *(const LAS bf16x8*)(MX + (tt * 16 + fr) * MXS + 1024 + ks * 32 + fq * 8);
                    acc = __builtin_amdgcn_mfma_f32_16x16x32_bf16(X, Y, acc, 0, 0, 0); }
                *(LAS u32x2*)(MID + (tt * 16 + fr) * MIDS + ot * 16 + 4 * fq) = pack4(acc[0], acc[1], acc[2], acc[3]);
            }
            __syncthreads();
        }
        const int h = wave;
        float ss[2] = {0.f, 0.f}, bon[2] = {0.f, 0.f};
#pragma unroll 1
        for (int ct = 0; ct < 4; ++ct) {
            const int crow = h * 64 + ct * 16 + fr, c = h * 64 + ct * 16 + 4 * fq;
            bf16x8 xw[2], xa[2], xg[5], xv;
#pragma unroll
            for (int ks = 0; ks < 2; ++ks) { xw[ks] = *(const bf16x8*)(w2T + crow * 64 + ks * 32 + fq * 8); xa[ks] = *(const bf16x8*)(a2T + crow * 64 + ks * 32 + fq * 8); }
#pragma unroll
            for (int ks = 0; ks < 5; ++ks) xg[ks] = *(const bf16x8*)(g2T + crow * 160 + ks * 32 + fq * 8);
            if (l == 1) xv = *(const bf16x8*)(v2T + crow * 32 + fq * 8); else xv = xw[0];
            const float4 w04 = *(const float4*)(w0 + c), a04 = *(const float4*)(a0 + c), kk_4 = *(const float4*)(kkp + c), ka4 = *(const float4*)(kap + c), rk4 = *(const float4*)(rkp + c);
            const float w0a[4] = {w04.x, w04.y, w04.z, w04.w}, a0a[4] = {a04.x, a04.y, a04.z, a04.w}, kka[4] = {kk_4.x, kk_4.y, kk_4.z, kk_4.w}, kaa[4] = {ka4.x, ka4.y, ka4.z, ka4.w}, rka[4] = {rk4.x, rk4.y, rk4.z, rk4.w};
            float v0a[4] = {0.f, 0.f, 0.f, 0.f};
            if (l == 1) { const float4 v04 = *(const float4*)(v0p + c); v0a[0] = v04.x; v0a[1] = v04.y; v0a[2] = v04.z; v0a[3] = v04.w; }
            u32x2 fwv[2] = {(u32x2){0u, 0u}, (u32x2){0u, 0u}};
            if (l == 1) { fwv[0] = *(const u32x2*)(V0 + (size_t)(t0 + fr) * 512 + c); fwv[1] = *(const u32x2*)(V0 + (size_t)(t0 + 16 + fr) * 512 + c); }
#pragma unroll
            for (int tt = 0; tt < 2; ++tt) {
                const LAS bf16_t* yrow = MX + (tt * 16 + fr) * MXS + fq * 8;
                f32x4 aW = (f32x4){0.f, 0.f, 0.f, 0.f}, aA = aW, aG = aW, aV = aW;
#pragma unroll
                for (int ks = 0; ks < 2; ++ks) { aW = __builtin_amdgcn_mfma_f32_16x16x32_bf16(xw[ks], *(const LAS bf16x8*)(yrow + 1536 + ks * 32), aW, 0, 0, 0);
                                                 aA = __builtin_amdgcn_mfma_f32_16x16x32_bf16(xa[ks], *(const LAS bf16x8*)(yrow + 1600 + ks * 32), aA, 0, 0, 0); }
#pragma unroll
                for (int ks = 0; ks < 5; ++ks) aG = __builtin_amdgcn_mfma_f32_16x16x32_bf16(xg[ks], *(const LAS bf16x8*)(yrow + 1664 + ks * 32), aG, 0, 0, 0);
                if (l == 1) aV = __builtin_amdgcn_mfma_f32_16x16x32_bf16(xv, *(const LAS bf16x8*)(MID + (tt * 16 + fr) * MIDS + fq * 8), aV, 0, 0, 0);
                const int j = tt * 16 + fr, t = t0 + j;
                LAS bf16_t* mrow = MX + j * MXS + c;
                const u32x2 rw = *(const LAS u32x2*)(mrow), kw = *(const LAS u32x2*)(mrow + 512), vw = *(const LAS u32x2*)(mrow + 1024);
                const float rr[4] = {lo16(rw.x), hi16(rw.x), lo16(rw.y), hi16(rw.y)}, kk4[4] = {lo16(kw.x), hi16(kw.x), lo16(kw.y), hi16(kw.y)};
                float vv[4] = {lo16(vw.x), hi16(vw.x), lo16(vw.y), hi16(vw.y)};
                if (l == 1) {
                    const u32x2 fw = fwv[tt]; const float vf[4] = {lo16(fw.x), hi16(fw.x), lo16(fw.y), hi16(fw.y)};
#pragma unroll
                    for (int e = 0; e < 4; ++e) { const float vg = sigm(v0a[e] + aV[e]); vv[e] = vv[e] + (vf[e] - vv[e]) * vg; }
                }
                float ew[4], kh[4], kr4[4], ag4[4];
#pragma unroll
                for (int e = 0; e < 4; ++e) {
                    ew[e] = 0.60653066f * sigm(w0a[e] + aW[e]);
                    const float a = sigm(a0a[e] + aA[e]); ag4[e] = a;
                    const float kr = kk4[e] * kka[e]; kr4[e] = kr; ss[tt] += kr * kr;
                    kh[e] = kk4[e] * (1.0f + (a - 1.0f) * kaa[e]);
                    bon[tt] += rr[e] * kh[e] * rka[e];
                }
                const size_t o = (size_t)t * 512 + c;
                *(u32x2*)(oR + o) = rw;
                *(u32x2*)(oV + o) = pack4(vv[0], vv[1], vv[2], vv[3]);
                *(u32x2*)(oE + o) = pack4(ew[0], ew[1], ew[2], ew[3]);
                *(u32x2*)(oK + o) = pack4(kh[0], kh[1], kh[2], kh[3]);
                *(u32x2*)(oG + o) = pack4(aG[0], aG[1], aG[2], aG[3]);
                *(LAS u32x2*)(mrow) = pack4(ag4[0], ag4[1], ag4[2], ag4[3]);
                *(LAS u32x2*)(mrow + 512) = pack4(kr4[0], kr4[1], kr4[2], kr4[3]);
            }
        }
#pragma unroll
        for (int tt = 0; tt < 2; ++tt) {
            float s1 = ss[tt], b1 = bon[tt];
            s1 += __shfl_xor(s1, 16); s1 += __shfl_xor(s1, 32); b1 += __shfl_xor(b1, 16); b1 += __shfl_xor(b1, 32);
            const float inv = rsqrtf(fmaxf(s1, 1e-24f));
            const int j = tt * 16 + fr, t = t0 + j;
#pragma unroll
            for (int ct = 0; ct < 4; ++ct) {
                const int c = h * 64 + ct * 16 + 4 * fq;
                const LAS bf16_t* mrow = MX + j * MXS + c;
                const u32x2 aw = *(const LAS u32x2*)(mrow), kw = *(const LAS u32x2*)(mrow + 512);
                const float ag4[4] = {lo16(aw.x), hi16(aw.x), lo16(aw.y), hi16(aw.y)}; float k4[4] = {lo16(kw.x) * inv, hi16(kw.x) * inv, lo16(kw.y) * inv, hi16(kw.y) * inv};
                const size_t o = (size_t)t * 512 + c;
                *(u32x2*)(oA + o) = pack4(-k4[0], -k4[1], -k4[2], -k4[3]);
                *(u32x2*)(oB + o) = pack4(k4[0] * ag4[0], k4[1] * ag4[1], k4[2] * ag4[2], k4[3] * ag4[3]);
            }
            if (fq == 0) bonus[(size_t)t * 8 + h] = b1;
        }
        __syncthreads();
    }
}

typedef float f2 __attribute__((ext_vector_type(2)));
__device__ __forceinline__ f2 pfma(f2 a, f2 b, f2 c) { return __builtin_elementwise_fma(a, b, c); }
template <bool ID> __device__ __forceinline__ void rwkv_scan(const bf16_t* __restrict__ R, const bf16_t* __restrict__ EW, const bf16_t* __restrict__ K, const bf16_t* __restrict__ V,
        const bf16_t* __restrict__ A, const bf16_t* __restrict__ B, unsigned base, int nsteps, f2 (&Sv)[32], f2 (&Si)[32], bf16_t* __restrict__ YH, bf16_t* __restrict__ QH, LAS float* L, int lane) {
    unsigned short q1[6], q2[6];
    { unsigned o = base; q1[0] = R[o]; q1[1] = EW[o]; q1[2] = K[o]; q1[3] = V[o]; q1[4] = A[o]; q1[5] = B[o];
      o = base + 512u; q2[0] = R[o]; q2[1] = EW[o]; q2[2] = K[o]; q2[3] = V[o]; q2[4] = A[o]; q2[5] = B[o]; }
    const LAS f32x4* pa = (const LAS f32x4*)L;
    float sav, sai;
    { L[lane] = bf2f(q1[4]);
      f2 av = {0.f, 0.f}, ai = {0.f, 0.f};
#pragma unroll
      for (int q = 0; q < 16; ++q) { const f32x4 a4 = pa[q]; const f2 a01 = {a4[0], a4[1]}, a23 = {a4[2], a4[3]};
          av = pfma(Sv[2 * q], a01, av); av = pfma(Sv[2 * q + 1], a23, av); if (ID) { ai = pfma(Si[2 * q], a01, ai); ai = pfma(Si[2 * q + 1], a23, ai); } }
      sav = av[0] + av[1]; sai = ai[0] + ai[1]; }
#pragma unroll 1
    for (int s = 0; s < nsteps; ++s) {
        L[lane] = bf2f(q2[4]); L[64 + lane] = __expf(-bf2f(q1[1])); L[128 + lane] = bf2f(q1[5]); L[192 + lane] = bf2f(q1[2]); L[256 + lane] = bf2f(q1[0]);
        const float v = bf2f(q1[3]);
#pragma unroll
        for (int j = 0; j < 6; ++j) q1[j] = q2[j];
        { const unsigned o = base + (unsigned)(s + 2 < nsteps ? s + 2 : nsteps - 1) * 512u; q2[0] = R[o]; q2[1] = EW[o]; q2[2] = K[o]; q2[3] = V[o]; q2[4] = A[o]; q2[5] = B[o]; }
        const f2 sav2 = {sav, sav}, sai2 = {sai, sai}, v2 = {v, v};
        f2 yv = {0.f, 0.f}, yi = {0.f, 0.f}, yv1 = {0.f, 0.f}, yi1 = {0.f, 0.f}, nv = {0.f, 0.f}, ni = {0.f, 0.f}, nv1 = {0.f, 0.f}, ni1 = {0.f, 0.f};
        f32x4 ca = pa[0], cw = pa[16], cb = pa[32], ck = pa[48], cr = pa[64];
#pragma unroll
        for (int q = 0; q < 16; ++q) {
            const f32x4 a4 = ca, w4 = cw, b4 = cb, k4 = ck, r4 = cr;
            if (q < 15) { ca = pa[1 + q]; cw = pa[17 + q]; cb = pa[33 + q]; ck = pa[49 + q]; cr = pa[65 + q]; }
            __builtin_amdgcn_sched_barrier(0);
            { const f2 a2 = {a4[0], a4[1]}, w2 = {w4[0], w4[1]}, b2 = {b4[0], b4[1]}, k2 = {k4[0], k4[1]}, r2 = {r4[0], r4[1]};
              f2 tv = sav2 * b2; tv = pfma(v2, k2, tv); Sv[2 * q] = pfma(Sv[2 * q], w2, tv); yv = pfma(Sv[2 * q], r2, yv); nv = pfma(Sv[2 * q], a2, nv);
              if (ID) { const f2 ti = sai2 * b2; Si[2 * q] = pfma(Si[2 * q], w2, ti); yi = pfma(Si[2 * q], r2, yi); ni = pfma(Si[2 * q], a2, ni); } }
            { const f2 a2 = {a4[2], a4[3]}, w2 = {w4[2], w4[3]}, b2 = {b4[2], b4[3]}, k2 = {k4[2], k4[3]}, r2 = {r4[2], r4[3]};
              f2 tv = sav2 * b2; tv = pfma(v2, k2, tv); Sv[2 * q + 1] = pfma(Sv[2 * q + 1], w2, tv); yv1 = pfma(Sv[2 * q + 1], r2, yv1); nv1 = pfma(Sv[2 * q + 1], a2, nv1);
              if (ID) { const f2 ti = sai2 * b2; Si[2 * q + 1] = pfma(Si[2 * q + 1], w2, ti); yi1 = pfma(Si[2 * q + 1], r2, yi1); ni1 = pfma(Si[2 * q + 1], a2, ni1); } }
        }
        sav = (nv[0] + nv[1]) + (nv1[0] + nv1[1]); sai = (ni[0] + ni[1]) + (ni1[0] + ni1[1]);
        const unsigned cbo = base + (unsigned)s * 512u;
        YH[cbo] = f2bf((yv[0] + yv[1]) + (yv1[0] + yv1[1])); if (ID) QH[cbo] = f2bf((yi[0] + yi[1]) + (yi1[0] + yi1[1]));
    }
}
__device__ void phase_rwkv_scan(const Ctx& p, int l, LAS unsigned char* lds) {
    unsigned char* ws = uptr(p.ws);
    const bf16_t* R = (const bf16_t*)(ws + OFF_B); const bf16_t* V = (const bf16_t*)(l == 0 ? ws + OFF_V0 : ws + OFF_B + SLOT); const bf16_t* EW = (const bf16_t*)(ws + OFF_B + 2 * SLOT);
    const bf16_t* K = (const bf16_t*)(ws + OFF_B + 3 * SLOT); const bf16_t* A = (const bf16_t*)(ws + OFF_B + 4 * SLOT); const bf16_t* B = (const bf16_t*)(ws + OFF_B + 5 * SLOT);
    bf16_t* YH = (bf16_t*)(ws + OFF_A); bf16_t* QH = (bf16_t*)(ws + OFF_A + SLOT); float* P = (float*)(ws + OFF_A + 34 * MiB); float* UC = (float*)(ws + OFF_A + 50 * MiB);
    const int tid = tidx(); const int wave = __builtin_amdgcn_readfirstlane(tid >> 6), lane = tid & 63;
    LAS float* L = (LAS float*)(lds + wave * 5120);
    if (wave < 4) {
        for (int item = bidx() * 4 + wave; item < 1024; item += gridDim.x * 4) {
            const int b = item >> 9, c = (item >> 3) & 63, h = item & 7;
            f2 Sv[32], Si[32]; const int li = tidx() & 63;
#pragma unroll
            for (int i = 0; i < 32; ++i) { Sv[i] = (f2){0.f, 0.f}; Si[i] = (f2){(2 * i == li) ? 1.f : 0.f, (2 * i + 1 == li) ? 1.f : 0.f}; }
            rwkv_scan<true>(R, EW, K, V, A, B, (unsigned)((b * 8192 + c * 128) * 512 + h * 64 + lane), 128, Sv, Si, YH, QH, L, lane);
            const int ln = tidx() & 63; int item2 = item; asm volatile("" : "+s"(item2));
            float* pp = P + (size_t)item2 * 4096 + ln * 64; float* up = UC + (size_t)item2 * 4096 + ln * 64;
#pragma unroll
            for (int i = 0; i < 32; i += 2) { *(float4*)(pp + 2 * i) = make_float4(Si[i][0], Si[i][1], Si[i + 1][0], Si[i + 1][1]); *(float4*)(up + 2 * i) = make_float4(Sv[i][0], Sv[i][1], Sv[i + 1][0], Sv[i + 1][1]); }
        }
    } else if (wave == 4) {
        for (int item = bidx(); item < 256; item += gridDim.x) {
            const int s = item >> 3, h = item & 7;
            const size_t so = (((size_t)l * 32 + s) * 8 + h) * 4096 + lane * 64;
            f2 Sv[32], Si[32];
            const float* sp = INP(p, 3) + so;
#pragma unroll
            for (int i = 0; i < 32; i += 2) { const float4 q = *(const float4*)(sp + 2 * i); Sv[i] = (f2){q.x, q.y}; Sv[i + 1] = (f2){q.z, q.w}; Si[i] = (f2){0.f, 0.f}; Si[i + 1] = (f2){0.f, 0.f}; }
            rwkv_scan<false>(R, EW, K, V, A, B, (unsigned)((T_P + s * 32) * 512 + h * 64 + lane), 32, Sv, Si, YH, QH, L, lane);
            float* op = p.out + O_RWS + so;
#pragma unroll
            for (int i = 0; i < 32; i += 2) *(float4*)(op + 2 * i) = make_float4(Sv[i][0], Sv[i][1], Sv[i + 1][0], Sv[i + 1][1]);
        }
    }
}
template <int CTRL> __device__ __forceinline__ float dpp_mov(float x) { return __uint_as_float(__builtin_amdgcn_update_dpp(0, __float_as_uint(x), CTRL, 0xF, 0xF, true)); }
__device__ __forceinline__ float wsum_fast(float x) {
    x += dpp_mov<0xB1>(x); x += dpp_mov<0x4E>(x); x += dpp_mov<0x141>(x); x += dpp_mov<0x140>(x);
    float t = rdl(x, 0); t += rdl(x, 16); t += rdl(x, 32); t += rdl(x, 48); return t; }
__device__ void phase_rwkv_chain(const Ctx& p, int l) {
    unsigned char* ws = uptr(p.ws);
    const float* P = (const float*)(ws + OFF_A + 34 * MiB); float* UC = (float*)(ws + OFF_A + 50 * MiB);
    const int tid = tidx(); const int wave = __builtin_amdgcn_readfirstlane(tid >> 6), lane = tid & 63;
    if (wave >= 4) return;
    for (int it = bidx() * 4 + wave; it < 1024; it += gridDim.x * 4) {
        const int b = it >> 9, h = (it >> 6) & 7, v = it & 63;
        const float* pb = P + (size_t)((b * 64) * 8 + h) * 4096 + lane;
        float* ub = UC + (size_t)((b * 64) * 8 + h) * 4096 + v * 64 + lane;
        float row = 0.f; float PA[64], PB[64];
#pragma unroll
        for (int i = 0; i < 64; ++i) PA[i] = pb[i * 64];
        float ucA = ub[0];
        for (int c = 0; c < 64; c += 2) {
            { const float* pc = pb + (size_t)(c + 1) * 32768;
#pragma unroll
              for (int i = 0; i < 64; ++i) PB[i] = pc[i * 64]; }
            const float ucB = ub[(size_t)(c + 1) * 32768];
            ub[(size_t)c * 32768] = row;
            { float n0 = ucA, n1 = 0.f;
#pragma unroll
              for (int i = 0; i < 64; i += 2) { n0 = fmaf(rdl(row, i), PA[i], n0); n1 = fmaf(rdl(row, i + 1), PA[i + 1], n1); }
              row = n0 + n1; }
            if (c + 2 < 64) { const float* pc = pb + (size_t)(c + 2) * 32768;
#pragma unroll
                for (int i = 0; i < 64; ++i) PA[i] = pc[i * 64];
                ucA = ub[(size_t)(c + 2) * 32768]; }
            ub[(size_t)(c + 1) * 32768] = row;
            { float n0 = ucB, n1 = 0.f;
#pragma unroll
              for (int i = 0; i < 64; i += 2) { n0 = fmaf(rdl(row, i), PB[i], n0); n1 = fmaf(rdl(row, i + 1), PB[i + 1], n1); }
              row = n0 + n1; }
        }
        p.out[O_RWP + (((size_t)l * 2 + b) * 8 + h) * 4096 + v * 64 + lane] = row;
    }
}
__device__ void phase_rwkv_fix(const Ctx& p, int l) {
    unsigned char* ws = uptr(p.ws);
    const bf16_t* YH = (const bf16_t*)(ws + OFF_A); const bf16_t* QH = (const bf16_t*)(ws + OFF_A + SLOT); const float* UC = (const float*)(ws + OFF_A + 50 * MiB);
    const bf16_t* V = (const bf16_t*)(l == 0 ? ws + OFF_V0 : ws + OFF_B + SLOT); const bf16_t* G = (const bf16_t*)(ws + OFF_G); const float* bonus = (const float*)(ws + OFF_SM + SM_BONUS);
    bf16_t* YA = (bf16_t*)(ws + OFF_B);
    const int tid = tidx(); const int wave = __builtin_amdgcn_readfirstlane(tid >> 6), lane = tid & 63, fr = lane & 15, fq = lane >> 4;
    const float* lnw = INP(p, 19) + l * 512; const float* lnb = INP(p, 20) + l * 512;
    for (int item = bidx() * 8 + wave; item < 4096 + 256; item += gridDim.x * 8) {
        const bool smp = item >= 4096;
        int h, t0, it = 0, ntile;
        if (!smp) { const int tq = item & 3; it = item >> 2; const int b = it >> 9, c = (it >> 3) & 63; h = it & 7; t0 = b * 8192 + c * 128 + tq * 32; ntile = 2; }
        else { const int si = item - 4096; h = si & 7; t0 = T_P + (si >> 3) * 32; ntile = 2; }
        bf16x8 X[4][2];
        if (!smp) {
#pragma unroll
            for (int vt = 0; vt < 4; ++vt)
#pragma unroll
                for (int ks = 0; ks < 2; ++ks) { const float* sp = UC + (size_t)it * 4096 + (vt * 16 + fr) * 64 + ks * 32 + fq * 8; const float4 a = *(const float4*)sp, b4 = *(const float4*)(sp + 4);
                    u32x4 w; w.x = cvt_pk_bf16(a.x, a.y); w.y = cvt_pk_bf16(a.z, a.w); w.z = cvt_pk_bf16(b4.x, b4.y); w.w = cvt_pk_bf16(b4.z, b4.w); X[vt][ks] = __builtin_bit_cast(bf16x8, w); }
        }
        float gw[4][4], gb[4][4];
#pragma unroll
        for (int vt = 0; vt < 4; ++vt) { const float4 a = *(const float4*)(lnw + h * 64 + vt * 16 + 4 * fq), b4 = *(const float4*)(lnb + h * 64 + vt * 16 + 4 * fq);
            gw[vt][0] = a.x; gw[vt][1] = a.y; gw[vt][2] = a.z; gw[vt][3] = a.w; gb[vt][0] = b4.x; gb[vt][1] = b4.y; gb[vt][2] = b4.z; gb[vt][3] = b4.w; }
        for (int tt = 0; tt < ntile; ++tt) {
            const int t = t0 + tt * 16 + fr; const size_t ob = (size_t)t * 512 + h * 64;
            float y[4][4];
            u32x2 yw[4], vw[4], gg[4];
#pragma unroll
            for (int vt = 0; vt < 4; ++vt) { yw[vt] = *(const u32x2*)(YH + ob + vt * 16 + 4 * fq); vw[vt] = *(const u32x2*)(V + ob + vt * 16 + 4 * fq); gg[vt] = *(const u32x2*)(G + ob + vt * 16 + 4 * fq); }
            const float bn = bonus[(size_t)t * 8 + h];
            if (!smp) {
                const bf16x8 Y0 = *(const bf16x8*)(QH + ob + fq * 8), Y1 = *(const bf16x8*)(QH + ob + 32 + fq * 8);
#pragma unroll
                for (int vt = 0; vt < 4; ++vt) { f32x4 acc = (f32x4){0.f, 0.f, 0.f, 0.f};
                    acc = __builtin_amdgcn_mfma_f32_16x16x32_bf16(X[vt][0], Y0, acc, 0, 0, 0); acc = __builtin_amdgcn_mfma_f32_16x16x32_bf16(X[vt][1], Y1, acc, 0, 0, 0);
                    y[vt][0] = acc[0] + lo16(yw[vt].x); y[vt][1] = acc[1] + hi16(yw[vt].x); y[vt][2] = acc[2] + lo16(yw[vt].y); y[vt][3] = acc[3] + hi16(yw[vt].y); }
            } else {
#pragma unroll
                for (int vt = 0; vt < 4; ++vt) { y[vt][0] = lo16(yw[vt].x); y[vt][1] = hi16(yw[vt].x); y[vt][2] = lo16(yw[vt].y); y[vt][3] = hi16(yw[vt].y); }
            }
            float sm = 0.f;
#pragma unroll
            for (int vt = 0; vt < 4; ++vt) sm += (y[vt][0] + y[vt][1]) + (y[vt][2] + y[vt][3]);
            sm += __shfl_xor(sm, 16); sm += __shfl_xor(sm, 32);
            const float mean = sm * (1.0f / 64.0f); float sq = 0.f;
#pragma unroll
            for (int vt = 0; vt < 4; ++vt)
#pragma unroll
                for (int e = 0; e < 4; ++e) { y[vt][e] -= mean; sq += y[vt][e] * y[vt][e]; }
            sq += __shfl_xor(sq, 16); sq += __shfl_xor(sq, 32);
            const float rs = rsqrtf(sq * (1.0f / 64.0f) + 64e-5f);
#pragma unroll
            for (int vt = 0; vt < 4; ++vt) {
                const float vv[4] = {lo16(vw[vt].x), hi16(vw[vt].x), lo16(vw[vt].y), hi16(vw[vt].y)}, g4[4] = {lo16(gg[vt].x), hi16(gg[vt].x), lo16(gg[vt].y), hi16(gg[vt].y)};
                float o[4];
#pragma unroll
                for (int e = 0; e < 4; ++e) o[e] = (y[vt][e] * rs * gw[vt][e] + gb[vt][e] + bn * vv[e]) * g4[e];
                *(u32x2*)(YA + ob + vt * 16 + 4 * fq) = pack4(o[0], o[1], o[2], o[3]);
            }
        }
    }
}
__device__ __forceinline__ float lb_of(const Ctx& p, int l, int c) { if (l == 0) return 0.f; const float* z = INP(p, 21); const float z0 = z[c], z1 = z[512 + c]; return __builtin_amdgcn_rcpf(1.0f + __expf(z0 - z1)); }
__device__ __forceinline__ void hgrn_scan(const bf16_t* __restrict__ PH, int t0, int nsteps, int h, int half, int kh, int lane, float lb, f2 (&S)[32], float& cp, bf16_t* __restrict__ OHp, float* __restrict__ ckp, LAS float* L) {
    const bf16_t* row = PH + (size_t)t0 * 2048 + h * 128 + kh * 64 + lane; const int voff = 1024 + (half - kh) * 64;
    unsigned short q1[3], q2[3], q3[3];
    { const bf16_t* r = row; q1[0] = r[0]; q1[1] = r[512]; q1[2] = r[voff];
      r = row + 2048; q2[0] = r[0]; q2[1] = r[512]; q2[2] = r[voff];
      r = row + 4096; q3[0] = r[0]; q3[1] = r[512]; q3[2] = r[voff]; }
    const LAS f32x4* pf = (const LAS f32x4*)L;
#pragma unroll 1
    for (int s = 0; s < nsteps; ++s) {
        const float ql = bf2f(q1[0]), fz = bf2f(q1[1]), v = bf2f(q1[2]);
#pragma unroll
        for (int j = 0; j < 3; ++j) { q1[j] = q2[j]; q2[j] = q3[j]; }
        { const bf16_t* r = row + (size_t)(s + 3 < nsteps ? s + 3 : nsteps - 1) * 2048; q3[0] = r[0]; q3[1] = r[512]; q3[2] = r[voff]; }
        const float fl = lb + (1.0f - lb) * sigm(fz);
        cp *= fl;
        if (ckp && (s & 31) == 31 && s < 127) ckp[(s >> 5) * 128 + lane] = cp;
        L[lane] = fl; L[64 + lane] = ql * sigm(ql);
        f32x4 F[2][4], Q[2][4];
#pragma unroll
        for (int i = 0; i < 4; ++i) { F[0][i] = pf[i]; Q[0][i] = pf[16 + i]; }
        const f2 v2 = {v, v}; f2 o2 = {0.f, 0.f}, o3 = {0.f, 0.f};
#pragma unroll
        for (int g = 0; g < 4; ++g) {
            if (g < 3) {
#pragma unroll
                for (int i = 0; i < 4; ++i) { F[(g + 1) & 1][i] = pf[(g + 1) * 4 + i]; Q[(g + 1) & 1][i] = pf[16 + (g + 1) * 4 + i]; } }
            __builtin_amdgcn_sched_barrier(0);
#pragma unroll
            for (int i = 0; i < 4; ++i) {
                const f32x4 f4 = F[g & 1][i], q4 = Q[g & 1][i]; const int idx = (g * 4 + i) * 2;
                const f2 f01 = {f4[0], f4[1]}, f23 = {f4[2], f4[3]}, q01 = {q4[0], q4[1]}, q23 = {q4[2], q4[3]};
                S[idx] = pfma(f01, S[idx] - v2, v2); o2 = pfma(S[idx], q01, o2);
                S[idx + 1] = pfma(f23, S[idx + 1] - v2, v2); o3 = pfma(S[idx + 1], q23, o3);
            }
        }
        OHp[(size_t)(t0 + s) * 512 + h * 128 + half * 64 + lane] = f2bf((o2[0] + o2[1]) + (o3[0] + o3[1]));
    }
}
constexpr size_t OFF_PGC = OFF_B + 3 * SLOT + 32 * MiB;
__device__ void phase_hgrn_scan(const Ctx& p, int l, LAS unsigned char* lds) {
    unsigned char* ws = uptr(p.ws);
    const bf16_t* PH = (const bf16_t*)(ws + OFF_A); bf16_t* OH0 = (bf16_t*)(ws + OFF_B + 2 * SLOT); bf16_t* OH1 = (bf16_t*)(ws + OFF_B + 5 * SLOT);
    float* UCH = (float*)(ws + OFF_B + 3 * SLOT); float* PGH = (float*)(ws + OFF_SM + SM_PGH); float* PGC = (float*)(ws + OFF_PGC);
    const int tid = tidx(); const int wave = __builtin_amdgcn_readfirstlane(tid >> 6), lane = tid & 63;
    LAS float* L = (LAS float*)(lds + wave * 1024);
    for (int item = bidx() * 8 + wave; item < 2048; item += gridDim.x * 8) {
        const int kh = item & 1, half = (item >> 1) & 1, h = (item >> 2) & 3, c = (item >> 4) & 63, b = item >> 10, idx = item >> 2;
        f2 S[32];
#pragma unroll
        for (int k = 0; k < 32; ++k) S[k] = (f2){0.f, 0.f};
        float cp = 1.f;
        hgrn_scan(PH, b * 8192 + c * 128, 128, h, half, kh, lane, lb_of(p, l, h * 128 + kh * 64 + lane), S, cp, kh ? OH1 : OH0, half == 0 ? PGC + (size_t)idx * 384 + kh * 64 : nullptr, L);
        float* up = UCH + (size_t)idx * 16384 + (size_t)(kh * 64) * 128 + half * 64 + lane;
#pragma unroll
        for (int k = 0; k < 32; ++k) { up[(2 * k) * 128] = S[k][0]; up[(2 * k + 1) * 128] = S[k][1]; }
        if (half == 0) PGH[idx * 128 + kh * 64 + lane] = cp;
    }
    if (wave < 2) {
        for (int item = bidx() * 2 + wave; item < 512; item += gridDim.x * 2) {
            const int kh = item & 1, half = (item >> 1) & 1, h = (item >> 2) & 3, s = item >> 4;
            const size_t so = (((size_t)l * 32 + s) * 4 + h) * 16384 + (size_t)(kh * 64) * 128 + half * 64 + lane;
            f2 S[32];
            const float* stp = INP(p, 4) + so;
#pragma unroll
            for (int k = 0; k < 32; ++k) S[k] = (f2){stp[(2 * k) * 128], stp[(2 * k + 1) * 128]};
            float cp = 1.f;
            hgrn_scan(PH, T_P + s * 32, 32, h, half, kh, lane, lb_of(p, l, h * 128 + kh * 64 + lane), S, cp, kh ? OH1 : OH0, nullptr, L);
#pragma unroll
            for (int k = 0; k < 32; ++k) { p.out[O_HGS + so + (2 * k) * 128] = S[k][0]; p.out[O_HGS + so + (2 * k + 1) * 128] = S[k][1]; }
        }
    }
}
__device__ void phase_hgrn_chain(const Ctx& p, int l) {
    unsigned char* ws = uptr(p.ws);
    float* UCH = (float*)(ws + OFF_B + 3 * SLOT); const float* PGH = (const float*)(ws + OFF_SM + SM_PGH);
    for (int gid = bidx() * 512 + tidx(); gid < 131072; gid += gridDim.x * 512) {
        const int b = gid >> 16, h = (gid >> 14) & 3, k = (gid >> 7) & 127, v = gid & 127;
        float s = 0.f;
        for (int c0 = 0; c0 < 64; c0 += 8) {
            float u[8], pg[8];
#pragma unroll
            for (int j = 0; j < 8; ++j) { const size_t idx = (size_t)(b * 64 + c0 + j) * 4 + h; u[j] = UCH[idx * 16384 + k * 128 + v]; pg[j] = PGH[idx * 128 + k]; }
#pragma unroll
            for (int j = 0; j < 8; ++j) { const size_t idx = (size_t)(b * 64 + c0 + j) * 4 + h; UCH[idx * 16384 + k * 128 + v] = s; s = fmaf(pg[j], s, u[j]); }
        }
        p.out[O_HGP + (((size_t)l * 2 + b) * 4 + h) * 16384 + k * 128 + v] = s;
    }
}
__device__ void phase_hgrn_fix(const Ctx& p, int l, LAS unsigned char* lds) {
    unsigned char* ws = uptr(p.ws);
    const bf16_t* PH = (const bf16_t*)(ws + OFF_A); const bf16_t* OH = (const bf16_t*)(ws + OFF_B + 2 * SLOT); const float* UCH = (const float*)(ws + OFF_B + 3 * SLOT);
    const float* PGC = (const float*)(ws + OFF_PGC); const bf16_t* OH1 = (const bf16_t*)(ws + OFF_B + 5 * SLOT);
    bf16_t* YB = (bf16_t*)(ws + OFF_B + SLOT);
    const int tid = tidx(); const int wave = __builtin_amdgcn_readfirstlane(tid >> 6), lane = tid & 63, fr = lane & 15, fq = lane >> 4;
    const float* nw = INP(p, 22) + l * 512;
    constexpr int QS = 136;
    LAS bf16_t* QT = (LAS bf16_t*)(lds + wave * 16384);
    for (int item = bidx() * 8 + wave; item < 2048; item += gridDim.x * 8) {
        const int tq = item & 3, idx = item >> 2, h = idx & 3, c = (idx >> 2) & 63, b = idx >> 8;
        const float lbl = lb_of(p, l, h * 128 + lane), lbh = lb_of(p, l, h * 128 + 64 + lane);
        const int tbase = b * 8192 + c * 128 + tq * 32;
        float rl = 1.f, rh = 1.f;
        if (tq) { rl = PGC[(size_t)idx * 384 + (tq - 1) * 128 + lane]; rh = PGC[(size_t)idx * 384 + (tq - 1) * 128 + 64 + lane]; }
        const bf16_t* row = PH + (size_t)tbase * 2048 + h * 128 + lane;
#pragma unroll 1
        for (int t8 = 0; t8 < 32; t8 += 8) {
            unsigned short rq[8][4];
#pragma unroll
            for (int j = 0; j < 8; ++j) { const bf16_t* r = row + (size_t)(t8 + j) * 2048; rq[j][0] = r[0]; rq[j][1] = r[64]; rq[j][2] = r[512]; rq[j][3] = r[576]; }
#pragma unroll
            for (int j = 0; j < 8; ++j) {
                const float ql = bf2f(rq[j][0]), qh = bf2f(rq[j][1]);
                rl *= lbl + (1.0f - lbl) * sigm(bf2f(rq[j][2])); rh *= lbh + (1.0f - lbh) * sigm(bf2f(rq[j][3]));
                QT[(t8 + j) * QS + lane] = f2bf(ql * sigm(ql) * rl); QT[(t8 + j) * QS + 64 + lane] = f2bf(qh * sigm(qh) * rh);
            }
        }
        f32x4 acc[8][2];
        const float* sb = UCH + (size_t)idx * 16384 + fr;
#pragma unroll
        for (int vt = 0; vt < 8; ++vt) {
            acc[vt][0] = (f32x4){0.f, 0.f, 0.f, 0.f}; acc[vt][1] = (f32x4){0.f, 0.f, 0.f, 0.f};
#pragma unroll
            for (int ks = 0; ks < 4; ++ks) {
                const float* sp = sb + (size_t)(ks * 32 + fq * 8) * 128 + vt * 16;
                u32x4 w; w.x = cvt_pk_bf16(sp[0], sp[128]); w.y = cvt_pk_bf16(sp[256], sp[384]); w.z = cvt_pk_bf16(sp[512], sp[640]); w.w = cvt_pk_bf16(sp[768], sp[896]);
                const bf16x8 X = __builtin_bit_cast(bf16x8, w);
                acc[vt][0] = __builtin_amdgcn_mfma_f32_16x16x32_bf16(X, *(const LAS bf16x8*)(QT + fr * QS + ks * 32 + fq * 8), acc[vt][0], 0, 0, 0);
                acc[vt][1] = __builtin_amdgcn_mfma_f32_16x16x32_bf16(X, *(const LAS bf16x8*)(QT + (16 + fr) * QS + ks * 32 + fq * 8), acc[vt][1], 0, 0, 0);
            }
        }
#pragma unroll
        for (int tt = 0; tt < 2; ++tt) {
            const int t = tbase + tt * 16 + fr;
            const bf16_t* op = OH + (size_t)t * 512 + h * 128 + 4 * fq; const bf16_t* op1 = OH1 + (size_t)t * 512 + h * 128 + 4 * fq; const bf16_t* gp = PH + (size_t)t * 2048 + 1536 + h * 128 + 4 * fq;
            float o[8][4]; float ss = 0.f;
#pragma unroll
            for (int vt = 0; vt < 8; ++vt) { const u32x2 ow = *(const u32x2*)(op + vt * 16), ox = *(const u32x2*)(op1 + vt * 16);
                o[vt][0] = acc[vt][tt][0] + (lo16(ow.x) + lo16(ox.x)); o[vt][1] = acc[vt][tt][1] + (hi16(ow.x) + hi16(ox.x)); o[vt][2] = acc[vt][tt][2] + (lo16(ow.y) + lo16(ox.y)); o[vt][3] = acc[vt][tt][3] + (hi16(ow.y) + hi16(ox.y));
                ss += (o[vt][0] * o[vt][0] + o[vt][1] * o[vt][1]) + (o[vt][2] * o[vt][2] + o[vt][3] * o[vt][3]); }
            ss += __shfl_xor(ss, 16); ss += __shfl_xor(ss, 32);
            const float rs = rsqrtf(ss * (1.0f / 128.0f) + 1e-6f);
#pragma unroll
            for (int vt = 0; vt < 8; ++vt) { const u32x2 gw = *(const u32x2*)(gp + vt * 16); const float4 n4 = *(const float4*)(nw + h * 128 + vt * 16 + 4 * fq);
                const float g4[4] = {lo16(gw.x), hi16(gw.x), lo16(gw.y), hi16(gw.y)}, nn[4] = {n4.x, n4.y, n4.z, n4.w}; float r[4];
#pragma unroll
                for (int e = 0; e < 4; ++e) r[e] = o[vt][e] * rs * nn[e] * g4[e] * sigm(g4[e]);
                *(u32x2*)(YB + (size_t)t * 512 + h * 128 + vt * 16 + 4 * fq) = pack4(r[0], r[1], r[2], r[3]); }
        }
    }
    if (wave == 0) {
        for (int item = bidx(); item < 128; item += gridDim.x) {
            const int s = item >> 2, h = item & 3;
            const float nw0 = nw[h * 128 + lane], nw1 = nw[h * 128 + 64 + lane];
#pragma unroll 4
            for (int tt = 0; tt < 32; ++tt) {
                const int t = T_P + s * 32 + tt;
                const float o0 = bf2f(OH[(size_t)t * 512 + h * 128 + lane]) + bf2f(OH1[(size_t)t * 512 + h * 128 + lane]), o1 = bf2f(OH[(size_t)t * 512 + h * 128 + 64 + lane]) + bf2f(OH1[(size_t)t * 512 + h * 128 + 64 + lane]);
                const float g0 = bf2f(PH[(size_t)t * 2048 + 1536 + h * 128 + lane]), g1 = bf2f(PH[(size_t)t * 2048 + 1536 + h * 128 + 64 + lane]);
                const float rs = rsqrtf(wsum_fast(o0 * o0 + o1 * o1) * (1.0f / 128.0f) + 1e-6f);
                YB[(size_t)t * 512 + h * 128 + lane] = f2bf(o0 * rs * nw0 * g0 * sigm(g0));
                YB[(size_t)t * 512 + h * 128 + 64 + lane] = f2bf(o1 * rs * nw1 * g1 * sigm(g1));
            }
        }
    }
}
__device__ void phase_final(const Ctx& p) {
    const int tid = tidx(); const int wave = __builtin_amdgcn_readfirstlane(tid >> 6), lane = tid & 63;
    const float* nf = INP(p, 29); const float* PART = (const float*)(uptr(p.ws) + OFF_PART);
    for (int row = bidx() * 8 + wave; row < T_ALL; row += gridDim.x * 8) {
        float* xp = p.out + (size_t)row * 1024; float4 v[4]; float ss = 0.f;
#pragma unroll
        for (int i = 0; i < 4; ++i) { v[i] = *(const float4*)(xp + i * 256 + lane * 4);
            if (row >= T_P) { const float* pr = PART + (size_t)(row - T_P) * 1024 + i * 256 + lane * 4;
#pragma unroll
                for (int sl = 0; sl < 4; ++sl) { const float4 q = *(const float4*)(pr + (size_t)sl * 1024 * 1024); v[i].x += q.x; v[i].y += q.y; v[i].z += q.z; v[i].w += q.w; } }
            ss += v[i].x * v[i].x + v[i].y * v[i].y + v[i].z * v[i].z + v[i].w * v[i].w; }
        const float s = rsqrtf(wsum(ss) * (1.0f / 1024.0f) + 1e-6f);
#pragma unroll
        for (int i = 0; i < 4; ++i) { const int c = i * 256 + lane * 4; const float4 w = *(const float4*)(nf + c);
            v[i].x *= s * w.x; v[i].y *= s * w.y; v[i].z *= s * w.z; v[i].w *= s * w.w; *(float4*)(xp + c) = v[i]; }
    }
}
#define VRES 1
#define GEMM_PRO unsigned char* ws = uptr(p.ws); float* rowss = (float*)(ws + OFF_SM + SM_ROWSS); bf16_t* XB = (bf16_t*)(ws + OFF_XB); \
    const float* rs_mix = rowss + (size_t)(2 * l) * T_ALL; float* rs_ffn = rowss + (size_t)(2 * l + 1) * T_ALL; float* rs_next = rowss + (size_t)(2 * l + 2) * T_ALL; (void)rs_mix; (void)rs_ffn; (void)rs_next; (void)XB
__global__ void __launch_bounds__(512, 2) mega_fwd(Params prm) {
    extern __shared__ __attribute__((aligned(16))) unsigned char lds_raw[];
    LAS unsigned char* lds = (LAS unsigned char*)lds_raw;
    cg::grid_group grid = cg::this_grid();
    Ctx p; p.ws = prm.ws; p.out = prm.out;
    { unsigned long long* tb = (unsigned long long*)(prm.ws + OFF_SM + SM_TBL + (size_t)blockIdx.x * 256);
      if (threadIdx.x == 0) {
#define TB(i) tb[i] = (unsigned long long)prm.in[i];
          TB(0) TB(1) TB(2) TB(3) TB(4) TB(5) TB(6) TB(7) TB(8) TB(9) TB(10) TB(11) TB(12) TB(13) TB(14) TB(15) TB(16) TB(17) TB(18) TB(19) TB(20) TB(21) TB(22) TB(23) TB(24) TB(25) TB(26) TB(27) TB(28) TB(29)
#undef TB
      }
      __threadfence_block(); __syncthreads();
      p.tbl = tb; }
    volatile LAS unsigned* xst = (volatile LAS unsigned*)(lds + 131072);
    if (threadIdx.x < 2) xst[threadIdx.x] = 0u;
    __syncthreads();
    XcdBarrier xb = xcd_barrier_post((unsigned*)(prm.ws + OFF_SM + SM_BAR), xst);
    grid.sync();
    phase_x0(p);
#pragma unroll 1
    for (int ph = 0; ph < 28; ++ph) {
        const int l = ph >= 14 ? 1 : 0, k = ph - 14 * l;
        switch (k) {
        case 0: if (l == 1) { GEMM_PRO; finalize_sample(p, rowss + (size_t)2 * T_ALL); } phase_convert_early(p, l, lds); break;
        case 1: { GEMM_PRO; EpiBf<0> E; E.O = (bf16_t*)(ws + OFF_A); E.ldc = 2048; E.rowss = rs_mix; run_gemm(lds, XB, (const bf16_t*)(ws + OFF_WRW), 2048, 1024, E); } break;
        case 2: phase_prep(p, l, lds); break;
        case 3: phase_rwkv_scan(p, l, lds); break;
        case 4: phase_rwkv_chain(p, l); break;
        case 5: phase_rwkv_fix(p, l); break;
        case 6: { GEMM_PRO; EpiBf<0> E; E.O = (bf16_t*)(ws + OFF_A); E.ldc = 2048; E.rowss = rs_mix; run_gemm(lds, XB, (const bf16_t*)(ws + OFF_WHG), 2048, 1024, E); } break;
        case 7: phase_hgrn_scan(p, l, lds); break;
        case 8: phase_hgrn_chain(p, l); phase_convert_late(p, l, lds); break;
        case 9: phase_hgrn_fix(p, l, lds); break;
        case 10: {
            GEMM_PRO; bf16_t* TA = (bf16_t*)(ws + OFF_A); bf16_t* TB = (bf16_t*)(ws + OFF_A + 34 * MiB);
            { EpiBf<2> E; E.O = TA; E.ldc = 1024; E.rowss = nullptr; run_gemm(lds, (const bf16_t*)(ws + OFF_B), (const bf16_t*)(ws + OFF_WOA), 1024, 512, E); }
            { EpiGate<0> E; E.M = TA; E.Tm = TA; E.rowss = rs_mix; run_gemm(lds, XB, (const bf16_t*)(ws + OFF_WGA), 1024, 1024, E); }
            { EpiBf<2> E; E.O = TB; E.ldc = 1024; E.rowss = nullptr; run_gemm(lds, (const bf16_t*)(ws + OFF_B + SLOT), (const bf16_t*)(ws + OFF_WOB), 1024, 512, E); }
            { EpiGate<1> E; E.M = TA; E.Tm = TB; E.rowss = rs_mix; run_gemm(lds, XB, (const bf16_t*)(ws + OFF_WGB), 1024, 1024, E); }
        } break;
        case 11: { GEMM_PRO; EpiResid E; E.X = p.out; E.XB = XB; E.rowss_out = rs_ffn; E.Xp0 = l == 0 ? INP(p, 0) : nullptr; E.Xs0 = l == 0 ? INP(p, 1) : nullptr; run_gemm(lds, (const bf16_t*)(ws + OFF_A), (const bf16_t*)(ws + OFF_WO), 1024, 1024, E); } break;
        case 12: { GEMM_PRO; EpiBf<1> E; E.O = (bf16_t*)(ws + OFF_A); E.ldc = 4096; E.rowss = rs_ffn; run_gemm(lds, XB, (const bf16_t*)(ws + OFF_WUP), 4096, 1024, E); } break;
        default: { GEMM_PRO; EpiResid E; E.X = p.out; E.XB = XB; E.rowss_out = rs_next; E.Xp0 = nullptr; E.Xs0 = nullptr; run_ffn_down(lds, (const bf16_t*)(ws + OFF_A), (const bf16_t*)(ws + OFF_WDN), E, (float*)(ws + OFF_PART)); } break;
        }
        xcd_barrier(xb);
    }
    phase_final(p);
}

extern "C" void kernel_launch(void* const* d_in, const int* in_sizes, int n_in, void* d_out, int out_size, void* d_ws, size_t ws_size, hipStream_t stream) {
    constexpr int LDS_BYTES = 131072 + 64;
    static int grid_blocks = 0;
    if (grid_blocks == 0) {
        int dev = 0, cus = 0, per_cu = 0;
        hipGetDevice(&dev);
        hipDeviceGetAttribute(&cus, hipDeviceAttributeMultiprocessorCount, dev);
        hipFuncSetAttribute((const void*)mega_fwd, hipFuncAttributeMaxDynamicSharedMemorySize, LDS_BYTES);
        hipOccupancyMaxActiveBlocksPerMultiprocessor(&per_cu, (const void*)mega_fwd, 512, LDS_BYTES);
        if (per_cu < 1) per_cu = 1;
        grid_blocks = cus;
        if (n_in != 30 || ws_size < WS_NEED) { fprintf(stderr, "kernel_launch: unexpected n_in %d / ws_size %zu\n", n_in, ws_size); }
    }
    if (hipMemsetAsync((unsigned char*)d_ws + OFF_SM + SM_BAR, 0, XCD_BAR_WORDS * 4, stream) != hipSuccess) fprintf(stderr, "memset failed\n");
    Params p{};
    for (int i = 0; i < 30; ++i) p.in[i] = (const float*)d_in[i];
    p.out = (float*)d_out; p.ws = (unsigned char*)d_ws;
    void* args[] = {&p};
    hipError_t e = hipLaunchCooperativeKernel((const void*)mega_fwd, dim3(grid_blocks), dim3(512), args, LDS_BYTES, stream);
    if (e != hipSuccess) fprintf(stderr, "cooperative launch failed: %s (grid %d)\n", hipGetErrorString(e), grid_blocks);
}
```

```cpp
#include <hip/hip_runtime.h>
#include <hip/hip_cooperative_groups.h>
#include <cstdio>
namespace cg = cooperative_groups;
#define VRES 1
namespace pg8 {
#define PG8_LAS __attribute__((address_space(3)))
typedef unsigned short bf16_t;
typedef short bf16x8 __attribute__((ext_vector_type(8)));
typedef float f32x4 __attribute__((ext_vector_type(4)));
typedef unsigned u32x4 __attribute__((ext_vector_type(4)));
constexpr int BM = 256, BK = 64, HALF = 128, HTB = HALF * BK * 2  , STAGE_BYTES = 8 * HTB, NXCD = 8, WGM = 8;

__host__ __device__ __forceinline__ int lds_byte(int r, int c) { const int st = (r >> 4) * 2 + (c >> 5), rr = r & 15, cc = c & 31, ob = rr * 64 + cc * 2; return st * 1024 + (ob ^ (((ob >> 9) & 1) << 5)); }
__host__ __device__ __forceinline__ void stage_rc(int b, int& R, int& C) { const int st = b / 1024, sb = b % 1024, swz = sb ^ (((sb >> 9) & 1) << 5); R = (st >> 1) * 16 + swz / 64; C = (st & 1) * 32 + (swz % 64) / 2; }
__host__ __device__ __forceinline__ int perm32(int rho) { const int n = rho >> 4, i = rho & 15; return 8 * (i >> 2) + 4 * n + (i & 3); }

struct Unit { int pm, pn; };
struct Gemm { const bf16_t* A; const bf16_t* Bt; int M, N, K, ld; };

struct StaticOrder {
    int nM, nN, nwg, G, c;
    __host__ __device__ void init(int M, int N, int G_, int c_) { nM = M / BM; nN = N / BM; nwg = nM * nN; G = G_; c = c_; }
    __host__ __device__ bool next(int i, Unit& u) const {
        const long L = (long)i * G + c; if (L >= nwg) return false;
        int wgid = (int)L; { const int q = nwg / NXCD, r = nwg % NXCD, xcd = wgid % NXCD, off = wgid / NXCD; wgid = (xcd < r ? xcd * (q + 1) : r * (q + 1) + (xcd - r) * q) + off; }
        const int nig = WGM * nN, gid = wgid / nig, fm = gid * WGM, gsz = (nM - fm) < WGM ? (nM - fm) : WGM;
        u.pm = fm + ((wgid % nig) % gsz); u.pn = (wgid % nig) / gsz; return true;
    }
    __device__ __forceinline__ void a_ready(const Unit&) const {}
    __device__ __forceinline__ void done(const Unit&) const {}
};
typedef float f32x2_cv __attribute__((ext_vector_type(2)));
typedef __bf16 bf16x2_cv __attribute__((ext_vector_type(2)));
__device__ __forceinline__ unsigned cvt_pk_bf16(float lo, float hi) { const f32x2_cv v = {lo, hi}; const bf16x2_cv b = __builtin_convertvector(v, bf16x2_cv); return __builtin_bit_cast(unsigned, b); }
template <class Epi, class Sched, bool STAMP = false>
__device__ __forceinline__ void gemm_phase(PG8_LAS unsigned char* lds, const Gemm g, const Sched& S, const Epi& E, unsigned long long* stamps) {
    int tid_ = threadIdx.x; asm volatile("" : "+v"(tid_)); const int tid = tid_, wid = __builtin_amdgcn_readfirstlane(tid >> 6), lane = tid & 63, wr = wid >> 2, wc = wid & 3, fr = lane & 15, fq = lane >> 4;
    const int K = g.K, nt = K / BK, LD = g.ld;
    unsigned voffA[2], voffB[2];
#pragma unroll
    for (int i = 0; i < 2; ++i) { int R, C; stage_rc(tid * 16 + i * 8192, R, C); const int Rb = Epi::PERM ? ((R & ~31) + perm32(R & 31)) : R;
        voffA[i] = (unsigned)(R * LD + C) * 2u; voffB[i] = (unsigned)(Rb * LD + C) * 2u; }
    const size_t kstep = (size_t)(BK * 2);
    const size_t hstep = (size_t)HALF * LD * 2;
    const size_t tstep = 2 * hstep;
    const unsigned ldsw = (unsigned)wid * 1024u;
    const int aoff = lds_byte(wr * 64 + fr, fq * 8), boff = lds_byte(wc * 32 + fr, fq * 8);
#define PG8_SA(b, h) (((b) * 2 + (h)) * HTB)
#define PG8_SB(b, h) ((4 + (b) * 2 + (h)) * HTB)
#define PG8_STAGE(bufoff, gbase, voff) do { _Pragma("unroll") for (int _i = 0; _i < 2; ++_i) \
        __builtin_amdgcn_global_load_lds((const unsigned*)((const char*)(gbase) + (voff)[_i]), (PG8_LAS unsigned*)(lds + (bufoff) + ldsw + _i * 8192), 16, 0, 0); } while (0)
#define PG8_LDA(dst, b, h) do { _Pragma("unroll") for (int m = 0; m < 4; ++m) _Pragma("unroll") for (int k = 0; k < 2; ++k) dst[m][k] = *(const PG8_LAS bf16x8*)(lds + PG8_SA(b, h) + aoff + m * 2048 + k * 1024); } while (0)
#define PG8_LDB(dst, b, h) do { _Pragma("unroll") for (int n = 0; n < 2; ++n) _Pragma("unroll") for (int k = 0; k < 2; ++k) dst[n][k] = *(const PG8_LAS bf16x8*)(lds + PG8_SB(b, h) + boff + n * 2048 + k * 1024); } while (0)
#define PG8_MMA(ai, bj, At, Bt) do { __builtin_amdgcn_s_setprio(1); _Pragma("unroll") for (int m = 0; m < 4; ++m) _Pragma("unroll") for (int n = 0; n < 2; ++n) _Pragma("unroll") for (int k = 0; k < 2; ++k) \
        acc[ai][bj][m][n] = __builtin_amdgcn_mfma_f32_16x16x32_bf16(Bt[n][k], At[m][k], acc[ai][bj][m][n], 0, 0, 0); __builtin_amdgcn_s_setprio(0); } while (0)
#define PG8_WAIT_V(n) asm volatile("s_waitcnt vmcnt(" #n ")" ::: "memory")
#define PG8_WAIT_L(n) asm volatile("s_waitcnt lgkmcnt(" #n ")" ::: "memory")
#define PG8_BAR __builtin_amdgcn_s_barrier()
#define PG8_SCHED __builtin_amdgcn_sched_barrier(0)
    Unit cur, nxt; int ui = 0;
    if (!S.next(0, cur)) return;
    f32x4 acc[2][2][4][2];
#pragma unroll
    for (int a = 0; a < 2; ++a)
#pragma unroll
        for (int b = 0; b < 2; ++b)
#pragma unroll
            for (int m = 0; m < 4; ++m)
#pragma unroll
                for (int n = 0; n < 2; ++n) acc[a][b][m][n] = (f32x4){0.f, 0.f, 0.f, 0.f};
    bf16x8 At[4][2], B0[2][2], B1[2][2];
    const char* cA = (const char*)g.A + (size_t)cur.pm * tstep; const char* cB = (const char*)g.Bt + (size_t)cur.pn * tstep;
    S.a_ready(cur);
    PG8_STAGE(PG8_SB(0, 0), cB, voffB); PG8_STAGE(PG8_SA(0, 0), cA, voffA); PG8_STAGE(PG8_SB(0, 1), cB + hstep, voffB); PG8_STAGE(PG8_SA(0, 1), cA + hstep, voffA);
    if (wr == 1) PG8_BAR;
    PG8_WAIT_V(4); PG8_BAR;
    PG8_STAGE(PG8_SB(1, 0), cB + kstep, voffB); PG8_STAGE(PG8_SA(1, 0), cA + kstep, voffA); PG8_STAGE(PG8_SB(1, 1), cB + hstep + kstep, voffB);
    PG8_WAIT_V(6); PG8_BAR;
    for (;;) {
        const bool has_next = S.next(ui + 1, nxt);
        const char* nA = has_next ? (const char*)g.A + (size_t)nxt.pm * tstep : cA; const char* nB = has_next ? (const char*)g.Bt + (size_t)nxt.pn * tstep : cB;
        for (int t = 0; t < nt; t += 2) {
            const bool last = (t == nt - 2);
            const char* a1 = cA + (size_t)(t + 1) * kstep;
            const char* a2 = last ? nA : cA + (size_t)(t + 2) * kstep; const char* b2 = last ? nB : cB + (size_t)(t + 2) * kstep;
            const char* a3 = a2 + kstep; const char* b3 = b2 + kstep;
            if (last && has_next) S.a_ready(nxt);
            PG8_LDB(B0, 0, 0); PG8_SCHED; PG8_LDA(At, 0, 0); PG8_STAGE(PG8_SA(1, 1), a1 + hstep, voffA);
            PG8_WAIT_L(8); PG8_BAR; PG8_WAIT_L(0); PG8_MMA(0, 0, At, B0); PG8_BAR; PG8_SCHED;
            PG8_LDB(B1, 0, 1); PG8_STAGE(PG8_SB(0, 0), b2, voffB);
            PG8_BAR; PG8_WAIT_L(0); PG8_MMA(0, 1, At, B1); PG8_BAR;
            PG8_LDA(At, 0, 1); PG8_STAGE(PG8_SA(0, 0), a2, voffA);
            PG8_BAR; PG8_WAIT_L(0); PG8_MMA(1, 0, At, B0); PG8_BAR; PG8_SCHED;
            PG8_STAGE(PG8_SB(0, 1), b2 + hstep, voffB);
            PG8_WAIT_V(6); PG8_BAR; PG8_MMA(1, 1, At, B1); PG8_BAR;
            PG8_LDB(B0, 1, 0); PG8_SCHED; PG8_LDA(At, 1, 0); PG8_STAGE(PG8_SA(0, 1), a2 + hstep, voffA);
            PG8_WAIT_L(8); PG8_BAR; PG8_WAIT_L(0); PG8_MMA(0, 0, At, B0); PG8_BAR; PG8_SCHED;
            PG8_LDB(B1, 1, 1); PG8_STAGE(PG8_SB(1, 0), b3, voffB);
            PG8_BAR; PG8_WAIT_L(0); PG8_MMA(0, 1, At, B1); PG8_BAR;
            PG8_LDA(At, 1, 1); PG8_STAGE(PG8_SA(1, 0), a3, voffA);
            PG8_BAR; PG8_WAIT_L(0); PG8_MMA(1, 0, At, B0); PG8_BAR; PG8_SCHED;
            PG8_STAGE(PG8_SB(1, 1), b3 + hstep, voffB);
            PG8_WAIT_V(6); PG8_BAR; PG8_MMA(1, 1, At, B1); PG8_BAR;
        }
        if constexpr (!Epi::AFTER_DRAIN) { E(acc, cur, wr, wc, fr, fq); S.done(cur); }
        if (!has_next) break;
#pragma unroll
        for (int a = 0; a < 2; ++a)
#pragma unroll
            for (int b = 0; b < 2; ++b)
#pragma unroll
                for (int m = 0; m < 4; ++m)
#pragma unroll
                    for (int n = 0; n < 2; ++n) acc[a][b][m][n] = (f32x4){0.f, 0.f, 0.f, 0.f};
        cur = nxt; cA = nA; cB = nB; ++ui;
    }
    PG8_WAIT_V(0);
    if (wr == 0) PG8_BAR;
    PG8_BAR;
    if constexpr (Epi::AFTER_DRAIN) { E.fused(acc, cur, wr, wc, fr, fq, lds, wid, lane); S.done(cur); }
#undef PG8_SA
#undef PG8_SB
#undef PG8_STAGE
#undef PG8_LDA
#undef PG8_LDB
#undef PG8_MMA
#undef PG8_WAIT_V
#undef PG8_WAIT_L
#undef PG8_BAR
#undef PG8_SCHED
}
}
using pg8::bf16_t; using pg8::bf16x8; using pg8::f32x4; using pg8::u32x4; using pg8::cvt_pk_bf16;
typedef unsigned u32x2 __attribute__((ext_vector_type(2)));
#define LAS PG8_LAS

constexpr int T_ALL = 17408, T_P = 16384;
constexpr size_t MiB = (size_t)1 << 20;
constexpr size_t OFF_WRW = 0, OFF_WHG = 4 * MiB, OFF_WGA = 8 * MiB, OFF_WGB = 10 * MiB, OFF_WOA = 12 * MiB, OFF_WOB = 13 * MiB, OFF_WO = 14 * MiB, OFF_WUP = 16 * MiB, OFF_WDN = 24 * MiB;
constexpr size_t OFF_G = 8 * MiB;
constexpr size_t OFF_SM = 32 * MiB;
constexpr size_t SM_W2T = 0, SM_A2T = 65536, SM_G2T = 131072, SM_V1T = 294912, SM_V2T = 327680, SM_ROWSS = 393216, SM_BONUS = 786432, SM_PGH = 1376256;
constexpr size_t OFF_XB = 34 * MiB, OFF_V0 = 68 * MiB, OFF_A = 85 * MiB, OFF_B = 153 * MiB, SLOT = 17 * MiB;
constexpr size_t WS_NEED = 255 * MiB;
constexpr size_t O_SHP = 17825792, O_RWP = 17833088, O_HGP = 17964160, O_SHS = 18226304, O_RWS = 18343040, O_HGS = 20440192;

__device__ __forceinline__ int tidx() { int t = threadIdx.x; asm volatile("" : "+v"(t)); return t; }
__device__ __forceinline__ int bidx() { int b = blockIdx.x; asm volatile("" : "+s"(b)); return b; }
#define GAS __attribute__((address_space(1)))
__device__ __forceinline__ unsigned char* uptr(unsigned char* q) {
    const unsigned long long v = (unsigned long long)q; unsigned lo = __builtin_amdgcn_readfirstlane((unsigned)v), hi = __builtin_amdgcn_readfirstlane((unsigned)(v >> 32));
    asm volatile("" : "+s"(lo), "+s"(hi));
    return (unsigned char*)(GAS unsigned char*)(((unsigned long long)hi << 32) | lo); }
struct Params { const float* in[30]; float* out; unsigned char* ws; };
struct Ctx { unsigned char* ws; float* out; const unsigned long long* tbl; };
__device__ __forceinline__ const float* ldp(const unsigned long long* tbl, int i) {
    const unsigned long long v = *(const volatile unsigned long long*)(tbl + i);
    const unsigned lo = __builtin_amdgcn_readfirstlane((unsigned)v), hi = __builtin_amdgcn_readfirstlane((unsigned)(v >> 32));
    return (const float*)(GAS const float*)(((unsigned long long)hi << 32) | lo); }
#define INP(p, i) ldp((p).tbl, i)
constexpr size_t SM_TBL = 1703936, SM_BAR = 1769472;
#define XB_TMO      128
#define XB_XCNT(j)  (256  + 64 * (j))
#define XB_XSUB(j)  (1280 + 64 * (j))
#define XB_XGEN(j)  (2304 + 64 * (j))
#define XB_TOP      3328
#define XB_TOPGEN   3392
#define XCD_BAR_WORDS 3456
#define XB_SPIN_CAP (1u << 18)

__device__ __forceinline__ unsigned xb_ld(unsigned* p)              { return __hip_atomic_load(p, __ATOMIC_RELAXED, __HIP_MEMORY_SCOPE_AGENT); }
__device__ __forceinline__ unsigned xb_add(unsigned* p, unsigned v) { return __hip_atomic_fetch_add(p, v, __ATOMIC_RELAXED, __HIP_MEMORY_SCOPE_AGENT); }
__device__ __forceinline__ unsigned xb_xcc_id() { return (unsigned)__builtin_amdgcn_s_getreg((3 << 11) | 20) & 0xFu; }
#define XB_SPIN(cond, bar) do { unsigned _sp = 0; while (cond) { __builtin_amdgcn_s_sleep(1); \
    if ((++_sp & 255u) == 0u) { if (xb_ld(&(bar)[XB_TMO])) break; if (_sp > XB_SPIN_CAP) { atomicAdd(&(bar)[XB_TMO], 1u); break; } } } } while (0)

struct XcdBarrier {
    unsigned* bar; unsigned x;
    volatile LAS unsigned* st;
};

__device__ __forceinline__ XcdBarrier xcd_barrier_post(unsigned* bar, volatile LAS unsigned* st) {
    XcdBarrier b; b.bar = bar; b.x = xb_xcc_id(); b.st = st;
    if (threadIdx.x == 0) (void)xb_add(&bar[XB_XCNT(b.x)], 1u);
    return b;
}
__device__ __forceinline__ void xcd_barrier_complete(unsigned* bar, unsigned x, unsigned& nloc, unsigned& nx) {
    const unsigned G = gridDim.x * gridDim.y * gridDim.z;
    unsigned sum, cnt, mine, sp = 0u;
    for (;;) {
        sum = 0u; cnt = 0u; mine = 0u;
#pragma unroll
        for (unsigned j = 0; j < 16; ++j) { const unsigned c = xb_ld(&bar[XB_XCNT(j)]); sum += c; cnt += (c > 0u) ? 1u : 0u; mine = (j == x) ? c : mine; }
        if (sum == G) break;
        __builtin_amdgcn_s_sleep(1);
        if ((++sp & 255u) == 0u) { if (xb_ld(&bar[XB_TMO])) break; if (sp > XB_SPIN_CAP) { atomicAdd(&bar[XB_TMO], 1u); break; } }
    }
    nloc = mine > 0u ? mine : 1u; nx = cnt > 0u ? cnt : 1u;
}

__device__ __forceinline__ void xcd_barrier(const XcdBarrier& b) {
    asm volatile("s_waitcnt vmcnt(0)" ::: "memory");
    __syncthreads();
    if (threadIdx.x == 0) {
        unsigned* bar = b.bar;
        __builtin_amdgcn_s_waitcnt(0);
        unsigned nloc = b.st[0], nx = b.st[1];
        if (nloc == 0u) { xcd_barrier_complete(bar, b.x, nloc, nx); b.st[0] = nloc; b.st[1] = nx; }
        const unsigned old = xb_add(&bar[XB_XSUB(b.x)], 1u);
        const unsigned gen = old / nloc;
        if (old + 1u == (gen + 1u) * nloc) {
            __builtin_amdgcn_fence(__ATOMIC_RELEASE, "agent");
            asm volatile("s_waitcnt vmcnt(0)" ::: "memory");
            const unsigned og = xb_add(&bar[XB_TOP], 1u);
            const unsigned tg = og / nx;
            if (og + 1u == (tg + 1u) * nx) xb_add(&bar[XB_TOPGEN], 1u);
            else XB_SPIN(xb_ld(&bar[XB_TOPGEN]) == tg, bar);
            __builtin_amdgcn_fence(__ATOMIC_ACQUIRE, "agent");
            xb_add(&bar[XB_XGEN(b.x)], 1u);
            asm volatile("s_waitcnt vmcnt(0)" ::: "memory");
        } else {
            XB_SPIN(xb_ld(&bar[XB_XGEN(b.x)]) == gen, bar);
            __builtin_amdgcn_fence(__ATOMIC_ACQUIRE, "agent");
            asm volatile("s_waitcnt vmcnt(0)" ::: "memory");
        }
    }
    __syncthreads();
}


__device__ __forceinline__ float bf2f(unsigned short b) { return __uint_as_float((unsigned)b << 16); }
__device__ __forceinline__ unsigned short f2bf(float f) { unsigned u = __float_as_uint(f); u += 0x7FFFu + ((u >> 16) & 1u); return (unsigned short)(u >> 16); }
__device__ __forceinline__ float sigm(float x) { return __builtin_amdgcn_rcpf(1.0f + __expf(-x)); }
__device__ __forceinline__ float tanh_fast(float x) { return 1.0f - 2.0f * __builtin_amdgcn_rcpf(1.0f + __expf(2.0f * x)); }
__device__ __forceinline__ float rdl(float x, int i) { return __uint_as_float(__builtin_amdgcn_readlane(__float_as_uint(x), i)); }
__device__ __forceinline__ float wsum(float x) {
#pragma unroll
    for (int o = 32; o; o >>= 1) x += __shfl_xor(x, o);
    return x; }
__device__ __forceinline__ float lo16(unsigned w) { return __uint_as_float(w << 16); }
__device__ __forceinline__ float hi16(unsigned w) { return __uint_as_float(w & 0xffff0000u); }
__device__ __forceinline__ float rstd_of(const float* rowss, int row) { return rsqrtf(rowss[row] * (1.0f / 1024.0f) + 1e-6f); }

template <int MODE> struct EpiBf {
    static constexpr bool PERM = true, AFTER_DRAIN = false;
    bf16_t* O; int ldc; const float* rowss;
    __device__ __forceinline__ void operator()(const f32x4 (&acc)[2][2][4][2], const pg8::Unit& u, int wr, int wc, int fr, int fq) const {
        const int row0 = u.pm * 256 + wr * 64 + fr, col0 = u.pn * 256 + wc * 32 + 8 * fq;
#pragma unroll
        for (int ai = 0; ai < 2; ++ai)
#pragma unroll
            for (int m = 0; m < 4; ++m) {
                const int row = row0 + ai * 128 + m * 16;
                const float s = (MODE == 2) ? 1.0f : rstd_of(rowss, row);
                bf16_t* rowp = O + (size_t)row * ldc + col0;
#pragma unroll
                for (int bj = 0; bj < 2; ++bj) {
                    f32x4 v0 = acc[ai][bj][m][0] * s, v1 = acc[ai][bj][m][1] * s;
                    if (MODE == 1) {
#pragma unroll
                        for (int j = 0; j < 4; ++j) { const float a = fmaxf(v0[j], 0.f), b = fmaxf(v1[j], 0.f); v0[j] = a * a; v1[j] = b * b; } }
                    u32x4 w; w.x = cvt_pk_bf16(v0[0], v0[1]); w.y = cvt_pk_bf16(v0[2], v0[3]); w.z = cvt_pk_bf16(v1[0], v1[1]); w.w = cvt_pk_bf16(v1[2], v1[3]);
                    *(u32x4*)(rowp + bj * 128) = w; } }
    }
};
template <int ACC> struct EpiGate {
    static constexpr bool PERM = true, AFTER_DRAIN = false;
    bf16_t* M; const bf16_t* Tm; const float* rowss;
    __device__ __forceinline__ void operator()(const f32x4 (&acc)[2][2][4][2], const pg8::Unit& u, int wr, int wc, int fr, int fq) const {
        const int row0 = u.pm * 256 + wr * 64 + fr, col0 = u.pn * 256 + wc * 32 + 8 * fq;
#pragma unroll
        for (int ai = 0; ai < 2; ++ai)
#pragma unroll
            for (int m = 0; m < 4; ++m) {
                const int row = row0 + ai * 128 + m * 16;
                const float s = rstd_of(rowss, row);
#pragma unroll
                for (int bj = 0; bj < 2; ++bj) {
                    const size_t off = (size_t)row * 1024 + col0 + bj * 128;
                    const u32x4 tv = *(const u32x4*)(Tm + off);
                    u32x4 pv = (u32x4){0u, 0u, 0u, 0u};
                    if (ACC) pv = *(const u32x4*)(M + off);
                    const f32x4 a0 = acc[ai][bj][m][0] * s, a1 = acc[ai][bj][m][1] * s;
                    float o[8];
                    o[0] = sigm(a0[0]) * lo16(tv.x); o[1] = sigm(a0[1]) * hi16(tv.x); o[2] = sigm(a0[2]) * lo16(tv.y); o[3] = sigm(a0[3]) * hi16(tv.y);
                    o[4] = sigm(a1[0]) * lo16(tv.z); o[5] = sigm(a1[1]) * hi16(tv.z); o[6] = sigm(a1[2]) * lo16(tv.w); o[7] = sigm(a1[3]) * hi16(tv.w);
                    if (ACC) { o[0] += lo16(pv.x); o[1] += hi16(pv.x); o[2] += lo16(pv.y); o[3] += hi16(pv.y); o[4] += lo16(pv.z); o[5] += hi16(pv.z); o[6] += lo16(pv.w); o[7] += hi16(pv.w); }
                    u32x4 w; w.x = cvt_pk_bf16(o[0], o[1]); w.y = cvt_pk_bf16(o[2], o[3]); w.z = cvt_pk_bf16(o[4], o[5]); w.w = cvt_pk_bf16(o[6], o[7]);
                    *(u32x4*)(M + off) = w; } }
    }
};
struct EpiResid {
    static constexpr bool PERM = false, AFTER_DRAIN = false;
    float* X; bf16_t* XB; float* rowss_out;
    __device__ __forceinline__ void operator()(const f32x4 (&acc)[2][2][4][2], const pg8::Unit& u, int wr, int wc, int fr, int fq) const {
        const int row0 = u.pm * 256 + wr * 64 + fr, col0 = u.pn * 256 + wc * 32 + 4 * fq;
#pragma unroll
        for (int ai = 0; ai < 2; ++ai)
#pragma unroll
            for (int m = 0; m < 4; ++m) {
                const int row = row0 + ai * 128 + m * 16;
                float* xp = X + (size_t)row * 1024 + col0; bf16_t* bp = XB + (size_t)row * 1024 + col0;
                float ss = 0.f;
#pragma unroll
                for (int bj = 0; bj < 2; ++bj)
#pragma unroll
                    for (int n = 0; n < 2; ++n) {
                        f32x4 xv = *(const f32x4*)(xp + bj * 128 + n * 16) + acc[ai][bj][m][n];
                        *(f32x4*)(xp + bj * 128 + n * 16) = xv;
                        ss += (xv[0] * xv[0] + xv[1] * xv[1]) + (xv[2] * xv[2] + xv[3] * xv[3]);
                        u32x2 w; w.x = cvt_pk_bf16(xv[0], xv[1]); w.y = cvt_pk_bf16(xv[2], xv[3]);
                        *(u32x2*)(bp + bj * 128 + n * 16) = w; }
                ss += __shfl_xor(ss, 16); ss += __shfl_xor(ss, 32);
                if (fq == 0) atomicAdd(rowss_out + row, ss); }
    }
};
template <class Epi> __device__ __forceinline__ void run_gemm(LAS unsigned char* lds, const bf16_t* A, const bf16_t* Bt, int N, int K, const Epi& E) {
    pg8::StaticOrder S; S.init(T_ALL, N, (int)gridDim.x, bidx());
    pg8::Gemm g; g.A = A; g.Bt = Bt; g.M = T_ALL; g.N = N; g.K = K; g.ld = K;
    pg8::gemm_phase<Epi, pg8::StaticOrder, false>(lds, g, S, E, nullptr);
}


struct OneUnit { int pm, pn, valid;
    __device__ bool next(int i, pg8::Unit& u) const { if (i != 0 || !valid) return false; u.pm = pm; u.pn = pn; return true; }
    __device__ __forceinline__ void a_ready(const pg8::Unit&) const {}
    __device__ __forceinline__ void done(const pg8::Unit&) const {} };
struct EpiPartial {
    static constexpr bool PERM = false, AFTER_DRAIN = false;
    float* PART;
    __device__ __forceinline__ void operator()(const f32x4 (&acc)[2][2][4][2], const pg8::Unit& u, int wr, int wc, int fr, int fq) const {
        const int row0 = (u.pm - 64) * 256 + wr * 64 + fr, col0 = u.pn * 256 + wc * 32 + 4 * fq;
#pragma unroll
        for (int ai = 0; ai < 2; ++ai)
#pragma unroll
            for (int m = 0; m < 4; ++m) { float* xp = PART + (size_t)(row0 + ai * 128 + m * 16) * 1024 + col0;
#pragma unroll
                for (int bj = 0; bj < 2; ++bj)
#pragma unroll
                    for (int n = 0; n < 2; ++n) *(f32x4*)(xp + bj * 128 + n * 16) = acc[ai][bj][m][n]; }
    }
};
constexpr size_t OFF_PART = OFF_B + 4 * SLOT;
__device__ __forceinline__ void run_ffn_down(LAS unsigned char* lds, const bf16_t* HID, const bf16_t* WDN, const EpiResid& E, float* PART) {
    { pg8::StaticOrder S; S.init(T_P, 1024, (int)gridDim.x, bidx());
      pg8::Gemm g; g.A = HID; g.Bt = WDN; g.M = T_P; g.N = 1024; g.K = 4096; g.ld = 4096;
      pg8::gemm_phase<EpiResid, pg8::StaticOrder, false>(lds, g, S, E, nullptr); }
    { const int t = bidx(); OneUnit S; S.valid = t < 128; const int sl = t & 7, u = (t >> 3) & 15; S.pm = 64 + (u >> 2); S.pn = u & 3;
      pg8::Gemm g; g.A = HID + sl * 512; g.Bt = WDN + sl * 512; g.M = T_ALL; g.N = 1024; g.K = 512; g.ld = 4096;
      EpiPartial EA; EA.PART = PART + (size_t)sl * 1024 * 1024;
      pg8::gemm_phase<EpiPartial, OneUnit, false>(lds, g, S, EA, nullptr); }
}
__device__ void finalize_sample(const Ctx& p, float* rowss_out) {
    unsigned char* ws = uptr(p.ws); bf16_t* XB = (bf16_t*)(ws + OFF_XB); const float* PART = (const float*)(ws + OFF_PART);
    const int tid = tidx(); const int wave = __builtin_amdgcn_readfirstlane(tid >> 6), lane = tid & 63;
    for (int row = T_P + bidx() * 8 + wave; row < T_ALL; row += gridDim.x * 8) {
        float* src = p.out + (size_t)row * 1024; const float* pr = PART + (size_t)(row - T_P) * 1024; float ss = 0.f;
#pragma unroll
        for (int i = 0; i < 4; ++i) { const int c = i * 256 + lane * 4; float4 v = *(const float4*)(src + c);
#pragma unroll
            for (int sl = 0; sl < 8; ++sl) { const float4 q = *(const float4*)(pr + (size_t)sl * 1024 * 1024 + c); v.x += q.x; v.y += q.y; v.z += q.z; v.w += q.w; }
            *(float4*)(src + c) = v;
            ss += v.x * v.x + v.y * v.y + v.z * v.z + v.w * v.w; u32x2 w; w.x = cvt_pk_bf16(v.x, v.y); w.y = cvt_pk_bf16(v.z, v.w); *(u32x2*)(XB + (size_t)row * 1024 + c) = w; }
        ss = wsum(ss); if (lane == 0) rowss_out[row] = ss;
    }
}
__device__ void conv_T(const float* __restrict__ src, int ld, int s0, int cnt, int K, const float* __restrict__ scale, bf16_t* __restrict__ dst, int d0, LAS unsigned char* lds) {
    LAS float* ts = (LAS float*)lds;
    const int tid = tidx(); const int nkt = K / 256, ntile = (cnt / 32) * nkt;
    for (int tile = bidx(); tile < ntile; tile += gridDim.x) {
        const int n0 = (tile / nkt) * 32, k0 = (tile % nkt) * 256;
        { const int kk = tid >> 3, nq = tid & 7; float4 v[4]; float sc[4];
#pragma unroll
          for (int r = 0; r < 4; ++r) { v[r] = *(const float4*)(src + (size_t)(k0 + r * 64 + kk) * ld + s0 + n0 + nq * 4); sc[r] = scale ? scale[k0 + r * 64 + kk] : 1.0f; }
#pragma unroll
          for (int r = 0; r < 4; ++r) { LAS float* q = ts + (nq * 4) * 257 + r * 64 + kk; q[0] = v[r].x * sc[r]; q[257] = v[r].y * sc[r]; q[514] = v[r].z * sc[r]; q[771] = v[r].w * sc[r]; } }
        __syncthreads();
        { const int n = tid >> 4, kq = tid & 15;
#pragma unroll
          for (int r = 0; r < 4; ++r) { const LAS float* q = ts + n * 257 + r * 64 + kq * 4; u32x2 w; w.x = cvt_pk_bf16(q[0], q[1]); w.y = cvt_pk_bf16(q[2], q[3]);
            *(u32x2*)(dst + (size_t)(d0 + n0 + n) * K + k0 + r * 64 + kq * 4) = w; } }
        __syncthreads();
    }
}
__device__ void conv_small(const float* __restrict__ src, int ld, int cnt, int K, bf16_t* __restrict__ dst) {
    for (int i = bidx() * 512 + tidx(); i < cnt * K; i += gridDim.x * 512) { const int c = i / K, j = i % K; dst[i] = f2bf(src[(size_t)j * ld + c]); }
}
__device__ void phase_convert_early(const Ctx& p, int l, LAS unsigned char* lds) {
    unsigned char* ws = uptr(p.ws);
    const float* win = INP(p, 6) + (size_t)l * 1024 * 5920; const float* nm = INP(p, 5) + l * 1024;
    conv_T(win, 5920, 0, 1824, 1024, nm, (bf16_t*)(ws + OFF_WRW), 0, lds);
    { u32x4* z = (u32x4*)(ws + OFF_WRW + (size_t)1824 * 1024 * 2); const int n = 224 * 1024 * 2 / 16;
      unsigned zz = 0u; asm volatile("" : "+v"(zz));
      for (int i = bidx() * 512 + tidx(); i < n; i += gridDim.x * 512) z[i] = (u32x4){zz, zz, zz, zz}; }
    conv_T(win, 5920, 1824, 2048, 1024, nm, (bf16_t*)(ws + OFF_WHG), 0, lds);
    conv_small(INP(p, 9) + (size_t)l * 64 * 512, 512, 512, 64, (bf16_t*)(ws + OFF_SM + SM_W2T));
    conv_small(INP(p, 11) + (size_t)l * 64 * 512, 512, 512, 64, (bf16_t*)(ws + OFF_SM + SM_A2T));
    conv_small(INP(p, 12) + (size_t)l * 160 * 512, 512, 512, 160, (bf16_t*)(ws + OFF_SM + SM_G2T));
    if (l == 1) {
        conv_small(INP(p, 14), 32, 32, 512, (bf16_t*)(ws + OFF_SM + SM_V1T));
        conv_small(INP(p, 15), 512, 512, 32, (bf16_t*)(ws + OFF_SM + SM_V2T));
    }
}
__device__ void phase_convert_late(const Ctx& p, int l, LAS unsigned char* lds) {
    unsigned char* ws = uptr(p.ws);
    const float* win = INP(p, 6) + (size_t)l * 1024 * 5920; const float* nm = INP(p, 5) + l * 1024;
    conv_T(win, 5920, 3872, 1024, 1024, nm, (bf16_t*)(ws + OFF_WGA), 0, lds);
    conv_T(win, 5920, 4896, 1024, 1024, nm, (bf16_t*)(ws + OFF_WGB), 0, lds);
    conv_T(INP(p, 23) + (size_t)l * 512 * 1024, 1024, 0, 1024, 512, nullptr, (bf16_t*)(ws + OFF_WOA), 0, lds);
    conv_T(INP(p, 24) + (size_t)l * 512 * 1024, 1024, 0, 1024, 512, nullptr, (bf16_t*)(ws + OFF_WOB), 0, lds);
    conv_T(INP(p, 25) + (size_t)l * 1024 * 1024, 1024, 0, 1024, 1024, nullptr, (bf16_t*)(ws + OFF_WO), 0, lds);
    conv_T(INP(p, 27) + (size_t)l * 1024 * 4096, 4096, 0, 4096, 1024, INP(p, 26) + l * 1024, (bf16_t*)(ws + OFF_WUP), 0, lds);
    conv_T(INP(p, 28) + (size_t)l * 4096 * 1024, 1024, 0, 1024, 4096, nullptr, (bf16_t*)(ws + OFF_WDN), 0, lds);
}
__device__ void phase_x0(const Ctx& p) {
    const int tid = tidx(); const int wave = __builtin_amdgcn_readfirstlane(tid >> 6), lane = tid & 63;
    unsigned char* ws = uptr(p.ws);
    float* rowss = (float*)(ws + OFF_SM + SM_ROWSS); bf16_t* XB = (bf16_t*)(ws + OFF_XB);
    for (int row = bidx() * 8 + wave; row < T_ALL; row += gridDim.x * 8) {
        const float* src = row < T_P ? INP(p, 0) + (size_t)row * 1024 : INP(p, 1) + (size_t)(row - T_P) * 1024;
        float ss = 0.f;
#pragma unroll
        for (int i = 0; i < 4; ++i) { const int c = i * 256 + lane * 4; const float4 v = *(const float4*)(src + c); *(float4*)(p.out + (size_t)row * 1024 + c) = v;
            ss += v.x * v.x + v.y * v.y + v.z * v.z + v.w * v.w; u32x2 w; w.x = cvt_pk_bf16(v.x, v.y); w.y = cvt_pk_bf16(v.z, v.w); *(u32x2*)(XB + (size_t)row * 1024 + c) = w; }
        ss = wsum(ss); if (lane == 0) rowss[row] = ss;
    }
    for (int i = bidx() * 512 + tidx(); i < 4 * T_ALL; i += gridDim.x * 512) rowss[T_ALL + i] = 0.f;
}
__device__ __forceinline__ u32x2 pack4(float a, float b, float c, float d) { u32x2 w; w.x = cvt_pk_bf16(a, b); w.y = cvt_pk_bf16(c, d); return w; }
__device__ void phase_prep(const Ctx& p, int l, LAS unsigned char* lds) {
    constexpr int MXS = 1832, MIDS = 40;
    unsigned char* ws = uptr(p.ws);
    const bf16_t* PR = (const bf16_t*)(ws + OFF_A);
    LAS bf16_t* MX = (LAS bf16_t*)lds; LAS bf16_t* MID = (LAS bf16_t*)(lds + 32 * MXS * 2);
    const int tid = tidx(); const int wave = __builtin_amdgcn_readfirstlane(tid >> 6), lane = tid & 63, fr = lane & 15, fq = lane >> 4;
    const float* mu = INP(p, 7) + l * 1824;
    const bf16_t* w2T = (const bf16_t*)(ws + OFF_SM + SM_W2T); const bf16_t* a2T = (const bf16_t*)(ws + OFF_SM + SM_A2T); const bf16_t* g2T = (const bf16_t*)(ws + OFF_SM + SM_G2T);
    const bf16_t* v1T = (const bf16_t*)(ws + OFF_SM + SM_V1T); const bf16_t* v2T = (const bf16_t*)(ws + OFF_SM + SM_V2T);
    bf16_t* oR = (bf16_t*)(ws + OFF_B); bf16_t* oV = (bf16_t*)(l == 0 ? ws + OFF_V0 : ws + OFF_B + SLOT); bf16_t* oE = (bf16_t*)(ws + OFF_B + 2 * SLOT);
    bf16_t* oK = (bf16_t*)(ws + OFF_B + 3 * SLOT); bf16_t* oA = (bf16_t*)(ws + OFF_B + 4 * SLOT); bf16_t* oB = (bf16_t*)(ws + OFF_B + 5 * SLOT);
    bf16_t* oG = (bf16_t*)(ws + OFF_G); const bf16_t* V0 = (const bf16_t*)(ws + OFF_V0);
    float* bonus = (float*)(ws + OFF_SM + SM_BONUS);
    const float* w0 = INP(p, 8) + l * 512; const float* a0 = INP(p, 10) + l * 512; const float* kkp = INP(p, 16) + l * 512; const float* kap = INP(p, 17) + l * 512; const float* rkp = INP(p, 18) + l * 512;
    const float* v0p = INP(p, 13);
    for (int ti = bidx(); ti < T_ALL / 32; ti += gridDim.x) {
        const int t0 = ti * 32;
        if (tid < 456) {
            const int cgp = tid % 228, rh = tid / 228, c0 = cgp * 8, rstart = rh * 16;
            float prev[8], m8[8];
            { const float4 a = *(const float4*)(mu + c0), b = *(const float4*)(mu + c0 + 4); m8[0] = a.x; m8[1] = a.y; m8[2] = a.z; m8[3] = a.w; m8[4] = b.x; m8[5] = b.y; m8[6] = b.z; m8[7] = b.w; }
            const bool seq_start = (rh == 0) && (t0 >= T_P || (t0 % 8192) == 0);
            if (seq_start) {
                if (t0 >= T_P) { const float* sp = INP(p, 2) + ((size_t)l * 32 + (t0 - T_P) / 32) * 1824 + c0;
#pragma unroll
                    for (int j = 0; j < 8; ++j) prev[j] = sp[j]; }
                else {
#pragma unroll
                    for (int j = 0; j < 8; ++j) prev[j] = 0.f; }
            } else {
                const u32x4 w = *(const u32x4*)(PR + (size_t)(t0 + rstart - 1) * 2048 + c0);
                prev[0] = lo16(w.x); prev[1] = hi16(w.x); prev[2] = lo16(w.y); prev[3] = hi16(w.y); prev[4] = lo16(w.z); prev[5] = hi16(w.z); prev[6] = lo16(w.w); prev[7] = hi16(w.w);
            }
            const int fn = c0 < 1536 ? 0 : (c0 < 1600 ? 1 : (c0 < 1664 ? 0 : 2));
#pragma unroll 1
            for (int r8 = 0; r8 < 16; r8 += 8) {
            u32x4 wrow[8];
#pragma unroll
            for (int r = 0; r < 8; ++r) wrow[r] = *(const u32x4*)(PR + (size_t)(t0 + rstart + r8 + r) * 2048 + c0);
#pragma unroll
            for (int rr = 0; rr < 8; ++rr) {
                const int r = r8 + rr; const u32x4 w = wrow[rr];
                float cur[8], o[8];
                cur[0] = lo16(w.x); cur[1] = hi16(w.x); cur[2] = lo16(w.y); cur[3] = hi16(w.y); cur[4] = lo16(w.z); cur[5] = hi16(w.z); cur[6] = lo16(w.w); cur[7] = hi16(w.w);
#pragma unroll
                for (int j = 0; j < 8; ++j) { float x = cur[j] + (prev[j] - cur[j]) * m8[j]; if (fn == 1) x = tanh_fast(x); else if (fn == 2) x = sigm(x); o[j] = x; prev[j] = cur[j]; }
                u32x4 q; q.x = cvt_pk_bf16(o[0], o[1]); q.y = cvt_pk_bf16(o[2], o[3]); q.z = cvt_pk_bf16(o[4], o[5]); q.w = cvt_pk_bf16(o[6], o[7]);
                *(LAS u32x4*)(MX + (rstart + r) * MXS + c0) = q;
            }
            }
            if (rh == 1) {
                const bool last = t0 >= T_P || ((t0 + 32) % 8192) == 0;
                if (last) { float* dst = t0 >= T_P ? p.out + O_SHS + ((size_t)l * 32 + (t0 - T_P) / 32) * 1824 + c0 : p.out + O_SHP + ((size_t)l * 2 + t0 / 8192) * 1824 + c0;
#pragma unroll
                    for (int j = 0; j < 8; ++j) dst[j] = prev[j]; }
            }
        }
        __syncthreads();
        if (l == 1 && VRES && VRES != 2) {
            if (wave < 4) {
                const int tt = wave & 1, ot = wave >> 1; f32x4 acc = (f32x4){0.f, 0.f, 0.f, 0.f};
#pragma unroll 4
                for (int ks = 0; ks < 16; ++ks) {
                    const bf16x8 X = *(const bf16x8*)(v1T + (ot * 16 + fr) * 512 + ks * 32 + fq * 8);
                    const bf16x8 Y = *(const LAS bf16x8*)(MX + (tt * 16 + fr) * MXS + 1024 + ks * 32 + fq * 8);
                    acc = __builtin_amdgcn_mfma_f32_16x16x32_bf16(X, Y, acc, 0, 0, 0); }
                *(LAS u32x2*)(MID + (tt * 16 + fr) * MIDS + ot * 16 + 4 * fq) = pack4(acc[0], acc[1], acc[2], acc[3]);
            }
            __syncthreads();
        }
        const int h = wave;
        float ss[2] = {0.f, 0.f}, bon[2] = {0.f, 0.f};
#pragma unroll 1
        for (int ct = 0; ct < 4; ++ct) {
            const int crow = h * 64 + ct * 16 + fr, c = h * 64 + ct * 16 + 4 * fq;
            bf16x8 xw[2], xa[2], xg[5], xv;
#pragma unroll
            for (int ks = 0; ks < 2; ++ks) { xw[ks] = *(const bf16x8*)(w2T + crow * 64 + ks * 32 + fq * 8); xa[ks] = *(const bf16x8*)(a2T + crow * 64 + ks * 32 + fq * 8); }
#pragma unroll
            for (int ks = 0; ks < 5; ++ks) xg[ks] = *(const bf16x8*)(g2T + crow * 160 + ks * 32 + fq * 8);
            if (l == 1) xv = *(const bf16x8*)(v2T + crow * 32 + fq * 8); else xv = xw[0];
            const float4 w04 = *(const float4*)(w0 + c), a04 = *(const float4*)(a0 + c), kk_4 = *(const float4*)(kkp + c), ka4 = *(const float4*)(kap + c), rk4 = *(const float4*)(rkp + c);
            const float w0a[4] = {w04.x, w04.y, w04.z, w04.w}, a0a[4] = {a04.x, a04.y, a04.z, a04.w}, kka[4] = {kk_4.x, kk_4.y, kk_4.z, kk_4.w}, kaa[4] = {ka4.x, ka4.y, ka4.z, ka4.w}, rka[4] = {rk4.x, rk4.y, rk4.z, rk4.w};
            float v0a[4] = {0.f, 0.f, 0.f, 0.f};
            if (l == 1) { const float4 v04 = *(const float4*)(v0p + c); v0a[0] = v04.x; v0a[1] = v04.y; v0a[2] = v04.z; v0a[3] = v04.w; }
            u32x2 fwv[2] = {(u32x2){0u, 0u}, (u32x2){0u, 0u}};
            if (l == 1) { fwv[0] = *(const u32x2*)(V0 + (size_t)(t0 + fr) * 512 + c); fwv[1] = *(const u32x2*)(V0 + (size_t)(t0 + 16 + fr) * 512 + c); }
#pragma unroll
            for (int tt = 0; tt < 2; ++tt) {
                const LAS bf16_t* yrow = MX + (tt * 16 + fr) * MXS + fq * 8;
                f32x4 aW = (f32x4){0.f, 0.f, 0.f, 0.f}, aA = aW, aG = aW, aV = aW;
#pragma unroll
                for (int ks = 0; ks < 2; ++ks) { aW = __builtin_amdgcn_mfma_f32_16x16x32_bf16(xw[ks], *(const LAS bf16x8*)(yrow + 1536 + ks * 32), aW, 0, 0, 0);
                                                 aA = __builtin_amdgcn_mfma_f32_16x16x32_bf16(xa[ks], *(const LAS bf16x8*)(yrow + 1600 + ks * 32), aA, 0, 0, 0); }
#pragma unroll
                for (int ks = 0; ks < 5; ++ks) aG = __builtin_amdgcn_mfma_f32_16x16x32_bf16(xg[ks], *(const LAS bf16x8*)(yrow + 1664 + ks * 32), aG, 0, 0, 0);
                if (l == 1) aV = __builtin_amdgcn_mfma_f32_16x16x32_bf16(xv, *(const LAS bf16x8*)(MID + (tt * 16 + fr) * MIDS + fq * 8), aV, 0, 0, 0);
                const int j = tt * 16 + fr, t = t0 + j;
                LAS bf16_t* mrow = MX + j * MXS + c;
                const u32x2 rw = *(const LAS u32x2*)(mrow), kw = *(const LAS u32x2*)(mrow + 512), vw = *(const LAS u32x2*)(mrow + 1024);
                const float rr[4] = {lo16(rw.x), hi16(rw.x), lo16(rw.y), hi16(rw.y)}, kk4[4] = {lo16(kw.x), hi16(kw.x), lo16(kw.y), hi16(kw.y)};
                float vv[4] = {lo16(vw.x), hi16(vw.x), lo16(vw.y), hi16(vw.y)};
                if (l == 1) {
                    const u32x2 fw = fwv[tt]; const float vf[4] = {lo16(fw.x), hi16(fw.x), lo16(fw.y), hi16(fw.y)};
#pragma unroll
                    for (int e = 0; e < 4; ++e) { const float vg = sigm(v0a[e] + aV[e]); vv[e] = vv[e] + (vf[e] - vv[e]) * vg; }
                }
                float ew[4], kh[4], kr4[4], ag4[4];
#pragma unroll
                for (int e = 0; e < 4; ++e) {
                    ew[e] = 0.60653066f * sigm(w0a[e] + aW[e]);
                    const float a = sigm(a0a[e] + aA[e]); ag4[e] = a;
                    const float kr = kk4[e] * kka[e]; kr4[e] = kr; ss[tt] += kr * kr;
                    kh[e] = kk4[e] * (1.0f + (a - 1.0f) * kaa[e]);
                    bon[tt] += rr[e] * kh[e] * rka[e];
                }
                const size_t o = (size_t)t * 512 + c;
                *(u32x2*)(oR + o) = rw;
                *(u32x2*)(oV + o) = pack4(vv[0], vv[1], vv[2], vv[3]);
                *(u32x2*)(oE + o) = pack4(ew[0], ew[1], ew[2], ew[3]);
                *(u32x2*)(oK + o) = pack4(kh[0], kh[1], kh[2], kh[3]);
                *(u32x2*)(oG + o) = pack4(aG[0], aG[1], aG[2], aG[3]);
                *(LAS u32x2*)(mrow) = pack4(ag4[0], ag4[1], ag4[2], ag4[3]);
                *(LAS u32x2*)(mrow + 512) = pack4(kr4[0], kr4[1], kr4[2], kr4[3]);
            }
        }
#pragma unroll
        for (int tt = 0; tt < 2; ++tt) {
            float s1 = ss[tt], b1 = bon[tt];
            s1 += __shfl_xor(s1, 16); s1 += __shfl_xor(s1, 32); b1 += __shfl_xor(b1, 16); b1 += __shfl_xor(b1, 32);
            const float inv = rsqrtf(fmaxf(s1, 1e-24f));
            const int j = tt * 16 + fr, t = t0 + j;
#pragma unroll
            for (int ct = 0; ct < 4; ++ct) {
                const int c = h * 64 + ct * 16 + 4 * fq;
                const LAS bf16_t* mrow = MX + j * MXS + c;
                const u32x2 aw = *(const LAS u32x2*)(mrow), kw = *(const LAS u32x2*)(mrow + 512);
                const float ag4[4] = {lo16(aw.x), hi16(aw.x), lo16(aw.y), hi16(aw.y)}; float k4[4] = {lo16(kw.x) * inv, hi16(kw.x) * inv, lo16(kw.y) * inv, hi16(kw.y) * inv};
                const size_t o = (size_t)t * 512 + c;
                *(u32x2*)(oA + o) = pack4(-k4[0], -k4[1], -k4[2], -k4[3]);
                *(u32x2*)(oB + o) = pack4(k4[0] * ag4[0], k4[1] * ag4[1], k4[2] * ag4[2], k4[3] * ag4[3]);
            }
            if (fq == 0) bonus[(size_t)t * 8 + h] = b1;
        }
        __syncthreads();
    }
}

typedef float f2 __attribute__((ext_vector_type(2)));
__device__ __forceinline__ f2 pfma(f2 a, f2 b, f2 c) { return __builtin_elementwise_fma(a, b, c); }
template <bool ID> __device__ __forceinline__ void rwkv_scan(const bf16_t* __restrict__ R, const bf16_t* __restrict__ EW, const bf16_t* __restrict__ K, const bf16_t* __restrict__ V,
        const bf16_t* __restrict__ A, const bf16_t* __restrict__ B, unsigned base, int nsteps, f2 (&Sv)[32], f2 (&Si)[32], bf16_t* __restrict__ YH, bf16_t* __restrict__ QH, LAS float* L, int lane) {
    unsigned short q1[6], q2[6];
    { unsigned o = base; q1[0] = R[o]; q1[1] = EW[o]; q1[2] = K[o]; q1[3] = V[o]; q1[4] = A[o]; q1[5] = B[o];
      o = base + 512u; q2[0] = R[o]; q2[1] = EW[o]; q2[2] = K[o]; q2[3] = V[o]; q2[4] = A[o]; q2[5] = B[o]; }
    const LAS f32x4* pa = (const LAS f32x4*)L;
    float sav, sai;
    { L[lane] = bf2f(q1[4]);
      f2 av = {0.f, 0.f}, ai = {0.f, 0.f};
#pragma unroll
      for (int q = 0; q < 16; ++q) { const f32x4 a4 = pa[q]; const f2 a01 = {a4[0], a4[1]}, a23 = {a4[2], a4[3]};
          av = pfma(Sv[2 * q], a01, av); av = pfma(Sv[2 * q + 1], a23, av); if (ID) { ai = pfma(Si[2 * q], a01, ai); ai = pfma(Si[2 * q + 1], a23, ai); } }
      sav = av[0] + av[1]; sai = ai[0] + ai[1]; }
#pragma unroll 1
    for (int s = 0; s < nsteps; ++s) {
        L[lane] = bf2f(q2[4]); L[64 + lane] = __expf(-bf2f(q1[1])); L[128 + lane] = bf2f(q1[5]); L[192 + lane] = bf2f(q1[2]); L[256 + lane] = bf2f(q1[0]);
        const float v = bf2f(q1[3]);
#pragma unroll
        for (int j = 0; j < 6; ++j) q1[j] = q2[j];
        { const unsigned o = base + (unsigned)(s + 2 < nsteps ? s + 2 : nsteps - 1) * 512u; q2[0] = R[o]; q2[1] = EW[o]; q2[2] = K[o]; q2[3] = V[o]; q2[4] = A[o]; q2[5] = B[o]; }
        const f2 sav2 = {sav, sav}, sai2 = {sai, sai}, v2 = {v, v};
        f2 yv = {0.f, 0.f}, yi = {0.f, 0.f}, yv1 = {0.f, 0.f}, yi1 = {0.f, 0.f}, nv = {0.f, 0.f}, ni = {0.f, 0.f}, nv1 = {0.f, 0.f}, ni1 = {0.f, 0.f};
        f32x4 ca = pa[0], cw = pa[16], cb = pa[32], ck = pa[48], cr = pa[64];
#pragma unroll
        for (int q = 0; q < 16; ++q) {
            const f32x4 a4 = ca, w4 = cw, b4 = cb, k4 = ck, r4 = cr;
            if (q < 15) { ca = pa[1 + q]; cw = pa[17 + q]; cb = pa[33 + q]; ck = pa[49 + q]; cr = pa[65 + q]; }
            __builtin_amdgcn_sched_barrier(0);
            { const f2 a2 = {a4[0], a4[1]}, w2 = {w4[0], w4[1]}, b2 = {b4[0], b4[1]}, k2 = {k4[0], k4[1]}, r2 = {r4[0], r4[1]};
              f2 tv = sav2 * b2; tv = pfma(v2, k2, tv); Sv[2 * q] = pfma(Sv[2 * q], w2, tv); yv = pfma(Sv[2 * q], r2, yv); nv = pfma(Sv[2 * q], a2, nv);
              if (ID) { const f2 ti = sai2 * b2; Si[2 * q] = pfma(Si[2 * q], w2, ti); yi = pfma(Si[2 * q], r2, yi); ni = pfma(Si[2 * q], a2, ni); } }
            { const f2 a2 = {a4[2], a4[3]}, w2 = {w4[2], w4[3]}, b2 = {b4[2], b4[3]}, k2 = {k4[2], k4[3]}, r2 = {r4[2], r4[3]};
              f2 tv = sav2 * b2; tv = pfma(v2, k2, tv); Sv[2 * q + 1] = pfma(Sv[2 * q + 1], w2, tv); yv1 = pfma(Sv[2 * q + 1], r2, yv1); nv1 = pfma(Sv[2 * q + 1], a2, nv1);
              if (ID) { const f2 ti = sai2 * b2; Si[2 * q + 1] = pfma(Si[2 * q + 1], w2, ti); yi1 = pfma(Si[2 * q + 1], r2, yi1); ni1 = pfma(Si[2 * q + 1], a2, ni1); } }
        }
        sav = (nv[0] + nv[1]) + (nv1[0] + nv1[1]); sai = (ni[0] + ni[1]) + (ni1[0] + ni1[1]);
        const unsigned cbo = base + (unsigned)s * 512u;
        YH[cbo] = f2bf((yv[0] + yv[1]) + (yv1[0] + yv1[1])); if (ID) QH[cbo] = f2bf((yi[0] + yi[1]) + (yi1[0] + yi1[1]));
    }
}
__device__ void phase_rwkv_scan(const Ctx& p, int l, LAS unsigned char* lds) {
    unsigned char* ws = uptr(p.ws);
    const bf16_t* R = (const bf16_t*)(ws + OFF_B); const bf16_t* V = (const bf16_t*)(l == 0 ? ws + OFF_V0 : ws + OFF_B + SLOT); const bf16_t* EW = (const bf16_t*)(ws + OFF_B + 2 * SLOT);
    const bf16_t* K = (const bf16_t*)(ws + OFF_B + 3 * SLOT); const bf16_t* A = (const bf16_t*)(ws + OFF_B + 4 * SLOT); const bf16_t* B = (const bf16_t*)(ws + OFF_B + 5 * SLOT);
    bf16_t* YH = (bf16_t*)(ws + OFF_A); bf16_t* QH = (bf16_t*)(ws + OFF_A + SLOT); float* P = (float*)(ws + OFF_A + 34 * MiB); float* UC = (float*)(ws + OFF_A + 50 * MiB);
    const int tid = tidx(); const int wave = __builtin_amdgcn_readfirstlane(tid >> 6), lane = tid & 63;
    LAS float* L = (LAS float*)(lds + wave * 5120);
    if (wave < 4) {
        for (int item = bidx() * 4 + wave; item < 1024; item += gridDim.x * 4) {
            const int b = item >> 9, c = (item >> 3) & 63, h = item & 7;
            f2 Sv[32], Si[32]; const int li = tidx() & 63;
#pragma unroll
            for (int i = 0; i < 32; ++i) { Sv[i] = (f2){0.f, 0.f}; Si[i] = (f2){(2 * i == li) ? 1.f : 0.f, (2 * i + 1 == li) ? 1.f : 0.f}; }
            rwkv_scan<true>(R, EW, K, V, A, B, (unsigned)((b * 8192 + c * 128) * 512 + h * 64 + lane), 128, Sv, Si, YH, QH, L, lane);
            const int ln = tidx() & 63; int item2 = item; asm volatile("" : "+s"(item2));
            float* pp = P + (size_t)item2 * 4096 + ln * 64; float* up = UC + (size_t)item2 * 4096 + ln * 64;
#pragma unroll
            for (int i = 0; i < 32; i += 2) { *(float4*)(pp + 2 * i) = make_float4(Si[i][0], Si[i][1], Si[i + 1][0], Si[i + 1][1]); *(float4*)(up + 2 * i) = make_float4(Sv[i][0], Sv[i][1], Sv[i + 1][0], Sv[i + 1][1]); }
        }
    } else if (wave == 4) {
        for (int item = bidx(); item < 256; item += gridDim.x) {
            const int s = item >> 3, h = item & 7;
            const size_t so = (((size_t)l * 32 + s) * 8 + h) * 4096 + lane * 64;
            f2 Sv[32], Si[32];
            const float* sp = INP(p, 3) + so;
#pragma unroll
            for (int i = 0; i < 32; i += 2) { const float4 q = *(const float4*)(sp + 2 * i); Sv[i] = (f2){q.x, q.y}; Sv[i + 1] = (f2){q.z, q.w}; Si[i] = (f2){0.f, 0.f}; Si[i + 1] = (f2){0.f, 0.f}; }
            rwkv_scan<false>(R, EW, K, V, A, B, (unsigned)((T_P + s * 32) * 512 + h * 64 + lane), 32, Sv, Si, YH, QH, L, lane);
            float* op = p.out + O_RWS + so;
#pragma unroll
            for (int i = 0; i < 32; i += 2) *(float4*)(op + 2 * i) = make_float4(Sv[i][0], Sv[i][1], Sv[i + 1][0], Sv[i + 1][1]);
        }
    }
}
template <int CTRL> __device__ __forceinline__ float dpp_mov(float x) { return __uint_as_float(__builtin_amdgcn_update_dpp(0, __float_as_uint(x), CTRL, 0xF, 0xF, true)); }
__device__ __forceinline__ float wsum_fast(float x) {
    x += dpp_mov<0xB1>(x); x += dpp_mov<0x4E>(x); x += dpp_mov<0x141>(x); x += dpp_mov<0x140>(x);
    float t = rdl(x, 0); t += rdl(x, 16); t += rdl(x, 32); t += rdl(x, 48); return t; }
__device__ void phase_rwkv_chain(const Ctx& p, int l) {
    unsigned char* ws = uptr(p.ws);
    const float* P = (const float*)(ws + OFF_A + 34 * MiB); float* UC = (float*)(ws + OFF_A + 50 * MiB);
    const int tid = tidx(); const int wave = __builtin_amdgcn_readfirstlane(tid >> 6), lane = tid & 63;
    if (wave >= 4) return;
    for (int it = bidx() * 4 + wave; it < 1024; it += gridDim.x * 4) {
        const int b = it >> 9, h = (it >> 6) & 7, v = it & 63;
        const float* pb = P + (size_t)((b * 64) * 8 + h) * 4096 + lane;
        float* ub = UC + (size_t)((b * 64) * 8 + h) * 4096 + v * 64 + lane;
        float row = 0.f; float PA[64], PB[64];
#pragma unroll
        for (int i = 0; i < 64; ++i) PA[i] = pb[i * 64];
        float ucA = ub[0];
        for (int c = 0; c < 64; c += 2) {
            { const float* pc = pb + (size_t)(c + 1) * 32768;
#pragma unroll
              for (int i = 0; i < 64; ++i) PB[i] = pc[i * 64]; }
            const float ucB = ub[(size_t)(c + 1) * 32768];
            ub[(size_t)c * 32768] = row;
            { float n0 = ucA, n1 = 0.f;
#pragma unroll
              for (int i = 0; i < 64; i += 2) { n0 = fmaf(rdl(row, i), PA[i], n0); n1 = fmaf(rdl(row, i + 1), PA[i + 1], n1); }
              row = n0 + n1; }
            if (c + 2 < 64) { const float* pc = pb + (size_t)(c + 2) * 32768;
#pragma unroll
                for (int i = 0; i < 64; ++i) PA[i] = pc[i * 64];
                ucA = ub[(size_t)(c + 2) * 32768]; }
            ub[(size_t)(c + 1) * 32768] = row;
            { float n0 = ucB, n1 = 0.f;
#pragma unroll
              for (int i = 0; i < 64; i += 2) { n0 = fmaf(rdl(row, i), PB[i], n0); n1 = fmaf(rdl(row, i + 1), PB[i + 1], n1); }
              row = n0 + n1; }
        }
        p.out[O_RWP + (((size_t)l * 2 + b) * 8 + h) * 4096 + v * 64 + lane] = row;
    }
}
__device__ void phase_rwkv_fix(const Ctx& p, int l) {
    unsigned char* ws = uptr(p.ws);
    const bf16_t* YH = (const bf16_t*)(ws + OFF_A); const bf16_t* QH = (const bf16_t*)(ws + OFF_A + SLOT); const float* UC = (const float*)(ws + OFF_A + 50 * MiB);
    const bf16_t* V = (const bf16_t*)(l == 0 ? ws + OFF_V0 : ws + OFF_B + SLOT); const bf16_t* G = (const bf16_t*)(ws + OFF_G); const float* bonus = (const float*)(ws + OFF_SM + SM_BONUS);
    bf16_t* YA = (bf16_t*)(ws + OFF_B);
    const int tid = tidx(); const int wave = __builtin_amdgcn_readfirstlane(tid >> 6), lane = tid & 63, fr = lane & 15, fq = lane >> 4;
    const float* lnw = INP(p, 19) + l * 512; const float* lnb = INP(p, 20) + l * 512;
    for (int item = bidx() * 8 + wave; item < 4096 + 256; item += gridDim.x * 8) {
        const bool smp = item >= 4096;
        int h, t0, it = 0, ntile;
        if (!smp) { const int tq = item & 3; it = item >> 2; const int b = it >> 9, c = (it >> 3) & 63; h = it & 7; t0 = b * 8192 + c * 128 + tq * 32; ntile = 2; }
        else { const int si = item - 4096; h = si & 7; t0 = T_P + (si >> 3) * 32; ntile = 2; }
        bf16x8 X[4][2];
        if (!smp) {
#pragma unroll
            for (int vt = 0; vt < 4; ++vt)
#pragma unroll
                for (int ks = 0; ks < 2; ++ks) { const float* sp = UC + (size_t)it * 4096 + (vt * 16 + fr) * 64 + ks * 32 + fq * 8; const float4 a = *(const float4*)sp, b4 = *(const float4*)(sp + 4);
                    u32x4 w; w.x = cvt_pk_bf16(a.x, a.y); w.y = cvt_pk_bf16(a.z, a.w); w.z = cvt_pk_bf16(b4.x, b4.y); w.w = cvt_pk_bf16(b4.z, b4.w); X[vt][ks] = __builtin_bit_cast(bf16x8, w); }
        }
        float gw[4][4], gb[4][4];
#pragma unroll
        for (int vt = 0; vt < 4; ++vt) { const float4 a = *(const float4*)(lnw + h * 64 + vt * 16 + 4 * fq), b4 = *(const float4*)(lnb + h * 64 + vt * 16 + 4 * fq);
            gw[vt][0] = a.x; gw[vt][1] = a.y; gw[vt][2] = a.z; gw[vt][3] = a.w; gb[vt][0] = b4.x; gb[vt][1] = b4.y; gb[vt][2] = b4.z; gb[vt][3] = b4.w; }
        for (int tt = 0; tt < ntile; ++tt) {
            const int t = t0 + tt * 16 + fr; const size_t ob = (size_t)t * 512 + h * 64;
            float y[4][4];
            u32x2 yw[4], vw[4], gg[4];
#pragma unroll
            for (int vt = 0; vt < 4; ++vt) { yw[vt] = *(const u32x2*)(YH + ob + vt * 16 + 4 * fq); vw[vt] = *(const u32x2*)(V + ob + vt * 16 + 4 * fq); gg[vt] = *(const u32x2*)(G + ob + vt * 16 + 4 * fq); }
            const float bn = bonus[(size_t)t * 8 + h];
            if (!smp) {
                const bf16x8 Y0 = *(const bf16x8*)(QH + ob + fq * 8), Y1 = *(const bf16x8*)(QH + ob + 32 + fq * 8);
#pragma unroll
                for (int vt = 0; vt < 4; ++vt) { f32x4 acc = (f32x4){0.f, 0.f, 0.f, 0.f};
                    acc = __builtin_amdgcn_mfma_f32_16x16x32_bf16(X[vt][0], Y0, acc, 0, 0, 0); acc = __builtin_amdgcn_mfma_f32_16x16x32_bf16(X[vt][1], Y1, acc, 0, 0, 0);
                    y[vt][0] = acc[0] + lo16(yw[vt].x); y[vt][1] = acc[1] + hi16(yw[vt].x); y[vt][2] = acc[2] + lo16(yw[vt].y); y[vt][3] = acc[3] + hi16(yw[vt].y); }
            } else {
#pragma unroll
                for (int vt = 0; vt < 4; ++vt) { y[vt][0] = lo16(yw[vt].x); y[vt][1] = hi16(yw[vt].x); y[vt][2] = lo16(yw[vt].y); y[vt][3] = hi16(yw[vt].y); }
            }
            float sm = 0.f;
#pragma unroll
            for (int vt = 0; vt < 4; ++vt) sm += (y[vt][0] + y[vt][1]) + (y[vt][2] + y[vt][3]);
            sm += __shfl_xor(sm, 16); sm += __shfl_xor(sm, 32);
            const float mean = sm * (1.0f / 64.0f); float sq = 0.f;
#pragma unroll
            for (int vt = 0; vt < 4; ++vt)
#pragma unroll
                for (int e = 0; e < 4; ++e) { y[vt][e] -= mean; sq += y[vt][e] * y[vt][e]; }
            sq += __shfl_xor(sq, 16); sq += __shfl_xor(sq, 32);
            const float rs = rsqrtf(sq * (1.0f / 64.0f) + 64e-5f);
#pragma unroll
            for (int vt = 0; vt < 4; ++vt) {
                const float vv[4] = {lo16(vw[vt].x), hi16(vw[vt].x), lo16(vw[vt].y), hi16(vw[vt].y)}, g4[4] = {lo16(gg[vt].x), hi16(gg[vt].x), lo16(gg[vt].y), hi16(gg[vt].y)};
                float o[4];
#pragma unroll
                for (int e = 0; e < 4; ++e) o[e] = (y[vt][e] * rs * gw[vt][e] + gb[vt][e] + bn * vv[e]) * g4[e];
                *(u32x2*)(YA + ob + vt * 16 + 4 * fq) = pack4(o[0], o[1], o[2], o[3]);
            }
        }
    }
}
__device__ __forceinline__ float lb_of(const Ctx& p, int l, int c) { if (l == 0) return 0.f; const float* z = INP(p, 21); const float z0 = z[c], z1 = z[512 + c]; return __builtin_amdgcn_rcpf(1.0f + __expf(z0 - z1)); }
__device__ __forceinline__ void hgrn_scan(const bf16_t* __restrict__ PH, int t0, int nsteps, int h, int half, int lane, float lbl, float lbh, f2 (&S)[64], float& cpl, float& cph, bf16_t* __restrict__ OH, float* __restrict__ ckp, LAS float* L) {
    const bf16_t* row = PH + (size_t)t0 * 2048 + h * 128 + lane;
    unsigned short q1[5], q2[5], q3[5];
    { const bf16_t* r = row; q1[0] = r[0]; q1[1] = r[64]; q1[2] = r[512]; q1[3] = r[576]; q1[4] = r[1024 + half * 64];
      r = row + 2048; q2[0] = r[0]; q2[1] = r[64]; q2[2] = r[512]; q2[3] = r[576]; q2[4] = r[1024 + half * 64];
      r = row + 4096; q3[0] = r[0]; q3[1] = r[64]; q3[2] = r[512]; q3[3] = r[576]; q3[4] = r[1024 + half * 64]; }
    const LAS f32x4* pf = (const LAS f32x4*)L;
#pragma unroll 1
    for (int s = 0; s < nsteps; ++s) {
        const float ql = bf2f(q1[0]), qh = bf2f(q1[1]), fzl = bf2f(q1[2]), fzh = bf2f(q1[3]), v = bf2f(q1[4]);
#pragma unroll
        for (int j = 0; j < 5; ++j) { q1[j] = q2[j]; q2[j] = q3[j]; }
        { const bf16_t* r = row + (size_t)(s + 3 < nsteps ? s + 3 : nsteps - 1) * 2048; q3[0] = r[0]; q3[1] = r[64]; q3[2] = r[512]; q3[3] = r[576]; q3[4] = r[1024 + half * 64]; }
        const float fl = lbl + (1.0f - lbl) * sigm(fzl), fh = lbh + (1.0f - lbh) * sigm(fzh);
        cpl *= fl; cph *= fh;
        if (ckp && (s & 31) == 31 && s < 127) { ckp[(s >> 5) * 128 + lane] = cpl; ckp[(s >> 5) * 128 + 64 + lane] = cph; }
        L[lane] = fl; L[64 + lane] = fh; L[128 + lane] = ql * sigm(ql); L[192 + lane] = qh * sigm(qh);
        f32x4 F[2][4], Q[2][4];
#pragma unroll
        for (int i = 0; i < 4; ++i) { F[0][i] = pf[i]; Q[0][i] = pf[32 + i]; }
        const f2 v2 = {v, v}; f2 o2 = {0.f, 0.f}, o3 = {0.f, 0.f};
#pragma unroll
        for (int g = 0; g < 8; ++g) {
            if (g < 7) {
#pragma unroll
                for (int i = 0; i < 4; ++i) { F[(g + 1) & 1][i] = pf[(g + 1) * 4 + i]; Q[(g + 1) & 1][i] = pf[32 + (g + 1) * 4 + i]; } }
            __builtin_amdgcn_sched_barrier(0);
#pragma unroll
            for (int i = 0; i < 4; ++i) {
                const f32x4 f4 = F[g & 1][i], q4 = Q[g & 1][i]; const int idx = (g * 4 + i) * 2;
                const f2 f01 = {f4[0], f4[1]}, f23 = {f4[2], f4[3]}, q01 = {q4[0], q4[1]}, q23 = {q4[2], q4[3]};
                S[idx] = pfma(f01, S[idx] - v2, v2); o2 = pfma(S[idx], q01, o2);
                S[idx + 1] = pfma(f23, S[idx + 1] - v2, v2); o3 = pfma(S[idx + 1], q23, o3);
            }
        }
        OH[(size_t)(t0 + s) * 512 + h * 128 + half * 64 + lane] = f2bf((o2[0] + o2[1]) + (o3[0] + o3[1]));
    }
}
__device__ void phase_hgrn_scan(const Ctx& p, int l, LAS unsigned char* lds) {
    unsigned char* ws = uptr(p.ws);
    const bf16_t* PH = (const bf16_t*)(ws + OFF_A); bf16_t* OH = (bf16_t*)(ws + OFF_B + 2 * SLOT); float* UCH = (float*)(ws + OFF_B + 3 * SLOT); float* PGH = (float*)(ws + OFF_SM + SM_PGH);
    float* PGC = (float*)(ws + OFF_B + 5 * SLOT);
    const int tid = tidx(); const int wave = __builtin_amdgcn_readfirstlane(tid >> 6), lane = tid & 63;
    LAS float* L = (LAS float*)(lds + wave * 4096);
    if (wave < 4) {
        for (int item = bidx() * 4 + wave; item < 1024; item += gridDim.x * 4) {
            const int half = item & 1, h = (item >> 1) & 3, c = (item >> 3) & 63, b = item >> 9, idx = item >> 1;
            f2 S[64];
#pragma unroll
            for (int k = 0; k < 64; ++k) S[k] = (f2){0.f, 0.f};
            float cpl = 1.f, cph = 1.f;
            hgrn_scan(PH, b * 8192 + c * 128, 128, h, half, lane, lb_of(p, l, h * 128 + lane), lb_of(p, l, h * 128 + 64 + lane), S, cpl, cph, OH, half == 0 ? PGC + (size_t)idx * 384 : nullptr, L);
            float* up = UCH + (size_t)idx * 16384 + half * 64 + lane;
#pragma unroll
            for (int k = 0; k < 64; ++k) { up[(2 * k) * 128] = S[k][0]; up[(2 * k + 1) * 128] = S[k][1]; }
            if (half == 0) { PGH[idx * 128 + lane] = cpl; PGH[idx * 128 + 64 + lane] = cph; }
        }
    } else if (wave == 4) {
        for (int item = bidx(); item < 256; item += gridDim.x) {
            const int half = item & 1, h = (item >> 1) & 3, s = item >> 3;
            const size_t so = (((size_t)l * 32 + s) * 4 + h) * 16384 + half * 64 + lane;
            f2 S[64];
            const float* stp = INP(p, 4) + so;
#pragma unroll
            for (int k = 0; k < 64; ++k) S[k] = (f2){stp[(2 * k) * 128], stp[(2 * k + 1) * 128]};
            float cpl = 1.f, cph = 1.f;
            hgrn_scan(PH, T_P + s * 32, 32, h, half, lane, lb_of(p, l, h * 128 + lane), lb_of(p, l, h * 128 + 64 + lane), S, cpl, cph, OH, nullptr, L);
#pragma unroll
            for (int k = 0; k < 64; ++k) { p.out[O_HGS + so + (2 * k) * 128] = S[k][0]; p.out[O_HGS + so + (2 * k + 1) * 128] = S[k][1]; }
        }
    }
}
__device__ void phase_hgrn_chain(const Ctx& p, int l) {
    unsigned char* ws = uptr(p.ws);
    float* UCH = (float*)(ws + OFF_B + 3 * SLOT); const float* PGH = (const float*)(ws + OFF_SM + SM_PGH);
    for (int gid = bidx() * 512 + tidx(); gid < 131072; gid += gridDim.x * 512) {
        const int b = gid >> 16, h = (gid >> 14) & 3, k = (gid >> 7) & 127, v = gid & 127;
        float s = 0.f;
        for (int c0 = 0; c0 < 64; c0 += 8) {
            float u[8], pg[8];
#pragma unroll
            for (int j = 0; j < 8; ++j) { const size_t idx = (size_t)(b * 64 + c0 + j) * 4 + h; u[j] = UCH[idx * 16384 + k * 128 + v]; pg[j] = PGH[idx * 128 + k]; }
#pragma unroll
            for (int j = 0; j < 8; ++j) { const size_t idx = (size_t)(b * 64 + c0 + j) * 4 + h; UCH[idx * 16384 + k * 128 + v] = s; s = fmaf(pg[j], s, u[j]); }
        }
        p.out[O_HGP + (((size_t)l * 2 + b) * 4 + h) * 16384 + k * 128 + v] = s;
    }
}
__device__ void phase_hgrn_fix(const Ctx& p, int l, LAS unsigned char* lds) {
    unsigned char* ws = uptr(p.ws);
    const bf16_t* PH = (const bf16_t*)(ws + OFF_A); const bf16_t* OH = (const bf16_t*)(ws + OFF_B + 2 * SLOT); const float* UCH = (const float*)(ws + OFF_B + 3 * SLOT);
    const float* PGC = (const float*)(ws + OFF_B + 5 * SLOT);
    bf16_t* YB = (bf16_t*)(ws + OFF_B + SLOT);
    const int tid = tidx(); const int wave = __builtin_amdgcn_readfirstlane(tid >> 6), lane = tid & 63, fr = lane & 15, fq = lane >> 4;
    const float* nw = INP(p, 22) + l * 512;
    constexpr int QS = 136;
    LAS bf16_t* QT = (LAS bf16_t*)(lds + wave * 16384);
    for (int item = bidx() * 8 + wave; item < 2048; item += gridDim.x * 8) {
        const int tq = item & 3, idx = item >> 2, h = idx & 3, c = (idx >> 2) & 63, b = idx >> 8;
        const float lbl = lb_of(p, l, h * 128 + lane), lbh = lb_of(p, l, h * 128 + 64 + lane);
        const int tbase = b * 8192 + c * 128 + tq * 32;
        float rl = 1.f, rh = 1.f;
        if (tq) { rl = PGC[(size_t)idx * 384 + (tq - 1) * 128 + lane]; rh = PGC[(size_t)idx * 384 + (tq - 1) * 128 + 64 + lane]; }
        const bf16_t* row = PH + (size_t)tbase * 2048 + h * 128 + lane;
#pragma unroll 1
        for (int t8 = 0; t8 < 32; t8 += 8) {
            unsigned short rq[8][4];
#pragma unroll
            for (int j = 0; j < 8; ++j) { const bf16_t* r = row + (size_t)(t8 + j) * 2048; rq[j][0] = r[0]; rq[j][1] = r[64]; rq[j][2] = r[512]; rq[j][3] = r[576]; }
#pragma unroll
            for (int j = 0; j < 8; ++j) {
                const float ql = bf2f(rq[j][0]), qh = bf2f(rq[j][1]);
                rl *= lbl + (1.0f - lbl) * sigm(bf2f(rq[j][2])); rh *= lbh + (1.0f - lbh) * sigm(bf2f(rq[j][3]));
                QT[(t8 + j) * QS + lane] = f2bf(ql * sigm(ql) * rl); QT[(t8 + j) * QS + 64 + lane] = f2bf(qh * sigm(qh) * rh);
            }
        }
        f32x4 acc[8][2];
        const float* sb = UCH + (size_t)idx * 16384 + fr;
#pragma unroll
        for (int vt = 0; vt < 8; ++vt) {
            acc[vt][0] = (f32x4){0.f, 0.f, 0.f, 0.f}; acc[vt][1] = (f32x4){0.f, 0.f, 0.f, 0.f};
#pragma unroll
            for (int ks = 0; ks < 4; ++ks) {
                const float* sp = sb + (size_t)(ks * 32 + fq * 8) * 128 + vt * 16;
                u32x4 w; w.x = cvt_pk_bf16(sp[0], sp[128]); w.y = cvt_pk_bf16(sp[256], sp[384]); w.z = cvt_pk_bf16(sp[512], sp[640]); w.w = cvt_pk_bf16(sp[768], sp[896]);
                const bf16x8 X = __builtin_bit_cast(bf16x8, w);
                acc[vt][0] = __builtin_amdgcn_mfma_f32_16x16x32_bf16(X, *(const LAS bf16x8*)(QT + fr * QS + ks * 32 + fq * 8), acc[vt][0], 0, 0, 0);
                acc[vt][1] = __builtin_amdgcn_mfma_f32_16x16x32_bf16(X, *(const LAS bf16x8*)(QT + (16 + fr) * QS + ks * 32 + fq * 8), acc[vt][1], 0, 0, 0);
            }
        }
#pragma unroll
        for (int tt = 0; tt < 2; ++tt) {
            const int t = tbase + tt * 16 + fr;
            const bf16_t* op = OH + (size_t)t * 512 + h * 128 + 4 * fq; const bf16_t* gp = PH + (size_t)t * 2048 + 1536 + h * 128 + 4 * fq;
            float o[8][4]; float ss = 0.f;
#pragma unroll
            for (int vt = 0; vt < 8; ++vt) { const u32x2 ow = *(const u32x2*)(op + vt * 16);
                o[vt][0] = acc[vt][tt][0] + lo16(ow.x); o[vt][1] = acc[vt][tt][1] + hi16(ow.x); o[vt][2] = acc[vt][tt][2] + lo16(ow.y); o[vt][3] = acc[vt][tt][3] + hi16(ow.y);
                ss += (o[vt][0] * o[vt][0] + o[vt][1] * o[vt][1]) + (o[vt][2] * o[vt][2] + o[vt][3] * o[vt][3]); }
            ss += __shfl_xor(ss, 16); ss += __shfl_xor(ss, 32);
            const float rs = rsqrtf(ss * (1.0f / 128.0f) + 1e-6f);
#pragma unroll
            for (int vt = 0; vt < 8; ++vt) { const u32x2 gw = *(const u32x2*)(gp + vt * 16); const float4 n4 = *(const float4*)(nw + h * 128 + vt * 16 + 4 * fq);
                const float g4[4] = {lo16(gw.x), hi16(gw.x), lo16(gw.y), hi16(gw.y)}, nn[4] = {n4.x, n4.y, n4.z, n4.w}; float r[4];
#pragma unroll
                for (int e = 0; e < 4; ++e) r[e] = o[vt][e] * rs * nn[e] * g4[e] * sigm(g4[e]);
                *(u32x2*)(YB + (size_t)t * 512 + h * 128 + vt * 16 + 4 * fq) = pack4(r[0], r[1], r[2], r[3]); }
        }
    }
    if (wave == 0) {
        for (int item = bidx(); item < 128; item += gridDim.x) {
            const int s = item >> 2, h = item & 3;
            const float nw0 = nw[h * 128 + lane], nw1 = nw[h * 128 + 64 + lane];
#pragma unroll 4
            for (int tt = 0; tt < 32; ++tt) {
                const int t = T_P + s * 32 + tt;
                const float o0 = bf2f(OH[(size_t)t * 512 + h * 128 + lane]), o1 = bf2f(OH[(size_t)t * 512 + h * 128 + 64 + lane]);
                const float g0 = bf2f(PH[(size_t)t * 2048 + 1536 + h * 128 + lane]), g1 = bf2f(PH[(size_t)t * 2048 + 1536 + h * 128 + 64 + lane]);
                const float rs = rsqrtf(wsum_fast(o0 * o0 + o1 * o1) * (1.0f / 128.0f) + 1e-6f);
                YB[(size_t)t * 512 + h * 128 + lane] = f2bf(o0 * rs * nw0 * g0 * sigm(g0));
                YB[(size_t)t * 512 + h * 128 + 64 + lane] = f2bf(o1 * rs * nw1 * g1 * sigm(g1));
            }
        }
    }
}
__device__ void phase_final(const Ctx& p) {
    const int tid = tidx(); const int wave = __builtin_amdgcn_readfirstlane(tid >> 6), lane = tid & 63;
    const float* nf = INP(p, 29); const float* PART = (const float*)(uptr(p.ws) + OFF_PART);
    for (int row = bidx() * 8 + wave; row < T_ALL; row += gridDim.x * 8) {
        float* xp = p.out + (size_t)row * 1024; float4 v[4]; float ss = 0.f;
#pragma unroll
        for (int i = 0; i < 4; ++i) { v[i] = *(const float4*)(xp + i * 256 + lane * 4);
            if (row >= T_P) { const float* pr = PART + (size_t)(row - T_P) * 1024 + i * 256 + lane * 4;
#pragma unroll
                for (int sl = 0; sl < 8; ++sl) { const float4 q = *(const float4*)(pr + (size_t)sl * 1024 * 1024); v[i].x += q.x; v[i].y += q.y; v[i].z += q.z; v[i].w += q.w; } }
            ss += v[i].x * v[i].x + v[i].y * v[i].y + v[i].z * v[i].z + v[i].w * v[i].w; }
        const float s = rsqrtf(wsum(ss) * (1.0f / 1024.0f) + 1e-6f);
#pragma unroll
        for (int i = 0; i < 4; ++i) { const int c = i * 256 + lane * 4; const float4 w = *(const float4*)(nf + c);
            v[i].x *= s * w.x; v[i].y *= s * w.y; v[i].z *= s * w.z; v[i].w *= s * w.w; *(float4*)(xp + c) = v[i]; }
    }
}
#define VRES 1
#define GEMM_PRO unsigned char* ws = uptr(p.ws); float* rowss = (float*)(ws + OFF_SM + SM_ROWSS); bf16_t* XB = (bf16_t*)(ws + OFF_XB); \
    const float* rs_mix = rowss + (size_t)(2 * l) * T_ALL; float* rs_ffn = rowss + (size_t)(2 * l + 1) * T_ALL; float* rs_next = rowss + (size_t)(2 * l + 2) * T_ALL; (void)rs_mix; (void)rs_ffn; (void)rs_next; (void)XB
__global__ void __launch_bounds__(512, 2) mega_fwd(Params prm) {
    extern __shared__ __attribute__((aligned(16))) unsigned char lds_raw[];
    LAS unsigned char* lds = (LAS unsigned char*)lds_raw;
    cg::grid_group grid = cg::this_grid();
    Ctx p; p.ws = prm.ws; p.out = prm.out;
    { unsigned long long* tb = (unsigned long long*)(prm.ws + OFF_SM + SM_TBL + (size_t)blockIdx.x * 256);
      if (threadIdx.x == 0) {
#define TB(i) tb[i] = (unsigned long long)prm.in[i];
          TB(0) TB(1) TB(2) TB(3) TB(4) TB(5) TB(6) TB(7) TB(8) TB(9) TB(10) TB(11) TB(12) TB(13) TB(14) TB(15) TB(16) TB(17) TB(18) TB(19) TB(20) TB(21) TB(22) TB(23) TB(24) TB(25) TB(26) TB(27) TB(28) TB(29)
#undef TB
      }
      __threadfence_block(); __syncthreads();
      p.tbl = tb; }
    volatile LAS unsigned* xst = (volatile LAS unsigned*)(lds + 131072);
    if (threadIdx.x < 2) xst[threadIdx.x] = 0u;
    __syncthreads();
    XcdBarrier xb = xcd_barrier_post((unsigned*)(prm.ws + OFF_SM + SM_BAR), xst);
    grid.sync();
    phase_x0(p);
#pragma unroll 1
    for (int ph = 0; ph < 28; ++ph) {
        const int l = ph >= 14 ? 1 : 0, k = ph - 14 * l;
        switch (k) {
        case 0: if (l == 1) { GEMM_PRO; finalize_sample(p, rowss + (size_t)2 * T_ALL); } phase_convert_early(p, l, lds); break;
        case 1: { GEMM_PRO; EpiBf<0> E; E.O = (bf16_t*)(ws + OFF_A); E.ldc = 2048; E.rowss = rs_mix; run_gemm(lds, XB, (const bf16_t*)(ws + OFF_WRW), 2048, 1024, E); } break;
        case 2: phase_prep(p, l, lds); break;
        case 3: phase_rwkv_scan(p, l, lds); break;
        case 4: phase_rwkv_chain(p, l); break;
        case 5: phase_rwkv_fix(p, l); break;
        case 6: { GEMM_PRO; EpiBf<0> E; E.O = (bf16_t*)(ws + OFF_A); E.ldc = 2048; E.rowss = rs_mix; run_gemm(lds, XB, (const bf16_t*)(ws + OFF_WHG), 2048, 1024, E); } break;
        case 7: phase_hgrn_scan(p, l, lds); break;
        case 8: phase_hgrn_chain(p, l); phase_convert_late(p, l, lds); break;
        case 9: phase_hgrn_fix(p, l, lds); break;
        case 10: {
            GEMM_PRO; bf16_t* TA = (bf16_t*)(ws + OFF_A); bf16_t* TB = (bf16_t*)(ws + OFF_A + 34 * MiB);
            { EpiBf<2> E; E.O = TA; E.ldc = 1024; E.rowss = nullptr; run_gemm(lds, (const bf16_t*)(ws + OFF_B), (const bf16_t*)(ws + OFF_WOA), 1024, 512, E); }
            { EpiGate<0> E; E.M = TA; E.Tm = TA; E.rowss = rs_mix; run_gemm(lds, XB, (const bf16_t*)(ws + OFF_WGA), 1024, 1024, E); }
            { EpiBf<2> E; E.O = TB; E.ldc = 1024; E.rowss = nullptr; run_gemm(lds, (const bf16_t*)(ws + OFF_B + SLOT), (const bf16_t*)(ws + OFF_WOB), 1024, 512, E); }
            { EpiGate<1> E; E.M = TA; E.Tm = TB; E.rowss = rs_mix; run_gemm(lds, XB, (const bf16_t*)(ws + OFF_WGB), 1024, 1024, E); }
        } break;
        case 11: { GEMM_PRO; EpiResid E; E.X = p.out; E.XB = XB; E.rowss_out = rs_ffn; run_gemm(lds, (const bf16_t*)(ws + OFF_A), (const bf16_t*)(ws + OFF_WO), 1024, 1024, E); } break;
        case 12: { GEMM_PRO; EpiBf<1> E; E.O = (bf16_t*)(ws + OFF_A); E.ldc = 4096; E.rowss = rs_ffn; run_gemm(lds, XB, (const bf16_t*)(ws + OFF_WUP), 4096, 1024, E); } break;
        default: { GEMM_PRO; EpiResid E; E.X = p.out; E.XB = XB; E.rowss_out = rs_next; run_ffn_down(lds, (const bf16_t*)(ws + OFF_A), (const bf16_t*)(ws + OFF_WDN), E, (float*)(ws + OFF_PART)); } break;
        }
        xcd_barrier(xb);
    }
    phase_final(p);
}

extern "C" void kernel_launch(void* const* d_in, const int* in_sizes, int n_in, void* d_out, int out_size, void* d_ws, size_t ws_size, hipStream_t stream) {
    constexpr int LDS_BYTES = 131072 + 64;
    static int grid_blocks = 0;
    if (grid_blocks == 0) {
        int dev = 0, cus = 0, per_cu = 0;
        hipGetDevice(&dev);
        hipDeviceGetAttribute(&cus, hipDeviceAttributeMultiprocessorCount, dev);
        hipFuncSetAttribute((const void*)mega_fwd, hipFuncAttributeMaxDynamicSharedMemorySize, LDS_BYTES);
        hipOccupancyMaxActiveBlocksPerMultiprocessor(&per_cu, (const void*)mega_fwd, 512, LDS_BYTES);
        if (per_cu < 1) per_cu = 1;
        grid_blocks = cus;
        if (n_in != 30 || ws_size < WS_NEED) { fprintf(stderr, "kernel_launch: unexpected n_in %d / ws_size %zu\n", n_in, ws_size); }
    }
    if (hipMemsetAsync((unsigned char*)d_ws + OFF_SM + SM_BAR, 0, XCD_BAR_WORDS * 4, stream) != hipSuccess) fprintf(stderr, "memset failed\n");
    Params p{};
    for (int i = 0; i < 30; ++i) p.in[i] = (const float*)d_in[i];
    p.out = (float*)d_out; p.ws = (unsigned char*)d_ws;
    void* args[] = {&p};
    hipError_t e = hipLaunchCooperativeKernel((const void*)mega_fwd, dim3(grid_blocks), dim3(512), args, LDS_BYTES, stream);
    if (e != hipSuccess) fprintf(stderr, "cooperative launch failed: %s (grid %d)\n", hipGetErrorString(e), grid_blocks);
}
```

```cpp
#include <hip/hip_runtime.h>
#include <hip/hip_cooperative_groups.h>
#include <cstdio>
namespace cg = cooperative_groups;
#define VRES 1
namespace pg8 {
#define PG8_LAS __attribute__((address_space(3)))
typedef unsigned short bf16_t;
typedef short bf16x8 __attribute__((ext_vector_type(8)));
typedef float f32x4 __attribute__((ext_vector_type(4)));
typedef unsigned u32x4 __attribute__((ext_vector_type(4)));
constexpr int BM = 256, BK = 64, HALF = 128, HTB = HALF * BK * 2  , STAGE_BYTES = 8 * HTB, NXCD = 8, WGM = 8;

__host__ __device__ __forceinline__ int lds_byte(int r, int c) { const int st = (r >> 4) * 2 + (c >> 5), rr = r & 15, cc = c & 31, ob = rr * 64 + cc * 2; return st * 1024 + (ob ^ (((ob >> 9) & 1) << 5)); }
__host__ __device__ __forceinline__ void stage_rc(int b, int& R, int& C) { const int st = b / 1024, sb = b % 1024, swz = sb ^ (((sb >> 9) & 1) << 5); R = (st >> 1) * 16 + swz / 64; C = (st & 1) * 32 + (swz % 64) / 2; }
__host__ __device__ __forceinline__ int perm32(int rho) { const int n = rho >> 4, i = rho & 15; return 8 * (i >> 2) + 4 * n + (i & 3); }

struct Unit { int pm, pn; };
struct Gemm { const bf16_t* A; const bf16_t* Bt; int M, N, K, ld; };

struct StaticOrder {
    int nM, nN, nwg, G, c;
    __host__ __device__ void init(int M, int N, int G_, int c_) { nM = M / BM; nN = N / BM; nwg = nM * nN; G = G_; c = c_; }
    __host__ __device__ bool next(int i, Unit& u) const {
        const long L = (long)i * G + c; if (L >= nwg) return false;
        int wgid = (int)L; { const int q = nwg / NXCD, r = nwg % NXCD, xcd = wgid % NXCD, off = wgid / NXCD; wgid = (xcd < r ? xcd * (q + 1) : r * (q + 1) + (xcd - r) * q) + off; }
        const int nig = WGM * nN, gid = wgid / nig, fm = gid * WGM, gsz = (nM - fm) < WGM ? (nM - fm) : WGM;
        u.pm = fm + ((wgid % nig) % gsz); u.pn = (wgid % nig) / gsz; return true;
    }
    __device__ __forceinline__ void a_ready(const Unit&) const {}
    __device__ __forceinline__ void done(const Unit&) const {}
};
typedef float f32x2_cv __attribute__((ext_vector_type(2)));
typedef __bf16 bf16x2_cv __attribute__((ext_vector_type(2)));
__device__ __forceinline__ unsigned cvt_pk_bf16(float lo, float hi) { const f32x2_cv v = {lo, hi}; const bf16x2_cv b = __builtin_convertvector(v, bf16x2_cv); return __builtin_bit_cast(unsigned, b); }
template <class Epi, class Sched, bool STAMP = false>
__device__ __forceinline__ void gemm_phase(PG8_LAS unsigned char* lds, const Gemm g, const Sched& S, const Epi& E, unsigned long long* stamps) {
    int tid_ = threadIdx.x; asm volatile("" : "+v"(tid_)); const int tid = tid_, wid = __builtin_amdgcn_readfirstlane(tid >> 6), lane = tid & 63, wr = wid >> 2, wc = wid & 3, fr = lane & 15, fq = lane >> 4;
    const int K = g.K, nt = K / BK, LD = g.ld;
    unsigned voffA[2], voffB[2];
#pragma unroll
    for (int i = 0; i < 2; ++i) { int R, C; stage_rc(tid * 16 + i * 8192, R, C); const int Rb = Epi::PERM ? ((R & ~31) + perm32(R & 31)) : R;
        voffA[i] = (unsigned)(R * LD + C) * 2u; voffB[i] = (unsigned)(Rb * LD + C) * 2u; }
    const size_t kstep = (size_t)(BK * 2);
    const size_t hstep = (size_t)HALF * LD * 2;
    const size_t tstep = 2 * hstep;
    const unsigned ldsw = (unsigned)wid * 1024u;
    const int aoff = lds_byte(wr * 64 + fr, fq * 8), boff = lds_byte(wc * 32 + fr, fq * 8);
#define PG8_SA(b, h) (((b) * 2 + (h)) * HTB)
#define PG8_SB(b, h) ((4 + (b) * 2 + (h)) * HTB)
#define PG8_STAGE(bufoff, gbase, voff) do { _Pragma("unroll") for (int _i = 0; _i < 2; ++_i) \
        __builtin_amdgcn_global_load_lds((const unsigned*)((const char*)(gbase) + (voff)[_i]), (PG8_LAS unsigned*)(lds + (bufoff) + ldsw + _i * 8192), 16, 0, 0); } while (0)
#define PG8_LDA(dst, b, h) do { _Pragma("unroll") for (int m = 0; m < 4; ++m) _Pragma("unroll") for (int k = 0; k < 2; ++k) dst[m][k] = *(const PG8_LAS bf16x8*)(lds + PG8_SA(b, h) + aoff + m * 2048 + k * 1024); } while (0)
#define PG8_LDB(dst, b, h) do { _Pragma("unroll") for (int n = 0; n < 2; ++n) _Pragma("unroll") for (int k = 0; k < 2; ++k) dst[n][k] = *(const PG8_LAS bf16x8*)(lds + PG8_SB(b, h) + boff + n * 2048 + k * 1024); } while (0)
#define PG8_MMA(ai, bj, At, Bt) do { __builtin_amdgcn_s_setprio(1); _Pragma("unroll") for (int m = 0; m < 4; ++m) _Pragma("unroll") for (int n = 0; n < 2; ++n) _Pragma("unroll") for (int k = 0; k < 2; ++k) \
        acc[ai][bj][m][n] = __builtin_amdgcn_mfma_f32_16x16x32_bf16(Bt[n][k], At[m][k], acc[ai][bj][m][n], 0, 0, 0); __builtin_amdgcn_s_setprio(0); } while (0)
#define PG8_WAIT_V(n) asm volatile("s_waitcnt vmcnt(" #n ")" ::: "memory")
#define PG8_WAIT_L(n) asm volatile("s_waitcnt lgkmcnt(" #n ")" ::: "memory")
#define PG8_BAR __builtin_amdgcn_s_barrier()
#define PG8_SCHED __builtin_amdgcn_sched_barrier(0)
    Unit cur, nxt; int ui = 0;
    if (!S.next(0, cur)) return;
    f32x4 acc[2][2][4][2];
#pragma unroll
    for (int a = 0; a < 2; ++a)
#pragma unroll
        for (int b = 0; b < 2; ++b)
#pragma unroll
            for (int m = 0; m < 4; ++m)
#pragma unroll
                for (int n = 0; n < 2; ++n) acc[a][b][m][n] = (f32x4){0.f, 0.f, 0.f, 0.f};
    bf16x8 At[4][2], B0[2][2], B1[2][2];
    const char* cA = (const char*)g.A + (size_t)cur.pm * tstep; const char* cB = (const char*)g.Bt + (size_t)cur.pn * tstep;
    S.a_ready(cur);
    PG8_STAGE(PG8_SB(0, 0), cB, voffB); PG8_STAGE(PG8_SA(0, 0), cA, voffA); PG8_STAGE(PG8_SB(0, 1), cB + hstep, voffB); PG8_STAGE(PG8_SA(0, 1), cA + hstep, voffA);
    if (wr == 1) PG8_BAR;
    PG8_WAIT_V(4); PG8_BAR;
    PG8_STAGE(PG8_SB(1, 0), cB + kstep, voffB); PG8_STAGE(PG8_SA(1, 0), cA + kstep, voffA); PG8_STAGE(PG8_SB(1, 1), cB + hstep + kstep, voffB);
    PG8_WAIT_V(6); PG8_BAR;
    for (;;) {
        const bool has_next = S.next(ui + 1, nxt);
        const char* nA = has_next ? (const char*)g.A + (size_t)nxt.pm * tstep : cA; const char* nB = has_next ? (const char*)g.Bt + (size_t)nxt.pn * tstep : cB;
        for (int t = 0; t < nt; t += 2) {
            const bool last = (t == nt - 2);
            const char* a1 = cA + (size_t)(t + 1) * kstep;
            const char* a2 = last ? nA : cA + (size_t)(t + 2) * kstep; const char* b2 = last ? nB : cB + (size_t)(t + 2) * kstep;
            const char* a3 = a2 + kstep; const char* b3 = b2 + kstep;
            if (last && has_next) S.a_ready(nxt);
            PG8_LDB(B0, 0, 0); PG8_SCHED; PG8_LDA(At, 0, 0); PG8_STAGE(PG8_SA(1, 1), a1 + hstep, voffA);
            PG8_WAIT_L(8); PG8_BAR; PG8_WAIT_L(0); PG8_MMA(0, 0, At, B0); PG8_BAR; PG8_SCHED;
            PG8_LDB(B1, 0, 1); PG8_STAGE(PG8_SB(0, 0), b2, voffB);
            PG8_BAR; PG8_WAIT_L(0); PG8_MMA(0, 1, At, B1); PG8_BAR;
            PG8_LDA(At, 0, 1); PG8_STAGE(PG8_SA(0, 0), a2, voffA);
            PG8_BAR; PG8_WAIT_L(0); PG8_MMA(1, 0, At, B0); PG8_BAR; PG8_SCHED;
            PG8_STAGE(PG8_SB(0, 1), b2 + hstep, voffB);
            PG8_WAIT_V(6); PG8_BAR; PG8_MMA(1, 1, At, B1); PG8_BAR;
            PG8_LDB(B0, 1, 0); PG8_SCHED; PG8_LDA(At, 1, 0); PG8_STAGE(PG8_SA(0, 1), a2 + hstep, voffA);
            PG8_WAIT_L(8); PG8_BAR; PG8_WAIT_L(0); PG8_MMA(0, 0, At, B0); PG8_BAR; PG8_SCHED;
            PG8_LDB(B1, 1, 1); PG8_STAGE(PG8_SB(1, 0), b3, voffB);
            PG8_BAR; PG8_WAIT_L(0); PG8_MMA(0, 1, At, B1); PG8_BAR;
            PG8_LDA(At, 1, 1); PG8_STAGE(PG8_SA(1, 0), a3, voffA);
            PG8_BAR; PG8_WAIT_L(0); PG8_MMA(1, 0, At, B0); PG8_BAR; PG8_SCHED;
            PG8_STAGE(PG8_SB(1, 1), b3 + hstep, voffB);
            PG8_WAIT_V(6); PG8_BAR; PG8_MMA(1, 1, At, B1); PG8_BAR;
        }
        if constexpr (!Epi::AFTER_DRAIN) { E(acc, cur, wr, wc, fr, fq); S.done(cur); }
        if (!has_next) break;
#pragma unroll
        for (int a = 0; a < 2; ++a)
#pragma unroll
            for (int b = 0; b < 2; ++b)
#pragma unroll
                for (int m = 0; m < 4; ++m)
#pragma unroll
                    for (int n = 0; n < 2; ++n) acc[a][b][m][n] = (f32x4){0.f, 0.f, 0.f, 0.f};
        cur = nxt; cA = nA; cB = nB; ++ui;
    }
    PG8_WAIT_V(0);
    if (wr == 0) PG8_BAR;
    PG8_BAR;
    if constexpr (Epi::AFTER_DRAIN) { E.fused(acc, cur, wr, wc, fr, fq, lds, wid, lane); S.done(cur); }
#undef PG8_SA
#undef PG8_SB
#undef PG8_STAGE
#undef PG8_LDA
#undef PG8_LDB
#undef PG8_MMA
#undef PG8_WAIT_V
#undef PG8_WAIT_L
#undef PG8_BAR
#undef PG8_SCHED
}
}
using pg8::bf16_t; using pg8::bf16x8; using pg8::f32x4; using pg8::u32x4; using pg8::cvt_pk_bf16;
typedef unsigned u32x2 __attribute__((ext_vector_type(2)));
#define LAS PG8_LAS

constexpr int T_ALL = 17408, T_P = 16384;
constexpr size_t MiB = (size_t)1 << 20;
constexpr size_t OFF_WRW = 0, OFF_WHG = 4 * MiB, OFF_WGA = 8 * MiB, OFF_WGB = 10 * MiB, OFF_WOA = 12 * MiB, OFF_WOB = 13 * MiB, OFF_WO = 14 * MiB, OFF_WUP = 16 * MiB, OFF_WDN = 24 * MiB;
constexpr size_t OFF_G = 8 * MiB;
constexpr size_t OFF_SM = 32 * MiB;
constexpr size_t SM_W2T = 0, SM_A2T = 65536, SM_G2T = 131072, SM_V1T = 294912, SM_V2T = 327680, SM_ROWSS = 393216, SM_BONUS = 786432, SM_PGH = 1376256;
constexpr size_t OFF_XB = 34 * MiB, OFF_V0 = 68 * MiB, OFF_A = 85 * MiB, OFF_B = 153 * MiB, SLOT = 17 * MiB;
constexpr size_t WS_NEED = 255 * MiB;
constexpr size_t O_SHP = 17825792, O_RWP = 17833088, O_HGP = 17964160, O_SHS = 18226304, O_RWS = 18343040, O_HGS = 20440192;

__device__ __forceinline__ int tidx() { int t = threadIdx.x; asm volatile("" : "+v"(t)); return t; }
__device__ __forceinline__ int bidx() { int b = blockIdx.x; asm volatile("" : "+s"(b)); return b; }
#define GAS __attribute__((address_space(1)))
__device__ __forceinline__ unsigned char* uptr(unsigned char* q) {
    const unsigned long long v = (unsigned long long)q; unsigned lo = __builtin_amdgcn_readfirstlane((unsigned)v), hi = __builtin_amdgcn_readfirstlane((unsigned)(v >> 32));
    asm volatile("" : "+s"(lo), "+s"(hi));
    return (unsigned char*)(GAS unsigned char*)(((unsigned long long)hi << 32) | lo); }
struct Params { const float* in[30]; float* out; unsigned char* ws; };
struct Ctx { unsigned char* ws; float* out; const unsigned long long* tbl; };
__device__ __forceinline__ const float* ldp(const unsigned long long* tbl, int i) {
    const unsigned long long v = *(const volatile unsigned long long*)(tbl + i);
    const unsigned lo = __builtin_amdgcn_readfirstlane((unsigned)v), hi = __builtin_amdgcn_readfirstlane((unsigned)(v >> 32));
    return (const float*)(GAS const float*)(((unsigned long long)hi << 32) | lo); }
#define INP(p, i) ldp((p).tbl, i)
constexpr size_t SM_TBL = 1703936, SM_BAR = 1769472;
#define XB_TMO      128
#define XB_XCNT(j)  (256  + 64 * (j))
#define XB_XSUB(j)  (1280 + 64 * (j))
#define XB_XGEN(j)  (2304 + 64 * (j))
#define XB_TOP      3328
#define XB_TOPGEN   3392
#define XCD_BAR_WORDS 3456
#define XB_SPIN_CAP (1u << 18)

__device__ __forceinline__ unsigned xb_ld(unsigned* p)              { return __hip_atomic_load(p, __ATOMIC_RELAXED, __HIP_MEMORY_SCOPE_AGENT); }
__device__ __forceinline__ unsigned xb_add(unsigned* p, unsigned v) { return __hip_atomic_fetch_add(p, v, __ATOMIC_RELAXED, __HIP_MEMORY_SCOPE_AGENT); }
__device__ __forceinline__ unsigned xb_xcc_id() { return (unsigned)__builtin_amdgcn_s_getreg((3 << 11) | 20) & 0xFu; }
#define XB_SPIN(cond, bar) do { unsigned _sp = 0; while (cond) { __builtin_amdgcn_s_sleep(1); \
    if ((++_sp & 255u) == 0u) { if (xb_ld(&(bar)[XB_TMO])) break; if (_sp > XB_SPIN_CAP) { atomicAdd(&(bar)[XB_TMO], 1u); break; } } } } while (0)

struct XcdBarrier {
    unsigned* bar; unsigned x;
    volatile LAS unsigned* st;
};

__device__ __forceinline__ XcdBarrier xcd_barrier_post(unsigned* bar, volatile LAS unsigned* st) {
    XcdBarrier b; b.bar = bar; b.x = xb_xcc_id(); b.st = st;
    if (threadIdx.x == 0) (void)xb_add(&bar[XB_XCNT(b.x)], 1u);
    return b;
}
__device__ __forceinline__ void xcd_barrier_complete(unsigned* bar, unsigned x, unsigned& nloc, unsigned& nx) {
    const unsigned G = gridDim.x * gridDim.y * gridDim.z;
    unsigned sum, cnt, mine, sp = 0u;
    for (;;) {
        sum = 0u; cnt = 0u; mine = 0u;
#pragma unroll
        for (unsigned j = 0; j < 16; ++j) { const unsigned c = xb_ld(&bar[XB_XCNT(j)]); sum += c; cnt += (c > 0u) ? 1u : 0u; mine = (j == x) ? c : mine; }
        if (sum == G) break;
        __builtin_amdgcn_s_sleep(1);
        if ((++sp & 255u) == 0u) { if (xb_ld(&bar[XB_TMO])) break; if (sp > XB_SPIN_CAP) { atomicAdd(&bar[XB_TMO], 1u); break; } }
    }
    nloc = mine > 0u ? mine : 1u; nx = cnt > 0u ? cnt : 1u;
}

__device__ __forceinline__ void xcd_barrier(const XcdBarrier& b) {
    asm volatile("s_waitcnt vmcnt(0)" ::: "memory");
    __syncthreads();
    if (threadIdx.x == 0) {
        unsigned* bar = b.bar;
        __builtin_amdgcn_s_waitcnt(0);
        unsigned nloc = b.st[0], nx = b.st[1];
        if (nloc == 0u) { xcd_barrier_complete(bar, b.x, nloc, nx); b.st[0] = nloc; b.st[1] = nx; }
        const unsigned old = xb_add(&bar[XB_XSUB(b.x)], 1u);
        const unsigned gen = old / nloc;
        if (old + 1u == (gen + 1u) * nloc) {
            __builtin_amdgcn_fence(__ATOMIC_RELEASE, "agent");
            asm volatile("s_waitcnt vmcnt(0)" ::: "memory");
            const unsigned og = xb_add(&bar[XB_TOP], 1u);
            const unsigned tg = og / nx;
            if (og + 1u == (tg + 1u) * nx) xb_add(&bar[XB_TOPGEN], 1u);
            else XB_SPIN(xb_ld(&bar[XB_TOPGEN]) == tg, bar);
            __builtin_amdgcn_fence(__ATOMIC_ACQUIRE, "agent");
            xb_add(&bar[XB_XGEN(b.x)], 1u);
            asm volatile("s_waitcnt vmcnt(0)" ::: "memory");
        } else {
            XB_SPIN(xb_ld(&bar[XB_XGEN(b.x)]) == gen, bar);
            __builtin_amdgcn_fence(__ATOMIC_ACQUIRE, "agent");
            asm volatile("s_waitcnt vmcnt(0)" ::: "memory");
        }
    }
    __syncthreads();
}


__device__ __forceinline__ float bf2f(unsigned short b) { return __uint_as_float((unsigned)b << 16); }
__device__ __forceinline__ unsigned short f2bf(float f) { unsigned u = __float_as_uint(f); u += 0x7FFFu + ((u >> 16) & 1u); return (unsigned short)(u >> 16); }
__device__ __forceinline__ float sigm(float x) { return __builtin_amdgcn_rcpf(1.0f + __expf(-x)); }
__device__ __forceinline__ float tanh_fast(float x) { return 1.0f - 2.0f * __builtin_amdgcn_rcpf(1.0f + __expf(2.0f * x)); }
__device__ __forceinline__ float rdl(float x, int i) { return __uint_as_float(__builtin_amdgcn_readlane(__float_as_uint(x), i)); }
__device__ __forceinline__ float wsum(float x) {
#pragma unroll
    for (int o = 32; o; o >>= 1) x += __shfl_xor(x, o);
    return x; }
__device__ __forceinline__ float lo16(unsigned w) { return __uint_as_float(w << 16); }
__device__ __forceinline__ float hi16(unsigned w) { return __uint_as_float(w & 0xffff0000u); }
__device__ __forceinline__ float rstd_of(const float* rowss, int row) { return rsqrtf(rowss[row] * (1.0f / 1024.0f) + 1e-6f); }

template <int MODE> struct EpiBf {
    static constexpr bool PERM = true, AFTER_DRAIN = false;
    bf16_t* O; int ldc; const float* rowss;
    __device__ __forceinline__ void operator()(const f32x4 (&acc)[2][2][4][2], const pg8::Unit& u, int wr, int wc, int fr, int fq) const {
        const int row0 = u.pm * 256 + wr * 64 + fr, col0 = u.pn * 256 + wc * 32 + 8 * fq;
#pragma unroll
        for (int ai = 0; ai < 2; ++ai)
#pragma unroll
            for (int m = 0; m < 4; ++m) {
                const int row = row0 + ai * 128 + m * 16;
                const float s = (MODE == 2) ? 1.0f : rstd_of(rowss, row);
                bf16_t* rowp = O + (size_t)row * ldc + col0;
#pragma unroll
                for (int bj = 0; bj < 2; ++bj) {
                    f32x4 v0 = acc[ai][bj][m][0] * s, v1 = acc[ai][bj][m][1] * s;
                    if (MODE == 1) {
#pragma unroll
                        for (int j = 0; j < 4; ++j) { const float a = fmaxf(v0[j], 0.f), b = fmaxf(v1[j], 0.f); v0[j] = a * a; v1[j] = b * b; } }
                    u32x4 w; w.x = cvt_pk_bf16(v0[0], v0[1]); w.y = cvt_pk_bf16(v0[2], v0[3]); w.z = cvt_pk_bf16(v1[0], v1[1]); w.w = cvt_pk_bf16(v1[2], v1[3]);
                    *(u32x4*)(rowp + bj * 128) = w; } }
    }
};
template <int ACC> struct EpiGate {
    static constexpr bool PERM = true, AFTER_DRAIN = false;
    bf16_t* M; const bf16_t* Tm; const float* rowss;
    __device__ __forceinline__ void operator()(const f32x4 (&acc)[2][2][4][2], const pg8::Unit& u, int wr, int wc, int fr, int fq) const {
        const int row0 = u.pm * 256 + wr * 64 + fr, col0 = u.pn * 256 + wc * 32 + 8 * fq;
#pragma unroll
        for (int ai = 0; ai < 2; ++ai)
#pragma unroll
            for (int m = 0; m < 4; ++m) {
                const int row = row0 + ai * 128 + m * 16;
                const float s = rstd_of(rowss, row);
#pragma unroll
                for (int bj = 0; bj < 2; ++bj) {
                    const size_t off = (size_t)row * 1024 + col0 + bj * 128;
                    const u32x4 tv = *(const u32x4*)(Tm + off);
                    u32x4 pv = (u32x4){0u, 0u, 0u, 0u};
                    if (ACC) pv = *(const u32x4*)(M + off);
                    const f32x4 a0 = acc[ai][bj][m][0] * s, a1 = acc[ai][bj][m][1] * s;
                    float o[8];
                    o[0] = sigm(a0[0]) * lo16(tv.x); o[1] = sigm(a0[1]) * hi16(tv.x); o[2] = sigm(a0[2]) * lo16(tv.y); o[3] = sigm(a0[3]) * hi16(tv.y);
                    o[4] = sigm(a1[0]) * lo16(tv.z); o[5] = sigm(a1[1]) * hi16(tv.z); o[6] = sigm(a1[2]) * lo16(tv.w); o[7] = sigm(a1[3]) * hi16(tv.w);
                    if (ACC) { o[0] += lo16(pv.x); o[1] += hi16(pv.x); o[2] += lo16(pv.y); o[3] += hi16(pv.y); o[4] += lo16(pv.z); o[5] += hi16(pv.z); o[6] += lo16(pv.w); o[7] += hi16(pv.w); }
                    u32x4 w; w.x = cvt_pk_bf16(o[0], o[1]); w.y = cvt_pk_bf16(o[2], o[3]); w.z = cvt_pk_bf16(o[4], o[5]); w.w = cvt_pk_bf16(o[6], o[7]);
                    *(u32x4*)(M + off) = w; } }
    }
};
struct EpiResid {
    static constexpr bool PERM = false, AFTER_DRAIN = false;
    float* X; bf16_t* XB; float* rowss_out; const float* Xp0; const float* Xs0;
    __device__ __forceinline__ void operator()(const f32x4 (&acc)[2][2][4][2], const pg8::Unit& u, int wr, int wc, int fr, int fq) const {
        const int row0 = u.pm * 256 + wr * 64 + fr, col0 = u.pn * 256 + wc * 32 + 4 * fq;
#pragma unroll
        for (int ai = 0; ai < 2; ++ai)
#pragma unroll
            for (int m = 0; m < 4; ++m) {
                const int row = row0 + ai * 128 + m * 16;
                float* xp = X + (size_t)row * 1024 + col0; bf16_t* bp = XB + (size_t)row * 1024 + col0;
                const float* xi = Xp0 ? (row < T_P ? Xp0 + (size_t)row * 1024 + col0 : Xs0 + (size_t)(row - T_P) * 1024 + col0) : xp;
                float ss = 0.f;
#pragma unroll
                for (int bj = 0; bj < 2; ++bj)
#pragma unroll
                    for (int n = 0; n < 2; ++n) {
                        f32x4 xv = *(const f32x4*)(xi + bj * 128 + n * 16) + acc[ai][bj][m][n];
                        *(f32x4*)(xp + bj * 128 + n * 16) = xv;
                        ss += (xv[0] * xv[0] + xv[1] * xv[1]) + (xv[2] * xv[2] + xv[3] * xv[3]);
                        u32x2 w; w.x = cvt_pk_bf16(xv[0], xv[1]); w.y = cvt_pk_bf16(xv[2], xv[3]);
                        *(u32x2*)(bp + bj * 128 + n * 16) = w; }
                ss += __shfl_xor(ss, 16); ss += __shfl_xor(ss, 32);
                if (fq == 0) atomicAdd(rowss_out + row, ss); }
    }
};
template <class Epi> __device__ __forceinline__ void run_gemm(LAS unsigned char* lds, const bf16_t* A, const bf16_t* Bt, int N, int K, const Epi& E) {
    pg8::StaticOrder S; S.init(T_ALL, N, (int)gridDim.x, bidx());
    pg8::Gemm g; g.A = A; g.Bt = Bt; g.M = T_ALL; g.N = N; g.K = K; g.ld = K;
    pg8::gemm_phase<Epi, pg8::StaticOrder, false>(lds, g, S, E, nullptr);
}


struct OneUnit { int pm, pn, valid;
    __device__ bool next(int i, pg8::Unit& u) const { if (i != 0 || !valid) return false; u.pm = pm; u.pn = pn; return true; }
    __device__ __forceinline__ void a_ready(const pg8::Unit&) const {}
    __device__ __forceinline__ void done(const pg8::Unit&) const {} };
struct EpiPartial {
    static constexpr bool PERM = false, AFTER_DRAIN = false;
    float* PART;
    __device__ __forceinline__ void operator()(const f32x4 (&acc)[2][2][4][2], const pg8::Unit& u, int wr, int wc, int fr, int fq) const {
        const int row0 = (u.pm - 64) * 256 + wr * 64 + fr, col0 = u.pn * 256 + wc * 32 + 4 * fq;
#pragma unroll
        for (int ai = 0; ai < 2; ++ai)
#pragma unroll
            for (int m = 0; m < 4; ++m) { float* xp = PART + (size_t)(row0 + ai * 128 + m * 16) * 1024 + col0;
#pragma unroll
                for (int bj = 0; bj < 2; ++bj)
#pragma unroll
                    for (int n = 0; n < 2; ++n) *(f32x4*)(xp + bj * 128 + n * 16) = acc[ai][bj][m][n]; }
    }
};
constexpr size_t OFF_PART = OFF_B + 4 * SLOT;
__device__ __forceinline__ void run_ffn_down(LAS unsigned char* lds, const bf16_t* HID, const bf16_t* WDN, const EpiResid& E, float* PART) {
    { pg8::StaticOrder S; S.init(T_P, 1024, (int)gridDim.x, bidx());
      pg8::Gemm g; g.A = HID; g.Bt = WDN; g.M = T_P; g.N = 1024; g.K = 4096; g.ld = 4096;
      pg8::gemm_phase<EpiResid, pg8::StaticOrder, false>(lds, g, S, E, nullptr); }
    { const int t = bidx(); OneUnit S; S.valid = t < 128; const int sl = t & 7, u = (t >> 3) & 15; S.pm = 64 + (u >> 2); S.pn = u & 3;
      pg8::Gemm g; g.A = HID + sl * 512; g.Bt = WDN + sl * 512; g.M = T_ALL; g.N = 1024; g.K = 512; g.ld = 4096;
      EpiPartial EA; EA.PART = PART + (size_t)sl * 1024 * 1024;
      pg8::gemm_phase<EpiPartial, OneUnit, false>(lds, g, S, EA, nullptr); }
}
__device__ void finalize_sample(const Ctx& p, float* rowss_out) {
    unsigned char* ws = uptr(p.ws); bf16_t* XB = (bf16_t*)(ws + OFF_XB); const float* PART = (const float*)(ws + OFF_PART);
    const int tid = tidx(); const int wave = __builtin_amdgcn_readfirstlane(tid >> 6), lane = tid & 63;
    for (int row = T_P + bidx() * 8 + wave; row < T_ALL; row += gridDim.x * 8) {
        float* src = p.out + (size_t)row * 1024; const float* pr = PART + (size_t)(row - T_P) * 1024; float ss = 0.f;
#pragma unroll
        for (int i = 0; i < 4; ++i) { const int c = i * 256 + lane * 4; float4 v = *(const float4*)(src + c);
#pragma unroll
            for (int sl = 0; sl < 8; ++sl) { const float4 q = *(const float4*)(pr + (size_t)sl * 1024 * 1024 + c); v.x += q.x; v.y += q.y; v.z += q.z; v.w += q.w; }
            *(float4*)(src + c) = v;
            ss += v.x * v.x + v.y * v.y + v.z * v.z + v.w * v.w; u32x2 w; w.x = cvt_pk_bf16(v.x, v.y); w.y = cvt_pk_bf16(v.z, v.w); *(u32x2*)(XB + (size_t)row * 1024 + c) = w; }
        ss = wsum(ss); if (lane == 0) rowss_out[row] = ss;
    }
}
__device__ void conv_T(const float* __restrict__ src, int ld, int s0, int cnt, int K, const float* __restrict__ scale, bf16_t* __restrict__ dst, int d0, LAS unsigned char* lds, int vb, int nvb) {
    LAS float* ts = (LAS float*)lds;
    const int tid = tidx(); const int nkt = K / 256, ntile = (cnt / 32) * nkt;
    if (vb < 0) return;
    for (int tile = vb; tile < ntile; tile += nvb) {
        const int n0 = (tile / nkt) * 32, k0 = (tile % nkt) * 256;
        { const int kk = tid >> 3, nq = tid & 7; float4 v[4]; float sc[4];
#pragma unroll
          for (int r = 0; r < 4; ++r) { v[r] = *(const float4*)(src + (size_t)(k0 + r * 64 + kk) * ld + s0 + n0 + nq * 4); sc[r] = scale ? scale[k0 + r * 64 + kk] : 1.0f; }
#pragma unroll
          for (int r = 0; r < 4; ++r) { LAS float* q = ts + (nq * 4) * 257 + r * 64 + kk; q[0] = v[r].x * sc[r]; q[257] = v[r].y * sc[r]; q[514] = v[r].z * sc[r]; q[771] = v[r].w * sc[r]; } }
        __syncthreads();
        { const int n = tid >> 4, kq = tid & 15;
#pragma unroll
          for (int r = 0; r < 4; ++r) { const LAS float* q = ts + n * 257 + r * 64 + kq * 4; u32x2 w; w.x = cvt_pk_bf16(q[0], q[1]); w.y = cvt_pk_bf16(q[2], q[3]);
            *(u32x2*)(dst + (size_t)(d0 + n0 + n) * K + k0 + r * 64 + kq * 4) = w; } }
        __syncthreads();
    }
}
__device__ void conv_small(const float* __restrict__ src, int ld, int cnt, int K, bf16_t* __restrict__ dst, int vb, int nvb) {
    if (vb < 0) return;
    for (int i = vb * 512 + tidx(); i < cnt * K; i += nvb * 512) { const int c = i / K, j = i % K; dst[i] = f2bf(src[(size_t)j * ld + c]); }
}
__device__ void phase_convert_early(const Ctx& p, int l, LAS unsigned char* lds, int vb, int nvb) {
    unsigned char* ws = uptr(p.ws);
    const float* win = INP(p, 6) + (size_t)l * 1024 * 5920; const float* nm = INP(p, 5) + l * 1024;
    conv_T(win, 5920, 0, 1824, 1024, nm, (bf16_t*)(ws + OFF_WRW), 0, lds, vb, nvb);
    { u32x4* z = (u32x4*)(ws + OFF_WRW + (size_t)1824 * 1024 * 2); const int n = 224 * 1024 * 2 / 16;
      unsigned zz = 0u; asm volatile("" : "+v"(zz));
      if (vb >= 0) for (int i = vb * 512 + tidx(); i < n; i += nvb * 512) z[i] = (u32x4){zz, zz, zz, zz}; }
    conv_T(win, 5920, 1824, 2048, 1024, nm, (bf16_t*)(ws + OFF_WHG), 0, lds, vb, nvb);
    conv_small(INP(p, 9) + (size_t)l * 64 * 512, 512, 512, 64, (bf16_t*)(ws + OFF_SM + SM_W2T), vb, nvb);
    conv_small(INP(p, 11) + (size_t)l * 64 * 512, 512, 512, 64, (bf16_t*)(ws + OFF_SM + SM_A2T), vb, nvb);
    conv_small(INP(p, 12) + (size_t)l * 160 * 512, 512, 512, 160, (bf16_t*)(ws + OFF_SM + SM_G2T), vb, nvb);
    if (l == 1) {
        conv_small(INP(p, 14), 32, 32, 512, (bf16_t*)(ws + OFF_SM + SM_V1T), vb, nvb);
        conv_small(INP(p, 15), 512, 512, 32, (bf16_t*)(ws + OFF_SM + SM_V2T), vb, nvb);
    }
}
__device__ void phase_convert_late(const Ctx& p, int l, LAS unsigned char* lds, int vb, int nvb) {
    unsigned char* ws = uptr(p.ws);
    const float* win = INP(p, 6) + (size_t)l * 1024 * 5920; const float* nm = INP(p, 5) + l * 1024;
    conv_T(win, 5920, 3872, 1024, 1024, nm, (bf16_t*)(ws + OFF_WGA), 0, lds, vb, nvb);
    conv_T(win, 5920, 4896, 1024, 1024, nm, (bf16_t*)(ws + OFF_WGB), 0, lds, vb, nvb);
    conv_T(INP(p, 23) + (size_t)l * 512 * 1024, 1024, 0, 1024, 512, nullptr, (bf16_t*)(ws + OFF_WOA), 0, lds, vb, nvb);
    conv_T(INP(p, 24) + (size_t)l * 512 * 1024, 1024, 0, 1024, 512, nullptr, (bf16_t*)(ws + OFF_WOB), 0, lds, vb, nvb);
    conv_T(INP(p, 25) + (size_t)l * 1024 * 1024, 1024, 0, 1024, 1024, nullptr, (bf16_t*)(ws + OFF_WO), 0, lds, vb, nvb);
    conv_T(INP(p, 27) + (size_t)l * 1024 * 4096, 4096, 0, 4096, 1024, INP(p, 26) + l * 1024, (bf16_t*)(ws + OFF_WUP), 0, lds, vb, nvb);
    conv_T(INP(p, 28) + (size_t)l * 4096 * 1024, 1024, 0, 1024, 4096, nullptr, (bf16_t*)(ws + OFF_WDN), 0, lds, vb, nvb);
}
__device__ void phase_x0(const Ctx& p) {
    const int tid = tidx(); const int wave = __builtin_amdgcn_readfirstlane(tid >> 6), lane = tid & 63;
    unsigned char* ws = uptr(p.ws);
    float* rowss = (float*)(ws + OFF_SM + SM_ROWSS); bf16_t* XB = (bf16_t*)(ws + OFF_XB);
    for (int row = bidx() * 8 + wave; row < T_ALL; row += gridDim.x * 8) {
        const float* src = row < T_P ? INP(p, 0) + (size_t)row * 1024 : INP(p, 1) + (size_t)(row - T_P) * 1024;
        float ss = 0.f;
#pragma unroll
        for (int i = 0; i < 4; ++i) { const int c = i * 256 + lane * 4; const float4 v = *(const float4*)(src + c);
            ss += v.x * v.x + v.y * v.y + v.z * v.z + v.w * v.w; u32x2 w; w.x = cvt_pk_bf16(v.x, v.y); w.y = cvt_pk_bf16(v.z, v.w); *(u32x2*)(XB + (size_t)row * 1024 + c) = w; }
        ss = wsum(ss); if (lane == 0) rowss[row] = ss;
    }
    for (int i = bidx() * 512 + tidx(); i < 4 * T_ALL; i += gridDim.x * 512) rowss[T_ALL + i] = 0.f;
}
__device__ __forceinline__ u32x2 pack4(float a, float b, float c, float d) { u32x2 w; w.x = cvt_pk_bf16(a, b); w.y = cvt_pk_bf16(c, d); return w; }
__device__ void phase_prep(const Ctx& p, int l, LAS unsigned char* lds) {
    constexpr int MXS = 1832, MIDS = 40;
    unsigned char* ws = uptr(p.ws);
    const bf16_t* PR = (const bf16_t*)(ws + OFF_A);
    LAS bf16_t* MX = (LAS bf16_t*)lds; LAS bf16_t* MID = (LAS bf16_t*)(lds + 32 * MXS * 2);
    const int tid = tidx(); const int wave = __builtin_amdgcn_readfirstlane(tid >> 6), lane = tid & 63, fr = lane & 15, fq = lane >> 4;
    const float* mu = INP(p, 7) + l * 1824;
    const bf16_t* w2T = (const bf16_t*)(ws + OFF_SM + SM_W2T); const bf16_t* a2T = (const bf16_t*)(ws + OFF_SM + SM_A2T); const bf16_t* g2T = (const bf16_t*)(ws + OFF_SM + SM_G2T);
    const bf16_t* v1T = (const bf16_t*)(ws + OFF_SM + SM_V1T); const bf16_t* v2T = (const bf16_t*)(ws + OFF_SM + SM_V2T);
    bf16_t* oR = (bf16_t*)(ws + OFF_B); bf16_t* oV = (bf16_t*)(l == 0 ? ws + OFF_V0 : ws + OFF_B + SLOT); bf16_t* oE = (bf16_t*)(ws + OFF_B + 2 * SLOT);
    bf16_t* oK = (bf16_t*)(ws + OFF_B + 3 * SLOT); bf16_t* oA = (bf16_t*)(ws + OFF_B + 4 * SLOT); bf16_t* oB = (bf16_t*)(ws + OFF_B + 5 * SLOT);
    bf16_t* oG = (bf16_t*)(ws + OFF_G); const bf16_t* V0 = (const bf16_t*)(ws + OFF_V0);
    float* bonus = (float*)(ws + OFF_SM + SM_BONUS);
    const float* w0 = INP(p, 8) + l * 512; const float* a0 = INP(p, 10) + l * 512; const float* kkp = INP(p, 16) + l * 512; const float* kap = INP(p, 17) + l * 512; const float* rkp = INP(p, 18) + l * 512;
    const float* v0p = INP(p, 13);
    for (int ti = bidx(); ti < T_ALL / 32; ti += gridDim.x) {
        const int t0 = ti * 32;
        if (tid < 456) {
            const int cgp = tid % 228, rh = tid / 228, c0 = cgp * 8, rstart = rh * 16;
            float prev[8], m8[8];
            { const float4 a = *(const float4*)(mu + c0), b = *(const float4*)(mu + c0 + 4); m8[0] = a.x; m8[1] = a.y; m8[2] = a.z; m8[3] = a.w; m8[4] = b.x; m8[5] = b.y; m8[6] = b.z; m8[7] = b.w; }
            const bool seq_start = (rh == 0) && (t0 >= T_P || (t0 % 8192) == 0);
            if (seq_start) {
                if (t0 >= T_P) { const float* sp = INP(p, 2) + ((size_t)l * 32 + (t0 - T_P) / 32) * 1824 + c0;
#pragma unroll
                    for (int j = 0; j < 8; ++j) prev[j] = sp[j]; }
                else {
#pragma unroll
                    for (int j = 0; j < 8; ++j) prev[j] = 0.f; }
            } else {
                const u32x4 w = *(const u32x4*)(PR + (size_t)(t0 + rstart - 1) * 2048 + c0);
                prev[0] = lo16(w.x); prev[1] = hi16(w.x); prev[2] = lo16(w.y); prev[3] = hi16(w.y); prev[4] = lo16(w.z); prev[5] = hi16(w.z); prev[6] = lo16(w.w); prev[7] = hi16(w.w);
            }
            const int fn = c0 < 1536 ? 0 : (c0 < 1600 ? 1 : (c0 < 1664 ? 0 : 2));
#pragma unroll 1
            for (int r8 = 0; r8 < 16; r8 += 8) {
            u32x4 wrow[8];
#pragma unroll
            for (int r = 0; r < 8; ++r) wrow[r] = *(const u32x4*)(PR + (size_t)(t0 + rstart + r8 + r) * 2048 + c0);
#pragma unroll
            for (int rr = 0; rr < 8; ++rr) {
                const int r = r8 + rr; const u32x4 w = wrow[rr];
                float cur[8], o[8];
                cur[0] = lo16(w.x); cur[1] = hi16(w.x); cur[2] = lo16(w.y); cur[3] = hi16(w.y); cur[4] = lo16(w.z); cur[5] = hi16(w.z); cur[6] = lo16(w.w); cur[7] = hi16(w.w);
#pragma unroll
                for (int j = 0; j < 8; ++j) { float x = cur[j] + (prev[j] - cur[j]) * m8[j]; if (fn == 1) x = tanh_fast(x); else if (fn == 2) x = sigm(x); o[j] = x; prev[j] = cur[j]; }
                u32x4 q; q.x = cvt_pk_bf16(o[0], o[1]); q.y = cvt_pk_bf16(o[2], o[3]); q.z = cvt_pk_bf16(o[4], o[5]); q.w = cvt_pk_bf16(o[6], o[7]);
                *(LAS u32x4*)(MX + (rstart + r) * MXS + c0) = q;
            }
            }
            if (rh == 1) {
                const bool last = t0 >= T_P || ((t0 + 32) % 8192) == 0;
                if (last) { float* dst = t0 >= T_P ? p.out + O_SHS + ((size_t)l * 32 + (t0 - T_P) / 32) * 1824 + c0 : p.out + O_SHP + ((size_t)l * 2 + t0 / 8192) * 1824 + c0;
#pragma unroll
                    for (int j = 0; j < 8; ++j) dst[j] = prev[j]; }
            }
        }
        __syncthreads();
        if (l == 1 && VRES && VRES != 2) {
            if (wave < 4) {
                const int tt = wave & 1, ot = wave >> 1; f32x4 acc = (f32x4){0.f, 0.f, 0.f, 0.f};
#pragma unroll 4
                for (int ks = 0; ks < 16; ++ks) {
                    const bf16x8 X = *(const bf16x8*)(v1T + (ot * 16 + fr) * 512 + ks * 32 + fq * 8);
                    const bf16x8 Y = *(const LAS bf16x8*)(MX + (tt * 16 + fr) * MXS + 1024 + ks * 32 + fq * 8);
                    acc = __builtin_amdgcn_mfma_f32_16x16x32_bf16(X, Y, acc, 0, 0, 0); }
                *(LAS u32x2*)(MID + (tt * 16 + fr) * MIDS + ot * 16 + 4 * fq) = pack4(acc[0], acc[1], acc[2], acc[3]);
            }
            __syncthreads();
        }
        const int h = wave;
        float ss[2] = {0.f, 0.f}, bon[2] = {0.f, 0.f};
#pragma unroll 1
        for (int ct = 0; ct < 4; ++ct) {
            const int crow = h * 64 + ct * 16 + fr, c = h * 64 + ct * 16 + 4 * fq;
            bf16x8 xw[2], xa[2], xg[5], xv;
#pragma unroll
            for (int ks = 0; ks < 2; ++ks) { xw[ks] = *(const bf16x8*)(w2T + crow * 64 + ks * 32 + fq * 8); xa[ks] = *(const bf16x8*)(a2T + crow * 64 + ks * 32 + fq * 8); }
#pragma unroll
            for (int ks = 0; ks < 5; ++ks) xg[ks] = *(const bf16x8*)(g2T + crow * 160 + ks * 32 + fq * 8);
            if (l == 1) xv = *(const bf16x8*)(v2T + crow * 32 + fq * 8); else xv = xw[0];
            const float4 w04 = *(const float4*)(w0 + c), a04 = *(const float4*)(a0 + c), kk_4 = *(const float4*)(kkp + c), ka4 = *(const float4*)(kap + c), rk4 = *(const float4*)(rkp + c);
            const float w0a[4] = {w04.x, w04.y, w04.z, w04.w}, a0a[4] = {a04.x, a04.y, a04.z, a04.w}, kka[4] = {kk_4.x, kk_4.y, kk_4.z, kk_4.w}, kaa[4] = {ka4.x, ka4.y, ka4.z, ka4.w}, rka[4] = {rk4.x, rk4.y, rk4.z, rk4.w};
            float v0a[4] = {0.f, 0.f, 0.f, 0.f};
            if (l == 1) { const float4 v04 = *(const float4*)(v0p + c); v0a[0] = v04.x; v0a[1] = v04.y; v0a[2] = v04.z; v0a[3] = v04.w; }
            u32x2 fwv[2] = {(u32x2){0u, 0u}, (u32x2){0u, 0u}};
            if (l == 1) { fwv[0] = *(const u32x2*)(V0 + (size_t)(t0 + fr) * 512 + c); fwv[1] = *(const u32x2*)(V0 + (size_t)(t0 + 16 + fr) * 512 + c); }
#pragma unroll
            for (int tt = 0; tt < 2; ++tt) {
                const LAS bf16_t* yrow = MX + (tt * 16 + fr) * MXS + fq * 8;
                f32x4 aW = (f32x4){0.f, 0.f, 0.f, 0.f}, aA = aW, aG = aW, aV = aW;
#pragma unroll
                for (int ks = 0; ks < 2; ++ks) { aW = __builtin_amdgcn_mfma_f32_16x16x32_bf16(xw[ks], *(const LAS bf16x8*)(yrow + 1536 + ks * 32), aW, 0, 0, 0);
                                                 aA = __builtin_amdgcn_mfma_f32_16x16x32_bf16(xa[ks], *(const LAS bf16x8*)(yrow + 1600 + ks * 32), aA, 0, 0, 0); }
#pragma unroll
                for (int ks = 0; ks < 5; ++ks) aG = __builtin_amdgcn_mfma_f32_16x16x32_bf16(xg[ks], *(const LAS bf16x8*)(yrow + 1664 + ks * 32), aG, 0, 0, 0);
                if (l == 1) aV = __builtin_amdgcn_mfma_f32_16x16x32_bf16(xv, *(const LAS bf16x8*)(MID + (tt * 16 + fr) * MIDS + fq * 8), aV, 0, 0, 0);
                const int j = tt * 16 + fr, t = t0 + j;
                LAS bf16_t* mrow = MX + j * MXS + c;
                const u32x2 rw = *(const LAS u32x2*)(mrow), kw = *(const LAS u32x2*)(mrow + 512), vw = *(const LAS u32x2*)(mrow + 1024);
                const float rr[4] = {lo16(rw.x), hi16(rw.x), lo16(rw.y), hi16(rw.y)}, kk4[4] = {lo16(kw.x), hi16(kw.x), lo16(kw.y), hi16(kw.y)};
                float vv[4] = {lo16(vw.x), hi16(vw.x), lo16(vw.y), hi16(vw.y)};
                if (l == 1) {
                    const u32x2 fw = fwv[tt]; const float vf[4] = {lo16(fw.x), hi16(fw.x), lo16(fw.y), hi16(fw.y)};
#pragma unroll
                    for (int e = 0; e < 4; ++e) { const float vg = sigm(v0a[e] + aV[e]); vv[e] = vv[e] + (vf[e] - vv[e]) * vg; }
                }
                float ew[4], kh[4], kr4[4], ag4[4];
#pragma unroll
                for (int e = 0; e < 4; ++e) {
                    ew[e] = 0.60653066f * sigm(w0a[e] + aW[e]);
                    const float a = sigm(a0a[e] + aA[e]); ag4[e] = a;
                    const float kr = kk4[e] * kka[e]; kr4[e] = kr; ss[tt] += kr * kr;
                    kh[e] = kk4[e] * (1.0f + (a - 1.0f) * kaa[e]);
                    bon[tt] += rr[e] * kh[e] * rka[e];
                }
                const size_t o = (size_t)t * 512 + c;
                *(u32x2*)(oR + o) = rw;
                *(u32x2*)(oV + o) = pack4(vv[0], vv[1], vv[2], vv[3]);
                *(u32x2*)(oE + o) = pack4(ew[0], ew[1], ew[2], ew[3]);
                *(u32x2*)(oK + o) = pack4(kh[0], kh[1], kh[2], kh[3]);
                *(u32x2*)(oG + o) = pack4(aG[0], aG[1], aG[2], aG[3]);
                *(LAS u32x2*)(mrow) = pack4(ag4[0], ag4[1], ag4[2], ag4[3]);
                *(LAS u32x2*)(mrow + 512) = pack4(kr4[0], kr4[1], kr4[2], kr4[3]);
            }
        }
#pragma unroll
        for (int tt = 0; tt < 2; ++tt) {
            float s1 = ss[tt], b1 = bon[tt];
            s1 += __shfl_xor(s1, 16); s1 += __shfl_xor(s1, 32); b1 += __shfl_xor(b1, 16); b1 += __shfl_xor(b1, 32);
            const float inv = rsqrtf(fmaxf(s1, 1e-24f));
            const int j = tt * 16 + fr, t = t0 + j;
#pragma unroll
            for (int ct = 0; ct < 4; ++ct) {
                const int c = h * 64 + ct * 16 + 4 * fq;
                const LAS bf16_t* mrow = MX + j * MXS + c;
                const u32x2 aw = *(const LAS u32x2*)(mrow), kw = *(const LAS u32x2*)(mrow + 512);
                const float ag4[4] = {lo16(aw.x), hi16(aw.x), lo16(aw.y), hi16(aw.y)}; float k4[4] = {lo16(kw.x) * inv, hi16(kw.x) * inv, lo16(kw.y) * inv, hi16(kw.y) * inv};
                const size_t o = (size_t)t * 512 + c;
                *(u32x2*)(oA + o) = pack4(-k4[0], -k4[1], -k4[2], -k4[3]);
                *(u32x2*)(oB + o) = pack4(k4[0] * ag4[0], k4[1] * ag4[1], k4[2] * ag4[2], k4[3] * ag4[3]);
            }
            if (fq == 0) bonus[(size_t)t * 8 + h] = b1;
        }
        __syncthreads();
    }
}

typedef float f2 __attribute__((ext_vector_type(2)));
__device__ __forceinline__ f2 pfma(f2 a, f2 b, f2 c) { return __builtin_elementwise_fma(a, b, c); }
template <bool ID> __device__ __forceinline__ void rwkv_scan(const bf16_t* __restrict__ R, const bf16_t* __restrict__ EW, const bf16_t* __restrict__ K, const bf16_t* __restrict__ V,
        const bf16_t* __restrict__ A, const bf16_t* __restrict__ B, unsigned base, int nsteps, f2 (&Sv)[32], f2 (&Si)[32], bf16_t* __restrict__ YH, bf16_t* __restrict__ QH, LAS float* L, int lane) {
    unsigned short q1[6], q2[6];
    { unsigned o = base; q1[0] = R[o]; q1[1] = EW[o]; q1[2] = K[o]; q1[3] = V[o]; q1[4] = A[o]; q1[5] = B[o];
      o = base + 512u; q2[0] = R[o]; q2[1] = EW[o]; q2[2] = K[o]; q2[3] = V[o]; q2[4] = A[o]; q2[5] = B[o]; }
    const LAS f32x4* pa = (const LAS f32x4*)L;
    float sav, sai;
    { L[lane] = bf2f(q1[4]);
      f2 av = {0.f, 0.f}, ai = {0.f, 0.f};
#pragma unroll
      for (int q = 0; q < 16; ++q) { const f32x4 a4 = pa[q]; const f2 a01 = {a4[0], a4[1]}, a23 = {a4[2], a4[3]};
          av = pfma(Sv[2 * q], a01, av); av = pfma(Sv[2 * q + 1], a23, av); if (ID) { ai = pfma(Si[2 * q], a01, ai); ai = pfma(Si[2 * q + 1], a23, ai); } }
      sav = av[0] + av[1]; sai = ai[0] + ai[1]; }
#pragma unroll 1
    for (int s = 0; s < nsteps; ++s) {
        L[lane] = bf2f(q2[4]); L[64 + lane] = __expf(-bf2f(q1[1])); L[128 + lane] = bf2f(q1[5]); L[192 + lane] = bf2f(q1[2]); L[256 + lane] = bf2f(q1[0]);
        const float v = bf2f(q1[3]);
#pragma unroll
        for (int j = 0; j < 6; ++j) q1[j] = q2[j];
        { const unsigned o = base + (unsigned)(s + 2 < nsteps ? s + 2 : nsteps - 1) * 512u; q2[0] = R[o]; q2[1] = EW[o]; q2[2] = K[o]; q2[3] = V[o]; q2[4] = A[o]; q2[5] = B[o]; }
        const f2 sav2 = {sav, sav}, sai2 = {sai, sai}, v2 = {v, v};
        f2 yv = {0.f, 0.f}, yi = {0.f, 0.f}, yv1 = {0.f, 0.f}, yi1 = {0.f, 0.f}, nv = {0.f, 0.f}, ni = {0.f, 0.f}, nv1 = {0.f, 0.f}, ni1 = {0.f, 0.f};
        f32x4 ca = pa[0], cw = pa[16], cb = pa[32], ck = pa[48], cr = pa[64];
#pragma unroll
        for (int q = 0; q < 16; ++q) {
            const f32x4 a4 = ca, w4 = cw, b4 = cb, k4 = ck, r4 = cr;
            if (q < 15) { ca = pa[1 + q]; cw = pa[17 + q]; cb = pa[33 + q]; ck = pa[49 + q]; cr = pa[65 + q]; }
            __builtin_amdgcn_sched_barrier(0);
            { const f2 a2 = {a4[0], a4[1]}, w2 = {w4[0], w4[1]}, b2 = {b4[0], b4[1]}, k2 = {k4[0], k4[1]}, r2 = {r4[0], r4[1]};
              f2 tv = sav2 * b2; tv = pfma(v2, k2, tv); Sv[2 * q] = pfma(Sv[2 * q], w2, tv); yv = pfma(Sv[2 * q], r2, yv); nv = pfma(Sv[2 * q], a2, nv);
              if (ID) { const f2 ti = sai2 * b2; Si[2 * q] = pfma(Si[2 * q], w2, ti); yi = pfma(Si[2 * q], r2, yi); ni = pfma(Si[2 * q], a2, ni); } }
            { const f2 a2 = {a4[2], a4[3]}, w2 = {w4[2], w4[3]}, b2 = {b4[2], b4[3]}, k2 = {k4[2], k4[3]}, r2 = {r4[2], r4[3]};
              f2 tv = sav2 * b2; tv = pfma(v2, k2, tv); Sv[2 * q + 1] = pfma(Sv[2 * q + 1], w2, tv); yv1 = pfma(Sv[2 * q + 1], r2, yv1); nv1 = pfma(Sv[2 * q + 1], a2, nv1);
              if (ID) { const f2 ti = sai2 * b2; Si[2 * q + 1] = pfma(Si[2 * q + 1], w2, ti); yi1 = pfma(Si[2 * q + 1], r2, yi1); ni1 = pfma(Si[2 * q + 1], a2, ni1); } }
        }
        sav = (nv[0] + nv[1]) + (nv1[0] + nv1[1]); sai = (ni[0] + ni[1]) + (ni1[0] + ni1[1]);
        const unsigned cbo = base + (unsigned)s * 512u;
        YH[cbo] = f2bf((yv[0] + yv[1]) + (yv1[0] + yv1[1])); if (ID) QH[cbo] = f2bf((yi[0] + yi[1]) + (yi1[0] + yi1[1]));
    }
}
__device__ void phase_rwkv_scan(const Ctx& p, int l, LAS unsigned char* lds) {
    unsigned char* ws = uptr(p.ws);
    const bf16_t* R = (const bf16_t*)(ws + OFF_B); const bf16_t* V = (const bf16_t*)(l == 0 ? ws + OFF_V0 : ws + OFF_B + SLOT); const bf16_t* EW = (const bf16_t*)(ws + OFF_B + 2 * SLOT);
    const bf16_t* K = (const bf16_t*)(ws + OFF_B + 3 * SLOT); const bf16_t* A = (const bf16_t*)(ws + OFF_B + 4 * SLOT); const bf16_t* B = (const bf16_t*)(ws + OFF_B + 5 * SLOT);
    bf16_t* YH = (bf16_t*)(ws + OFF_A); bf16_t* QH = (bf16_t*)(ws + OFF_A + SLOT); float* P = (float*)(ws + OFF_A + 34 * MiB); float* UC = (float*)(ws + OFF_A + 50 * MiB);
    const int tid = tidx(); const int wave = __builtin_amdgcn_readfirstlane(tid >> 6), lane = tid & 63;
    LAS float* L = (LAS float*)(lds + wave * 5120);
    if (wave < 4) {
        for (int item = bidx() * 4 + wave; item < 1024; item += gridDim.x * 4) {
            const int b = item >> 9, c = (item >> 3) & 63, h = item & 7;
            f2 Sv[32], Si[32]; const int li = tidx() & 63;
#pragma unroll
            for (int i = 0; i < 32; ++i) { Sv[i] = (f2){0.f, 0.f}; Si[i] = (f2){(2 * i == li) ? 1.f : 0.f, (2 * i + 1 == li) ? 1.f : 0.f}; }
            rwkv_scan<true>(R, EW, K, V, A, B, (unsigned)((b * 8192 + c * 128) * 512 + h * 64 + lane), 128, Sv, Si, YH, QH, L, lane);
            const int ln = tidx() & 63; int item2 = item; asm volatile("" : "+s"(item2));
            float* pp = P + (size_t)item2 * 4096 + ln * 64; float* up = UC + (size_t)item2 * 4096 + ln * 64;
#pragma unroll
            for (int i = 0; i < 32; i += 2) { *(float4*)(pp + 2 * i) = make_float4(Si[i][0], Si[i][1], Si[i + 1][0], Si[i + 1][1]); *(float4*)(up + 2 * i) = make_float4(Sv[i][0], Sv[i][1], Sv[i + 1][0], Sv[i + 1][1]); }
        }
    } else if (wave == 4) {
        for (int item = bidx(); item < 256; item += gridDim.x) {
            const int s = item >> 3, h = item & 7;
            const size_t so = (((size_t)l * 32 + s) * 8 + h) * 4096 + lane * 64;
            f2 Sv[32], Si[32];
            const float* sp = INP(p, 3) + so;
#pragma unroll
            for (int i = 0; i < 32; i += 2) { const float4 q = *(const float4*)(sp + 2 * i); Sv[i] = (f2){q.x, q.y}; Sv[i + 1] = (f2){q.z, q.w}; Si[i] = (f2){0.f, 0.f}; Si[i + 1] = (f2){0.f, 0.f}; }
            rwkv_scan<false>(R, EW, K, V, A, B, (unsigned)((T_P + s * 32) * 512 + h * 64 + lane), 32, Sv, Si, YH, QH, L, lane);
            float* op = p.out + O_RWS + so;
#pragma unroll
            for (int i = 0; i < 32; i += 2) *(float4*)(op + 2 * i) = make_float4(Sv[i][0], Sv[i][1], Sv[i + 1][0], Sv[i + 1][1]);
        }
    }
}
template <int CTRL> __device__ __forceinline__ float dpp_mov(float x) { return __uint_as_float(__builtin_amdgcn_update_dpp(0, __float_as_uint(x), CTRL, 0xF, 0xF, true)); }
__device__ __forceinline__ float wsum_fast(float x) {
    x += dpp_mov<0xB1>(x); x += dpp_mov<0x4E>(x); x += dpp_mov<0x141>(x); x += dpp_mov<0x140>(x);
    float t = rdl(x, 0); t += rdl(x, 16); t += rdl(x, 32); t += rdl(x, 48); return t; }
__device__ void phase_rwkv_chain(const Ctx& p, int l) {
    unsigned char* ws = uptr(p.ws);
    const float* P = (const float*)(ws + OFF_A + 34 * MiB); float* UC = (float*)(ws + OFF_A + 50 * MiB);
    const int tid = tidx(); const int wave = __builtin_amdgcn_readfirstlane(tid >> 6), lane = tid & 63;
    if (wave >= 4) return;
    for (int it = bidx() * 4 + wave; it < 1024; it += gridDim.x * 4) {
        const int b = it >> 9, h = (it >> 6) & 7, v = it & 63;
        const float* pb = P + (size_t)((b * 64) * 8 + h) * 4096 + lane;
        float* ub = UC + (size_t)((b * 64) * 8 + h) * 4096 + v * 64 + lane;
        float row = 0.f; float PA[64], PB[64];
#pragma unroll
        for (int i = 0; i < 64; ++i) PA[i] = pb[i * 64];
        float ucA = ub[0];
        for (int c = 0; c < 64; c += 2) {
            { const float* pc = pb + (size_t)(c + 1) * 32768;
#pragma unroll
              for (int i = 0; i < 64; ++i) PB[i] = pc[i * 64]; }
            const float ucB = ub[(size_t)(c + 1) * 32768];
            ub[(size_t)c * 32768] = row;
            { float n0 = ucA, n1 = 0.f;
#pragma unroll
              for (int i = 0; i < 64; i += 2) { n0 = fmaf(rdl(row, i), PA[i], n0); n1 = fmaf(rdl(row, i + 1), PA[i + 1], n1); }
              row = n0 + n1; }
            if (c + 2 < 64) { const float* pc = pb + (size_t)(c + 2) * 32768;
#pragma unroll
                for (int i = 0; i < 64; ++i) PA[i] = pc[i * 64];
                ucA = ub[(size_t)(c + 2) * 32768]; }
            ub[(size_t)(c + 1) * 32768] = row;
            { float n0 = ucB, n1 = 0.f;
#pragma unroll
              for (int i = 0; i < 64; i += 2) { n0 = fmaf(rdl(row, i), PB[i], n0); n1 = fmaf(rdl(row, i + 1), PB[i + 1], n1); }
              row = n0 + n1; }
        }
        p.out[O_RWP + (((size_t)l * 2 + b) * 8 + h) * 4096 + v * 64 + lane] = row;
    }
}
__device__ void phase_rwkv_fix(const Ctx& p, int l) {
    unsigned char* ws = uptr(p.ws);
    const bf16_t* YH = (const bf16_t*)(ws + OFF_A); const bf16_t* QH = (const bf16_t*)(ws + OFF_A + SLOT); const float* UC = (const float*)(ws + OFF_A + 50 * MiB);
    const bf16_t* V = (const bf16_t*)(l == 0 ? ws + OFF_V0 : ws + OFF_B + SLOT); const bf16_t* G = (const bf16_t*)(ws + OFF_G); const float* bonus = (const float*)(ws + OFF_SM + SM_BONUS);
    bf16_t* YA = (bf16_t*)(ws + OFF_B);
    const int tid = tidx(); const int wave = __builtin_amdgcn_readfirstlane(tid >> 6), lane = tid & 63, fr = lane & 15, fq = lane >> 4;
    const float* lnw = INP(p, 19) + l * 512; const float* lnb = INP(p, 20) + l * 512;
    for (int item = bidx() * 8 + wave; item < 4096 + 256; item += gridDim.x * 8) {
        const bool smp = item >= 4096;
        int h, t0, it = 0, ntile;
        if (!smp) { const int tq = item & 3; it = item >> 2; const int b = it >> 9, c = (it >> 3) & 63; h = it & 7; t0 = b * 8192 + c * 128 + tq * 32; ntile = 2; }
        else { const int si = item - 4096; h = si & 7; t0 = T_P + (si >> 3) * 32; ntile = 2; }
        bf16x8 X[4][2];
        if (!smp) {
#pragma unroll
            for (int vt = 0; vt < 4; ++vt)
#pragma unroll
                for (int ks = 0; ks < 2; ++ks) { const float* sp = UC + (size_t)it * 4096 + (vt * 16 + fr) * 64 + ks * 32 + fq * 8; const float4 a = *(const float4*)sp, b4 = *(const float4*)(sp + 4);
                    u32x4 w; w.x = cvt_pk_bf16(a.x, a.y); w.y = cvt_pk_bf16(a.z, a.w); w.z = cvt_pk_bf16(b4.x, b4.y); w.w = cvt_pk_bf16(b4.z, b4.w); X[vt][ks] = __builtin_bit_cast(bf16x8, w); }
        }
        float gw[4][4], gb[4][4];
#pragma unroll
        for (int vt = 0; vt < 4; ++vt) { const float4 a = *(const float4*)(lnw + h * 64 + vt * 16 + 4 * fq), b4 = *(const float4*)(lnb + h * 64 + vt * 16 + 4 * fq);
            gw[vt][0] = a.x; gw[vt][1] = a.y; gw[vt][2] = a.z; gw[vt][3] = a.w; gb[vt][0] = b4.x; gb[vt][1] = b4.y; gb[vt][2] = b4.z; gb[vt][3] = b4.w; }
        for (int tt = 0; tt < ntile; ++tt) {
            const int t = t0 + tt * 16 + fr; const size_t ob = (size_t)t * 512 + h * 64;
            float y[4][4];
            u32x2 yw[4], vw[4], gg[4];
#pragma unroll
            for (int vt = 0; vt < 4; ++vt) { yw[vt] = *(const u32x2*)(YH + ob + vt * 16 + 4 * fq); vw[vt] = *(const u32x2*)(V + ob + vt * 16 + 4 * fq); gg[vt] = *(const u32x2*)(G + ob + vt * 16 + 4 * fq); }
            const float bn = bonus[(size_t)t * 8 + h];
            if (!smp) {
                const bf16x8 Y0 = *(const bf16x8*)(QH + ob + fq * 8), Y1 = *(const bf16x8*)(QH + ob + 32 + fq * 8);
#pragma unroll
                for (int vt = 0; vt < 4; ++vt) { f32x4 acc = (f32x4){0.f, 0.f, 0.f, 0.f};
                    acc = __builtin_amdgcn_mfma_f32_16x16x32_bf16(X[vt][0], Y0, acc, 0, 0, 0); acc = __builtin_amdgcn_mfma_f32_16x16x32_bf16(X[vt][1], Y1, acc, 0, 0, 0);
                    y[vt][0] = acc[0] + lo16(yw[vt].x); y[vt][1] = acc[1] + hi16(yw[vt].x); y[vt][2] = acc[2] + lo16(yw[vt].y); y[vt][3] = acc[3] + hi16(yw[vt].y); }
            } else {
#pragma unroll
                for (int vt = 0; vt < 4; ++vt) { y[vt][0] = lo16(yw[vt].x); y[vt][1] = hi16(yw[vt].x); y[vt][2] = lo16(yw[vt].y); y[vt][3] = hi16(yw[vt].y); }
            }
            float sm = 0.f;
#pragma unroll
            for (int vt = 0; vt < 4; ++vt) sm += (y[vt][0] + y[vt][1]) + (y[vt][2] + y[vt][3]);
            sm += __shfl_xor(sm, 16); sm += __shfl_xor(sm, 32);
            const float mean = sm * (1.0f / 64.0f); float sq = 0.f;
#pragma unroll
            for (int vt = 0; vt < 4; ++vt)
#pragma unroll
                for (int e = 0; e < 4; ++e) { y[vt][e] -= mean; sq += y[vt][e] * y[vt][e]; }
            sq += __shfl_xor(sq, 16); sq += __shfl_xor(sq, 32);
            const float rs = rsqrtf(sq * (1.0f / 64.0f) + 64e-5f);
#pragma unroll
            for (int vt = 0; vt < 4; ++vt) {
                const float vv[4] = {lo16(vw[vt].x), hi16(vw[vt].x), lo16(vw[vt].y), hi16(vw[vt].y)}, g4[4] = {lo16(gg[vt].x), hi16(gg[vt].x), lo16(gg[vt].y), hi16(gg[vt].y)};
                float o[4];
#pragma unroll
                for (int e = 0; e < 4; ++e) o[e] = (y[vt][e] * rs * gw[vt][e] + gb[vt][e] + bn * vv[e]) * g4[e];
                *(u32x2*)(YA + ob + vt * 16 + 4 * fq) = pack4(o[0], o[1], o[2], o[3]);
            }
        }
    }
}
__device__ __forceinline__ float lb_of(const Ctx& p, int l, int c) { if (l == 0) return 0.f; const float* z = INP(p, 21); const float z0 = z[c], z1 = z[512 + c]; return __builtin_amdgcn_rcpf(1.0f + __expf(z0 - z1)); }
__device__ __forceinline__ void hgrn_scan(const bf16_t* __restrict__ PH, int t0, int nsteps, int h, int half, int kh, int lane, float lb, f2 (&S)[32], float& cp, bf16_t* __restrict__ OHp, float* __restrict__ ckp, LAS float* L) {
    const bf16_t* row = PH + (size_t)t0 * 2048 + h * 128 + kh * 64 + lane; const int voff = 1024 + (half - kh) * 64;
    unsigned short q1[3], q2[3], q3[3];
    { const bf16_t* r = row; q1[0] = r[0]; q1[1] = r[512]; q1[2] = r[voff];
      r = row + 2048; q2[0] = r[0]; q2[1] = r[512]; q2[2] = r[voff];
      r = row + 4096; q3[0] = r[0]; q3[1] = r[512]; q3[2] = r[voff]; }
    const LAS f32x4* pf = (const LAS f32x4*)L;
#pragma unroll 1
    for (int s = 0; s < nsteps; ++s) {
        const float ql = bf2f(q1[0]), fz = bf2f(q1[1]), v = bf2f(q1[2]);
#pragma unroll
        for (int j = 0; j < 3; ++j) { q1[j] = q2[j]; q2[j] = q3[j]; }
        { const bf16_t* r = row + (size_t)(s + 3 < nsteps ? s + 3 : nsteps - 1) * 2048; q3[0] = r[0]; q3[1] = r[512]; q3[2] = r[voff]; }
        const float fl = lb + (1.0f - lb) * sigm(fz);
        cp *= fl;
        if (ckp && (s & 31) == 31 && s < 127) ckp[(s >> 5) * 128 + lane] = cp;
        L[lane] = fl; L[64 + lane] = ql * sigm(ql);
        f32x4 F[2][4], Q[2][4];
#pragma unroll
        for (int i = 0; i < 4; ++i) { F[0][i] = pf[i]; Q[0][i] = pf[16 + i]; }
        const f2 v2 = {v, v}; f2 o2 = {0.f, 0.f}, o3 = {0.f, 0.f};
#pragma unroll
        for (int g = 0; g < 4; ++g) {
            if (g < 3) {
#pragma unroll
                for (int i = 0; i < 4; ++i) { F[(g + 1) & 1][i] = pf[(g + 1) * 4 + i]; Q[(g + 1) & 1][i] = pf[16 + (g + 1) * 4 + i]; } }
            __builtin_amdgcn_sched_barrier(0);
#pragma unroll
            for (int i = 0; i < 4; ++i) {
                const f32x4 f4 = F[g & 1][i], q4 = Q[g & 1][i]; const int idx = (g * 4 + i) * 2;
                const f2 f01 = {f4[0], f4[1]}, f23 = {f4[2], f4[3]}, q01 = {q4[0], q4[1]}, q23 = {q4[2], q4[3]};
                S[idx] = pfma(f01, S[idx] - v2, v2); o2 = pfma(S[idx], q01, o2);
                S[idx + 1] = pfma(f23, S[idx + 1] - v2, v2); o3 = pfma(S[idx + 1], q23, o3);
            }
        }
        OHp[(size_t)(t0 + s) * 512 + h * 128 + half * 64 + lane] = f2bf((o2[0] + o2[1]) + (o3[0] + o3[1]));
    }
}
constexpr size_t OFF_PGC = OFF_B + 3 * SLOT + 32 * MiB;
__device__ void phase_hgrn_scan(const Ctx& p, int l, LAS unsigned char* lds) {
    unsigned char* ws = uptr(p.ws);
    const bf16_t* PH = (const bf16_t*)(ws + OFF_A); bf16_t* OH0 = (bf16_t*)(ws + OFF_B + 2 * SLOT); bf16_t* OH1 = (bf16_t*)(ws + OFF_B + 5 * SLOT);
    float* UCH = (float*)(ws + OFF_B + 3 * SLOT); float* PGH = (float*)(ws + OFF_SM + SM_PGH); float* PGC = (float*)(ws + OFF_PGC);
    const int tid = tidx(); const int wave = __builtin_amdgcn_readfirstlane(tid >> 6), lane = tid & 63;
    LAS float* L = (LAS float*)(lds + wave * 1024);
    for (int item = bidx() * 8 + wave; item < 2048; item += gridDim.x * 8) {
        const int kh = item & 1, half = (item >> 1) & 1, h = (item >> 2) & 3, c = (item >> 4) & 63, b = item >> 10, idx = item >> 2;
        f2 S[32];
#pragma unroll
        for (int k = 0; k < 32; ++k) S[k] = (f2){0.f, 0.f};
        float cp = 1.f;
        hgrn_scan(PH, b * 8192 + c * 128, 128, h, half, kh, lane, lb_of(p, l, h * 128 + kh * 64 + lane), S, cp, kh ? OH1 : OH0, half == 0 ? PGC + (size_t)idx * 384 + kh * 64 : nullptr, L);
        float* up = UCH + (size_t)idx * 16384 + (size_t)(kh * 64) * 128 + half * 64 + lane;
#pragma unroll
        for (int k = 0; k < 32; ++k) { up[(2 * k) * 128] = S[k][0]; up[(2 * k + 1) * 128] = S[k][1]; }
        if (half == 0) PGH[idx * 128 + kh * 64 + lane] = cp;
    }
    if (wave < 2) {
        for (int item = bidx() * 2 + wave; item < 512; item += gridDim.x * 2) {
            const int kh = item & 1, half = (item >> 1) & 1, h = (item >> 2) & 3, s = item >> 4;
            const size_t so = (((size_t)l * 32 + s) * 4 + h) * 16384 + (size_t)(kh * 64) * 128 + half * 64 + lane;
            f2 S[32];
            const float* stp = INP(p, 4) + so;
#pragma unroll
            for (int k = 0; k < 32; ++k) S[k] = (f2){stp[(2 * k) * 128], stp[(2 * k + 1) * 128]};
            float cp = 1.f;
            hgrn_scan(PH, T_P + s * 32, 32, h, half, kh, lane, lb_of(p, l, h * 128 + kh * 64 + lane), S, cp, kh ? OH1 : OH0, nullptr, L);
#pragma unroll
            for (int k = 0; k < 32; ++k) { p.out[O_HGS + so + (2 * k) * 128] = S[k][0]; p.out[O_HGS + so + (2 * k + 1) * 128] = S[k][1]; }
        }
    }
}
__device__ void phase_hgrn_chain(const Ctx& p, int l) {
    unsigned char* ws = uptr(p.ws);
    float* UCH = (float*)(ws + OFF_B + 3 * SLOT); const float* PGH = (const float*)(ws + OFF_SM + SM_PGH);
    for (int gid = bidx() * 512 + tidx(); gid < 131072; gid += gridDim.x * 512) {
        const int b = gid >> 16, h = (gid >> 14) & 3, k = (gid >> 7) & 127, v = gid & 127;
        float s = 0.f;
        for (int c0 = 0; c0 < 64; c0 += 8) {
            float u[8], pg[8];
#pragma unroll
            for (int j = 0; j < 8; ++j) { const size_t idx = (size_t)(b * 64 + c0 + j) * 4 + h; u[j] = UCH[idx * 16384 + k * 128 + v]; pg[j] = PGH[idx * 128 + k]; }
#pragma unroll
            for (int j = 0; j < 8; ++j) { const size_t idx = (size_t)(b * 64 + c0 + j) * 4 + h; UCH[idx * 16384 + k * 128 + v] = s; s = fmaf(pg[j], s, u[j]); }
        }
        p.out[O_HGP + (((size_t)l * 2 + b) * 4 + h) * 16384 + k * 128 + v] = s;
    }
}
__device__ void phase_hgrn_fix(const Ctx& p, int l, LAS unsigned char* lds) {
    unsigned char* ws = uptr(p.ws);
    const bf16_t* PH = (const bf16_t*)(ws + OFF_A); const bf16_t* OH = (const bf16_t*)(ws + OFF_B + 2 * SLOT); const float* UCH = (const float*)(ws + OFF_B + 3 * SLOT);
    const float* PGC = (const float*)(ws + OFF_PGC); const bf16_t* OH1 = (const bf16_t*)(ws + OFF_B + 5 * SLOT);
    bf16_t* YB = (bf16_t*)(ws + OFF_B + SLOT);
    const int tid = tidx(); const int wave = __builtin_amdgcn_readfirstlane(tid >> 6), lane = tid & 63, fr = lane & 15, fq = lane >> 4;
    const float* nw = INP(p, 22) + l * 512;
    constexpr int QS = 136;
    LAS bf16_t* QT = (LAS bf16_t*)(lds + wave * 16384);
    for (int item = bidx() * 8 + wave; item < 2048; item += gridDim.x * 8) {
        const int tq = item & 3, idx = item >> 2, h = idx & 3, c = (idx >> 2) & 63, b = idx >> 8;
        const float lbl = lb_of(p, l, h * 128 + lane), lbh = lb_of(p, l, h * 128 + 64 + lane);
        const int tbase = b * 8192 + c * 128 + tq * 32;
        float rl = 1.f, rh = 1.f;
        if (tq) { rl = PGC[(size_t)idx * 384 + (tq - 1) * 128 + lane]; rh = PGC[(size_t)idx * 384 + (tq - 1) * 128 + 64 + lane]; }
        const bf16_t* row = PH + (size_t)tbase * 2048 + h * 128 + lane;
#pragma unroll 1
        for (int t8 = 0; t8 < 32; t8 += 8) {
            unsigned short rq[8][4];
#pragma unroll
            for (int j = 0; j < 8; ++j) { const bf16_t* r = row + (size_t)(t8 + j) * 2048; rq[j][0] = r[0]; rq[j][1] = r[64]; rq[j][2] = r[512]; rq[j][3] = r[576]; }
#pragma unroll
            for (int j = 0; j < 8; ++j) {
                const float ql = bf2f(rq[j][0]), qh = bf2f(rq[j][1]);
                rl *= lbl + (1.0f - lbl) * sigm(bf2f(rq[j][2])); rh *= lbh + (1.0f - lbh) * sigm(bf2f(rq[j][3]));
                QT[(t8 + j) * QS + lane] = f2bf(ql * sigm(ql) * rl); QT[(t8 + j) * QS + 64 + lane] = f2bf(qh * sigm(qh) * rh);
            }
        }
        f32x4 acc[8][2];
        const float* sb = UCH + (size_t)idx * 16384 + fr;
#pragma unroll
        for (int vt = 0; vt < 8; ++vt) {
            acc[vt][0] = (f32x4){0.f, 0.f, 0.f, 0.f}; acc[vt][1] = (f32x4){0.f, 0.f, 0.f, 0.f};
#pragma unroll
            for (int ks = 0; ks < 4; ++ks) {
                const float* sp = sb + (size_t)(ks * 32 + fq * 8) * 128 + vt * 16;
                u32x4 w; w.x = cvt_pk_bf16(sp[0], sp[128]); w.y = cvt_pk_bf16(sp[256], sp[384]); w.z = cvt_pk_bf16(sp[512], sp[640]); w.w = cvt_pk_bf16(sp[768], sp[896]);
                const bf16x8 X = __builtin_bit_cast(bf16x8, w);
                acc[vt][0] = __builtin_amdgcn_mfma_f32_16x16x32_bf16(X, *(const LAS bf16x8*)(QT + fr * QS + ks * 32 + fq * 8), acc[vt][0], 0, 0, 0);
                acc[vt][1] = __builtin_amdgcn_mfma_f32_16x16x32_bf16(X, *(const LAS bf16x8*)(QT + (16 + fr) * QS + ks * 32 + fq * 8), acc[vt][1], 0, 0, 0);
            }
        }
#pragma unroll
        for (int tt = 0; tt < 2; ++tt) {
            const int t = tbase + tt * 16 + fr;
            const bf16_t* op = OH + (size_t)t * 512 + h * 128 + 4 * fq; const bf16_t* op1 = OH1 + (size_t)t * 512 + h * 128 + 4 * fq; const bf16_t* gp = PH + (size_t)t * 2048 + 1536 + h * 128 + 4 * fq;
            float o[8][4]; float ss = 0.f;
#pragma unroll
            for (int vt = 0; vt < 8; ++vt) { const u32x2 ow = *(const u32x2*)(op + vt * 16), ox = *(const u32x2*)(op1 + vt * 16);
                o[vt][0] = acc[vt][tt][0] + (lo16(ow.x) + lo16(ox.x)); o[vt][1] = acc[vt][tt][1] + (hi16(ow.x) + hi16(ox.x)); o[vt][2] = acc[vt][tt][2] + (lo16(ow.y) + lo16(ox.y)); o[vt][3] = acc[vt][tt][3] + (hi16(ow.y) + hi16(ox.y));
                ss += (o[vt][0] * o[vt][0] + o[vt][1] * o[vt][1]) + (o[vt][2] * o[vt][2] + o[vt][3] * o[vt][3]); }
            ss += __shfl_xor(ss, 16); ss += __shfl_xor(ss, 32);
            const float rs = rsqrtf(ss * (1.0f / 128.0f) + 1e-6f);
#pragma unroll
            for (int vt = 0; vt < 8; ++vt) { const u32x2 gw = *(const u32x2*)(gp + vt * 16); const float4 n4 = *(const float4*)(nw + h * 128 + vt * 16 + 4 * fq);
                const float g4[4] = {lo16(gw.x), hi16(gw.x), lo16(gw.y), hi16(gw.y)}, nn[4] = {n4.x, n4.y, n4.z, n4.w}; float r[4];
#pragma unroll
                for (int e = 0; e < 4; ++e) r[e] = o[vt][e] * rs * nn[e] * g4[e] * sigm(g4[e]);
                *(u32x2*)(YB + (size_t)t * 512 + h * 128 + vt * 16 + 4 * fq) = pack4(r[0], r[1], r[2], r[3]); }
        }
    }
    if (wave == 0) {
        for (int item = bidx(); item < 128; item += gridDim.x) {
            const int s = item >> 2, h = item & 3;
            const float nw0 = nw[h * 128 + lane], nw1 = nw[h * 128 + 64 + lane];
#pragma unroll 4
            for (int tt = 0; tt < 32; ++tt) {
                const int t = T_P + s * 32 + tt;
                const float o0 = bf2f(OH[(size_t)t * 512 + h * 128 + lane]) + bf2f(OH1[(size_t)t * 512 + h * 128 + lane]), o1 = bf2f(OH[(size_t)t * 512 + h * 128 + 64 + lane]) + bf2f(OH1[(size_t)t * 512 + h * 128 + 64 + lane]);
                const float g0 = bf2f(PH[(size_t)t * 2048 + 1536 + h * 128 + lane]), g1 = bf2f(PH[(size_t)t * 2048 + 1536 + h * 128 + 64 + lane]);
                const float rs = rsqrtf(wsum_fast(o0 * o0 + o1 * o1) * (1.0f / 128.0f) + 1e-6f);
                YB[(size_t)t * 512 + h * 128 + lane] = f2bf(o0 * rs * nw0 * g0 * sigm(g0));
                YB[(size_t)t * 512 + h * 128 + 64 + lane] = f2bf(o1 * rs * nw1 * g1 * sigm(g1));
            }
        }
    }
}
__device__ void phase_final(const Ctx& p) {
    const int tid = tidx(); const int wave = __builtin_amdgcn_readfirstlane(tid >> 6), lane = tid & 63;
    const float* nf = INP(p, 29); const float* PART = (const float*)(uptr(p.ws) + OFF_PART);
    for (int row = bidx() * 8 + wave; row < T_ALL; row += gridDim.x * 8) {
        float* xp = p.out + (size_t)row * 1024; float4 v[4]; float ss = 0.f;
#pragma unroll
        for (int i = 0; i < 4; ++i) { v[i] = *(const float4*)(xp + i * 256 + lane * 4);
            if (row >= T_P) { const float* pr = PART + (size_t)(row - T_P) * 1024 + i * 256 + lane * 4;
#pragma unroll
                for (int sl = 0; sl < 8; ++sl) { const float4 q = *(const float4*)(pr + (size_t)sl * 1024 * 1024); v[i].x += q.x; v[i].y += q.y; v[i].z += q.z; v[i].w += q.w; } }
            ss += v[i].x * v[i].x + v[i].y * v[i].y + v[i].z * v[i].z + v[i].w * v[i].w; }
        const float s = rsqrtf(wsum(ss) * (1.0f / 1024.0f) + 1e-6f);
#pragma unroll
        for (int i = 0; i < 4; ++i) { const int c = i * 256 + lane * 4; const float4 w = *(const float4*)(nf + c);
            v[i].x *= s * w.x; v[i].y *= s * w.y; v[i].z *= s * w.z; v[i].w *= s * w.w; *(float4*)(xp + c) = v[i]; }
    }
}
#define VRES 1
#define GEMM_PRO unsigned char* ws = uptr(p.ws); float* rowss = (float*)(ws + OFF_SM + SM_ROWSS); bf16_t* XB = (bf16_t*)(ws + OFF_XB); \
    const float* rs_mix = rowss + (size_t)(2 * l) * T_ALL; float* rs_ffn = rowss + (size_t)(2 * l + 1) * T_ALL; float* rs_next = rowss + (size_t)(2 * l + 2) * T_ALL; (void)rs_mix; (void)rs_ffn; (void)rs_next; (void)XB
__global__ void __launch_bounds__(512, 2) mega_fwd(Params prm) {
    extern __shared__ __attribute__((aligned(16))) unsigned char lds_raw[];
    LAS unsigned char* lds = (LAS unsigned char*)lds_raw;
    cg::grid_group grid = cg::this_grid();
    Ctx p; p.ws = prm.ws; p.out = prm.out;
    { unsigned long long* tb = (unsigned long long*)(prm.ws + OFF_SM + SM_TBL + (size_t)blockIdx.x * 256);
      if (threadIdx.x == 0) {
#define TB(i) tb[i] = (unsigned long long)prm.in[i];
          TB(0) TB(1) TB(2) TB(3) TB(4) TB(5) TB(6) TB(7) TB(8) TB(9) TB(10) TB(11) TB(12) TB(13) TB(14) TB(15) TB(16) TB(17) TB(18) TB(19) TB(20) TB(21) TB(22) TB(23) TB(24) TB(25) TB(26) TB(27) TB(28) TB(29)
#undef TB
      }
      __threadfence_block(); __syncthreads();
      p.tbl = tb; }
    volatile LAS unsigned* xst = (volatile LAS unsigned*)(lds + 131072);
    if (threadIdx.x < 2) xst[threadIdx.x] = 0u;
    __syncthreads();
    XcdBarrier xb = xcd_barrier_post((unsigned*)(prm.ws + OFF_SM + SM_BAR), xst);
    grid.sync();
    phase_x0(p);
#pragma unroll 1
    for (int ph = 0; ph < 28; ++ph) {
        const int l = ph >= 14 ? 1 : 0, k = ph - 14 * l;
        switch (k) {
        case 0: if (l == 1) { GEMM_PRO; finalize_sample(p, rowss + (size_t)2 * T_ALL); } else phase_convert_early(p, 0, lds, bidx(), (int)gridDim.x); break;
        case 1: { GEMM_PRO; EpiBf<0> E; E.O = (bf16_t*)(ws + OFF_A); E.ldc = 2048; E.rowss = rs_mix; run_gemm(lds, XB, (const bf16_t*)(ws + OFF_WRW), 2048, 1024, E); } break;
        case 2: phase_prep(p, l, lds); break;
        case 3: phase_rwkv_scan(p, l, lds); break;
        case 4: phase_rwkv_chain(p, l); break;
        case 5: phase_rwkv_fix(p, l); break;
        case 6: { GEMM_PRO; EpiBf<0> E; E.O = (bf16_t*)(ws + OFF_A); E.ldc = 2048; E.rowss = rs_mix; run_gemm(lds, XB, (const bf16_t*)(ws + OFF_WHG), 2048, 1024, E);
                  { const int b = bidx(); phase_convert_late(p, l, lds, b >= 32 ? b - 32 : -1, (int)gridDim.x - 32); } } break;
        case 7: phase_hgrn_scan(p, l, lds); break;
        case 8: phase_hgrn_chain(p, l); break;
        case 9: phase_hgrn_fix(p, l, lds); break;
        case 10: {
            GEMM_PRO; bf16_t* TA = (bf16_t*)(ws + OFF_A); bf16_t* TB = (bf16_t*)(ws + OFF_A + 34 * MiB);
            { EpiBf<2> E; E.O = TA; E.ldc = 1024; E.rowss = nullptr; run_gemm(lds, (const bf16_t*)(ws + OFF_B), (const bf16_t*)(ws + OFF_WOA), 1024, 512, E); }
            { EpiGate<0> E; E.M = TA; E.Tm = TA; E.rowss = rs_mix; run_gemm(lds, XB, (const bf16_t*)(ws + OFF_WGA), 1024, 1024, E); }
            { EpiBf<2> E; E.O = TB; E.ldc = 1024; E.rowss = nullptr; run_gemm(lds, (const bf16_t*)(ws + OFF_B + SLOT), (const bf16_t*)(ws + OFF_WOB), 1024, 512, E); }
            { EpiGate<1> E; E.M = TA; E.Tm = TB; E.rowss = rs_mix; run_gemm(lds, XB, (const bf16_t*)(ws + OFF_WGB), 1024, 1024, E); }
        } break;
        case 11: { GEMM_PRO; EpiResid E; E.X = p.out; E.XB = XB; E.rowss_out = rs_ffn; E.Xp0 = l == 0 ? INP(p, 0) : nullptr; E.Xs0 = l == 0 ? INP(p, 1) : nullptr; run_gemm(lds, (const bf16_t*)(ws + OFF_A), (const bf16_t*)(ws + OFF_WO), 1024, 1024, E);
                   if (l == 0) { const int b = bidx(); phase_convert_early(p, 1, lds, b >= 16 ? b - 16 : -1, (int)gridDim.x - 16); } } break;
        case 12: { GEMM_PRO; EpiBf<1> E; E.O = (bf16_t*)(ws + OFF_A); E.ldc = 4096; E.rowss = rs_ffn; run_gemm(lds, XB, (const bf16_t*)(ws + OFF_WUP), 4096, 1024, E); } break;
        default: { GEMM_PRO; EpiResid E; E.X = p.out; E.XB = XB; E.rowss_out = rs_next; E.Xp0 = nullptr; E.Xs0 = nullptr; run_ffn_down(lds, (const bf16_t*)(ws + OFF_A), (const bf16_t*)(ws + OFF_WDN), E, (float*)(ws + OFF_PART)); } break;
        }
        xcd_barrier(xb);
    }
    phase_final(p);
}

extern "C" void kernel_launch(void* const* d_in, const int* in_sizes, int n_in, void* d_out, int out_size, void* d_ws, size_t ws_size, hipStream_t stream) {
    constexpr int LDS_BYTES = 131072 + 64;
    static int grid_blocks = 0;
    if (grid_blocks == 0) {
        int dev = 0, cus = 0, per_cu = 0;
        hipGetDevice(&dev);
        hipDeviceGetAttribute(&cus, hipDeviceAttributeMultiprocessorCount, dev);
        hipFuncSetAttribute((const void*)mega_fwd, hipFuncAttributeMaxDynamicSharedMemorySize, LDS_BYTES);
        hipOccupancyMaxActiveBlocksPerMultiprocessor(&per_cu, (const void*)mega_fwd, 512, LDS_BYTES);
        if (per_cu < 1) per_cu = 1;
        grid_blocks = cus;
        if (n_in != 30 || ws_size < WS_NEED) { fprintf(stderr, "kernel_launch: unexpected n_in %d / ws_size %zu\n", n_in, ws_size); }
    }
    if (hipMemsetAsync((unsigned char*)d_ws + OFF_SM + SM_BAR, 0, XCD_BAR_WORDS * 4, stream) != hipSuccess) fprintf(stderr, "memset failed\n");
    Params p{};
    for (int i = 0; i < 30; ++i) p.in[i] = (const float*)d_in[i];
    p.out = (float*)d_out; p.ws = (unsigned char*)d_ws;
    void* args[] = {&p};
    hipError_t e = hipLaunchCooperativeKernel((const void*)mega_fwd, dim3(grid_blocks), dim3(512), args, LDS_BYTES, stream);
    if (e != hipSuccess) fprintf(stderr, "cooperative launch failed: %s (grid %d)\n", hipGetErrorString(e), grid_blocks);
}
```

```cpp
#include <hip/hip_runtime.h>
#include <hip/hip_cooperative_groups.h>
#include <cstdio>
namespace cg = cooperative_groups;
#define VRES 1
namespace pg8 {
#define PG8_LAS __attribute__((address_space(3)))
typedef unsigned short bf16_t;
typedef short bf16x8 __attribute__((ext_vector_type(8)));
typedef float f32x4 __attribute__((ext_vector_type(4)));
typedef unsigned u32x4 __attribute__((ext_vector_type(4)));
constexpr int BM = 256, BK = 64, HALF = 128, HTB = HALF * BK * 2  , STAGE_BYTES = 8 * HTB, NXCD = 8, WGM = 8;

__host__ __device__ __forceinline__ int lds_byte(int r, int c) { const int st = (r >> 4) * 2 + (c >> 5), rr = r & 15, cc = c & 31, ob = rr * 64 + cc * 2; return st * 1024 + (ob ^ (((ob >> 9) & 1) << 5)); }
__host__ __device__ __forceinline__ void stage_rc(int b, int& R, int& C) { const int st = b / 1024, sb = b % 1024, swz = sb ^ (((sb >> 9) & 1) << 5); R = (st >> 1) * 16 + swz / 64; C = (st & 1) * 32 + (swz % 64) / 2; }
__host__ __device__ __forceinline__ int perm32(int rho) { const int n = rho >> 4, i = rho & 15; return 8 * (i >> 2) + 4 * n + (i & 3); }

struct Unit { int pm, pn; };
struct Gemm { const bf16_t* A; const bf16_t* Bt; int M, N, K, ld; };

struct StaticOrder {
    int nM, nN, nwg, G, c;
    __host__ __device__ void init(int M, int N, int G_, int c_) { nM = M / BM; nN = N / BM; nwg = nM * nN; G = G_; c = c_; }
    __host__ __device__ bool next(int i, Unit& u) const {
        const long L = (long)i * G + c; if (L >= nwg) return false;
        int wgid = (int)L; { const int q = nwg / NXCD, r = nwg % NXCD, xcd = wgid % NXCD, off = wgid / NXCD; wgid = (xcd < r ? xcd * (q + 1) : r * (q + 1) + (xcd - r) * q) + off; }
        const int nig = WGM * nN, gid = wgid / nig, fm = gid * WGM, gsz = (nM - fm) < WGM ? (nM - fm) : WGM;
        u.pm = fm + ((wgid % nig) % gsz); u.pn = (wgid % nig) / gsz; return true;
    }
    __device__ __forceinline__ void a_ready(const Unit&) const {}
    __device__ __forceinline__ void done(const Unit&) const {}
};
typedef float f32x2_cv __attribute__((ext_vector_type(2)));
typedef __bf16 bf16x2_cv __attribute__((ext_vector_type(2)));
__device__ __forceinline__ unsigned cvt_pk_bf16(float lo, float hi) { const f32x2_cv v = {lo, hi}; const bf16x2_cv b = __builtin_convertvector(v, bf16x2_cv); return __builtin_bit_cast(unsigned, b); }
template <class Epi, class Sched, bool STAMP = false>
__device__ __forceinline__ void gemm_phase(PG8_LAS unsigned char* lds, const Gemm g, const Sched& S, const Epi& E, unsigned long long* stamps) {
    int tid_ = threadIdx.x; asm volatile("" : "+v"(tid_)); const int tid = tid_, wid = __builtin_amdgcn_readfirstlane(tid >> 6), lane = tid & 63, wr = wid >> 2, wc = wid & 3, fr = lane & 15, fq = lane >> 4;
    const int K = g.K, nt = K / BK, LD = g.ld;
    unsigned voffA[2], voffB[2];
#pragma unroll
    for (int i = 0; i < 2; ++i) { int R, C; stage_rc(tid * 16 + i * 8192, R, C); const int Rb = Epi::PERM ? ((R & ~31) + perm32(R & 31)) : R;
        voffA[i] = (unsigned)(R * LD + C) * 2u; voffB[i] = (unsigned)(Rb * LD + C) * 2u; }
    const size_t kstep = (size_t)(BK * 2);
    const size_t hstep = (size_t)HALF * LD * 2;
    const size_t tstep = 2 * hstep;
    const unsigned ldsw = (unsigned)wid * 1024u;
    const int aoff = lds_byte(wr * 64 + fr, fq * 8), boff = lds_byte(wc * 32 + fr, fq * 8);
#define PG8_SA(b, h) (((b) * 2 + (h)) * HTB)
#define PG8_SB(b, h) ((4 + (b) * 2 + (h)) * HTB)
#define PG8_STAGE(bufoff, gbase, voff) do { _Pragma("unroll") for (int _i = 0; _i < 2; ++_i) \
        __builtin_amdgcn_global_load_lds((const unsigned*)((const char*)(gbase) + (voff)[_i]), (PG8_LAS unsigned*)(lds + (bufoff) + ldsw + _i * 8192), 16, 0, 0); } while (0)
#define PG8_LDA(dst, b, h) do { _Pragma("unroll") for (int m = 0; m < 4; ++m) _Pragma("unroll") for (int k = 0; k < 2; ++k) dst[m][k] = *(const PG8_LAS bf16x8*)(lds + PG8_SA(b, h) + aoff + m * 2048 + k * 1024); } while (0)
#define PG8_LDB(dst, b, h) do { _Pragma("unroll") for (int n = 0; n < 2; ++n) _Pragma("unroll") for (int k = 0; k < 2; ++k) dst[n][k] = *(const PG8_LAS bf16x8*)(lds + PG8_SB(b, h) + boff + n * 2048 + k * 1024); } while (0)
#define PG8_MMA(ai, bj, At, Bt) do { __builtin_amdgcn_s_setprio(1); _Pragma("unroll") for (int m = 0; m < 4; ++m) _Pragma("unroll") for (int n = 0; n < 2; ++n) _Pragma("unroll") for (int k = 0; k < 2; ++k) \
        acc[ai][bj][m][n] = __builtin_amdgcn_mfma_f32_16x16x32_bf16(Bt[n][k], At[m][k], acc[ai][bj][m][n], 0, 0, 0); __builtin_amdgcn_s_setprio(0); } while (0)
#define PG8_WAIT_V(n) asm volatile("s_waitcnt vmcnt(" #n ")" ::: "memory")
#define PG8_WAIT_L(n) asm volatile("s_waitcnt lgkmcnt(" #n ")" ::: "memory")
#define PG8_BAR __builtin_amdgcn_s_barrier()
#define PG8_SCHED __builtin_amdgcn_sched_barrier(0)
    Unit cur, nxt; int ui = 0;
    if (!S.next(0, cur)) return;
    f32x4 acc[2][2][4][2];
#pragma unroll
    for (int a = 0; a < 2; ++a)
#pragma unroll
        for (int b = 0; b < 2; ++b)
#pragma unroll
            for (int m = 0; m < 4; ++m)
#pragma unroll
                for (int n = 0; n < 2; ++n) acc[a][b][m][n] = (f32x4){0.f, 0.f, 0.f, 0.f};
    bf16x8 At[4][2], B0[2][2], B1[2][2];
    const char* cA = (const char*)g.A + (size_t)cur.pm * tstep; const char* cB = (const char*)g.Bt + (size_t)cur.pn * tstep;
    S.a_ready(cur);
    PG8_STAGE(PG8_SB(0, 0), cB, voffB); PG8_STAGE(PG8_SA(0, 0), cA, voffA); PG8_STAGE(PG8_SB(0, 1), cB + hstep, voffB); PG8_STAGE(PG8_SA(0, 1), cA + hstep, voffA);
    if (wr == 1) PG8_BAR;
    PG8_WAIT_V(4); PG8_BAR;
    PG8_STAGE(PG8_SB(1, 0), cB + kstep, voffB); PG8_STAGE(PG8_SA(1, 0), cA + kstep, voffA); PG8_STAGE(PG8_SB(1, 1), cB + hstep + kstep, voffB);
    PG8_WAIT_V(6); PG8_BAR;
    for (;;) {
        const bool has_next = S.next(ui + 1, nxt);
        const char* nA = has_next ? (const char*)g.A + (size_t)nxt.pm * tstep : cA; const char* nB = has_next ? (const char*)g.Bt + (size_t)nxt.pn * tstep : cB;
        for (int t = 0; t < nt; t += 2) {
            const bool last = (t == nt - 2);
            const char* a1 = cA + (size_t)(t + 1) * kstep;
            const char* a2 = last ? nA : cA + (size_t)(t + 2) * kstep; const char* b2 = last ? nB : cB + (size_t)(t + 2) * kstep;
            const char* a3 = a2 + kstep; const char* b3 = b2 + kstep;
            if (last && has_next) S.a_ready(nxt);
            PG8_LDB(B0, 0, 0); PG8_SCHED; PG8_LDA(At, 0, 0); PG8_STAGE(PG8_SA(1, 1), a1 + hstep, voffA);
            PG8_WAIT_L(8); PG8_BAR; PG8_WAIT_L(0); PG8_MMA(0, 0, At, B0); PG8_BAR; PG8_SCHED;
            PG8_LDB(B1, 0, 1); PG8_STAGE(PG8_SB(0, 0), b2, voffB);
            PG8_BAR; PG8_WAIT_L(0); PG8_MMA(0, 1, At, B1); PG8_BAR;
            PG8_LDA(At, 0, 1); PG8_STAGE(PG8_SA(0, 0), a2, voffA);
            PG8_BAR; PG8_WAIT_L(0); PG8_MMA(1, 0, At, B0); PG8_BAR; PG8_SCHED;
            PG8_STAGE(PG8_SB(0, 1), b2 + hstep, voffB);
            PG8_WAIT_V(6); PG8_BAR; PG8_MMA(1, 1, At, B1); PG8_BAR;
            PG8_LDB(B0, 1, 0); PG8_SCHED; PG8_LDA(At, 1, 0); PG8_STAGE(PG8_SA(0, 1), a2 + hstep, voffA);
            PG8_WAIT_L(8); PG8_BAR; PG8_WAIT_L(0); PG8_MMA(0, 0, At, B0); PG8_BAR; PG8_SCHED;
            PG8_LDB(B1, 1, 1); PG8_STAGE(PG8_SB(1, 0), b3, voffB);
            PG8_BAR; PG8_WAIT_L(0); PG8_MMA(0, 1, At, B1); PG8_BAR;
            PG8_LDA(At, 1, 1); PG8_STAGE(PG8_SA(1, 0), a3, voffA);
            PG8_BAR; PG8_WAIT_L(0); PG8_MMA(1, 0, At, B0); PG8_BAR; PG8_SCHED;
            PG8_STAGE(PG8_SB(1, 1), b3 + hstep, voffB);
            PG8_WAIT_V(6); PG8_BAR; PG8_MMA(1, 1, At, B1); PG8_BAR;
        }
        if constexpr (!Epi::AFTER_DRAIN) { E(acc, cur, wr, wc, fr, fq); S.done(cur); }
        if (!has_next) break;
#pragma unroll
        for (int a = 0; a < 2; ++a)
#pragma unroll
            for (int b = 0; b < 2; ++b)
#pragma unroll
                for (int m = 0; m < 4; ++m)
#pragma unroll
                    for (int n = 0; n < 2; ++n) acc[a][b][m][n] = (f32x4){0.f, 0.f, 0.f, 0.f};
        cur = nxt; cA = nA; cB = nB; ++ui;
    }
    PG8_WAIT_V(0);
    if (wr == 0) PG8_BAR;
    PG8_BAR;
    if constexpr (Epi::AFTER_DRAIN) { E.fused(acc, cur, wr, wc, fr, fq, lds, wid, lane); S.done(cur); }
#undef PG8_SA
#undef PG8_SB
#undef PG8_STAGE
#undef PG8_LDA
#undef PG8_LDB
#undef PG8_MMA
#undef PG8_WAIT_V
#undef PG8_WAIT_L
#undef PG8_BAR
#undef PG8_SCHED
}
}
using pg8::bf16_t; using pg8::bf16x8; using pg8::f32x4; using pg8::u32x4; using pg8::cvt_pk_bf16;
typedef unsigned u32x2 __attribute__((ext_vector_type(2)));
#define LAS PG8_LAS

constexpr int T_ALL = 17408, T_P = 16384;
constexpr size_t MiB = (size_t)1 << 20;
constexpr size_t OFF_WRW = 0, OFF_WHG = 4 * MiB, OFF_WGA = 8 * MiB, OFF_WGB = 10 * MiB, OFF_WOA = 12 * MiB, OFF_WOB = 13 * MiB, OFF_WO = 14 * MiB, OFF_WUP = 16 * MiB, OFF_WDN = 24 * MiB;
constexpr size_t OFF_G = 8 * MiB;
constexpr size_t OFF_SM = 32 * MiB;
constexpr size_t SM_W2T = 0, SM_A2T = 65536, SM_G2T = 131072, SM_V1T = 294912, SM_V2T = 327680, SM_ROWSS = 393216, SM_BONUS = 786432, SM_PGH = 1376256;
constexpr size_t OFF_XB = 34 * MiB, OFF_V0 = 68 * MiB, OFF_A = 85 * MiB, OFF_B = 153 * MiB, SLOT = 17 * MiB;
constexpr size_t WS_NEED = 255 * MiB;
constexpr size_t O_SHP = 17825792, O_RWP = 17833088, O_HGP = 17964160, O_SHS = 18226304, O_RWS = 18343040, O_HGS = 20440192;

__device__ __forceinline__ int tidx() { int t = threadIdx.x; asm volatile("" : "+v"(t)); return t; }
__device__ __forceinline__ int bidx() { int b = blockIdx.x; asm volatile("" : "+s"(b)); return b; }
#define GAS __attribute__((address_space(1)))
__device__ __forceinline__ unsigned char* uptr(unsigned char* q) {
    const unsigned long long v = (unsigned long long)q; unsigned lo = __builtin_amdgcn_readfirstlane((unsigned)v), hi = __builtin_amdgcn_readfirstlane((unsigned)(v >> 32));
    asm volatile("" : "+s"(lo), "+s"(hi));
    return (unsigned char*)(GAS unsigned char*)(((unsigned long long)hi << 32) | lo); }
struct Params { const float* in[30]; float* out; unsigned char* ws; };
struct Ctx { unsigned char* ws; float* out; const unsigned long long* tbl; };
__device__ __forceinline__ const float* ldp(const unsigned long long* tbl, int i) {
    const unsigned long long v = *(const volatile unsigned long long*)(tbl + i);
    const unsigned lo = __builtin_amdgcn_readfirstlane((unsigned)v), hi = __builtin_amdgcn_readfirstlane((unsigned)(v >> 32));
    return (const float*)(GAS const float*)(((unsigned long long)hi << 32) | lo); }
#define INP(p, i) ldp((p).tbl, i)
constexpr size_t SM_TBL = 1703936, SM_BAR = 1769472;
#define XB_TMO      128
#define XB_XCNT(j)  (256  + 64 * (j))
#define XB_XSUB(j)  (1280 + 64 * (j))
#define XB_XGEN(j)  (2304 + 64 * (j))
#define XB_TOP      3328
#define XB_TOPGEN   3392
#define XCD_BAR_WORDS 3456
#define XB_SPIN_CAP (1u << 18)

__device__ __forceinline__ unsigned xb_ld(unsigned* p)              { return __hip_atomic_load(p, __ATOMIC_RELAXED, __HIP_MEMORY_SCOPE_AGENT); }
__device__ __forceinline__ unsigned xb_add(unsigned* p, unsigned v) { return __hip_atomic_fetch_add(p, v, __ATOMIC_RELAXED, __HIP_MEMORY_SCOPE_AGENT); }
__device__ __forceinline__ unsigned xb_xcc_id() { return (unsigned)__builtin_amdgcn_s_getreg((3 << 11) | 20) & 0xFu; }
#define XB_SPIN(cond, bar) do { unsigned _sp = 0; while (cond) { __builtin_amdgcn_s_sleep(1); \
    if ((++_sp & 255u) == 0u) { if (xb_ld(&(bar)[XB_TMO])) break; if (_sp > XB_SPIN_CAP) { atomicAdd(&(bar)[XB_TMO], 1u); break; } } } } while (0)

struct XcdBarrier {
    unsigned* bar; unsigned x;
    volatile LAS unsigned* st;
};

__device__ __forceinline__ XcdBarrier xcd_barrier_post(unsigned* bar, volatile LAS unsigned* st) {
    XcdBarrier b; b.bar = bar; b.x = xb_xcc_id(); b.st = st;
    if (threadIdx.x == 0) (void)xb_add(&bar[XB_XCNT(b.x)], 1u);
    return b;
}
__device__ __forceinline__ void xcd_barrier_complete(unsigned* bar, unsigned x, unsigned& nloc, unsigned& nx) {
    const unsigned G = gridDim.x * gridDim.y * gridDim.z;
    unsigned sum, cnt, mine, sp = 0u;
    for (;;) {
        sum = 0u; cnt = 0u; mine = 0u;
#pragma unroll
        for (unsigned j = 0; j < 16; ++j) { const unsigned c = xb_ld(&bar[XB_XCNT(j)]); sum += c; cnt += (c > 0u) ? 1u : 0u; mine = (j == x) ? c : mine; }
        if (sum == G) break;
        __builtin_amdgcn_s_sleep(1);
        if ((++sp & 255u) == 0u) { if (xb_ld(&bar[XB_TMO])) break; if (sp > XB_SPIN_CAP) { atomicAdd(&bar[XB_TMO], 1u); break; } }
    }
    nloc = mine > 0u ? mine : 1u; nx = cnt > 0u ? cnt : 1u;
}

__device__ __forceinline__ void xcd_barrier(const XcdBarrier& b) {
    asm volatile("s_waitcnt vmcnt(0)" ::: "memory");
    __syncthreads();
    if (threadIdx.x == 0) {
        unsigned* bar = b.bar;
        __builtin_amdgcn_s_waitcnt(0);
        unsigned nloc = b.st[0], nx = b.st[1];
        if (nloc == 0u) { xcd_barrier_complete(bar, b.x, nloc, nx); b.st[0] = nloc; b.st[1] = nx; }
        const unsigned old = xb_add(&bar[XB_XSUB(b.x)], 1u);
        const unsigned gen = old / nloc;
        if (old + 1u == (gen + 1u) * nloc) {
            __builtin_amdgcn_fence(__ATOMIC_RELEASE, "agent");
            asm volatile("s_waitcnt vmcnt(0)" ::: "memory");
            const unsigned og = xb_add(&bar[XB_TOP], 1u);
            const unsigned tg = og / nx;
            if (og + 1u == (tg + 1u) * nx) xb_add(&bar[XB_TOPGEN], 1u);
            else XB_SPIN(xb_ld(&bar[XB_TOPGEN]) == tg, bar);
            __builtin_amdgcn_fence(__ATOMIC_ACQUIRE, "agent");
            xb_add(&bar[XB_XGEN(b.x)], 1u);
            asm volatile("s_waitcnt vmcnt(0)" ::: "memory");
        } else {
            XB_SPIN(xb_ld(&bar[XB_XGEN(b.x)]) == gen, bar);
            __builtin_amdgcn_fence(__ATOMIC_ACQUIRE, "agent");
            asm volatile("s_waitcnt vmcnt(0)" ::: "memory");
        }
    }
    __syncthreads();
}


__device__ __forceinline__ float bf2f(unsigned short b) { return __uint_as_float((unsigned)b << 16); }
__device__ __forceinline__ unsigned short f2bf(float f) { unsigned u = __float_as_uint(f); u += 0x7FFFu + ((u >> 16) & 1u); return (unsigned short)(u >> 16); }
__device__ __forceinline__ float sigm(float x) { return __builtin_amdgcn_rcpf(1.0f + __expf(-x)); }
__device__ __forceinline__ float tanh_fast(float x) { return 1.0f - 2.0f * __builtin_amdgcn_rcpf(1.0f + __expf(2.0f * x)); }
__device__ __forceinline__ float rdl(float x, int i) { return __uint_as_float(__builtin_amdgcn_readlane(__float_as_uint(x), i)); }
__device__ __forceinline__ float wsum(float x) {
#pragma unroll
    for (int o = 32; o; o >>= 1) x += __shfl_xor(x, o);
    return x; }
__device__ __forceinline__ float lo16(unsigned w) { return __uint_as_float(w << 16); }
__device__ __forceinline__ float hi16(unsigned w) { return __uint_as_float(w & 0xffff0000u); }
__device__ __forceinline__ float rstd_of(const float* rowss, int row) { return rsqrtf(rowss[row] * (1.0f / 1024.0f) + 1e-6f); }

template <int MODE> struct EpiBf {
    static constexpr bool PERM = true, AFTER_DRAIN = false;
    bf16_t* O; int ldc; const float* rowss;
    __device__ __forceinline__ void operator()(const f32x4 (&acc)[2][2][4][2], const pg8::Unit& u, int wr, int wc, int fr, int fq) const {
        const int row0 = u.pm * 256 + wr * 64 + fr, col0 = u.pn * 256 + wc * 32 + 8 * fq;
#pragma unroll
        for (int ai = 0; ai < 2; ++ai)
#pragma unroll
            for (int m = 0; m < 4; ++m) {
                const int row = row0 + ai * 128 + m * 16;
                const float s = (MODE == 2) ? 1.0f : rstd_of(rowss, row);
                bf16_t* rowp = O + (size_t)row * ldc + col0;
#pragma unroll
                for (int bj = 0; bj < 2; ++bj) {
                    f32x4 v0 = acc[ai][bj][m][0] * s, v1 = acc[ai][bj][m][1] * s;
                    if (MODE == 1) {
#pragma unroll
                        for (int j = 0; j < 4; ++j) { const float a = fmaxf(v0[j], 0.f), b = fmaxf(v1[j], 0.f); v0[j] = a * a; v1[j] = b * b; } }
                    u32x4 w; w.x = cvt_pk_bf16(v0[0], v0[1]); w.y = cvt_pk_bf16(v0[2], v0[3]); w.z = cvt_pk_bf16(v1[0], v1[1]); w.w = cvt_pk_bf16(v1[2], v1[3]);
                    *(u32x4*)(rowp + bj * 128) = w; } }
    }
};
template <int ACC> struct EpiGate {
    static constexpr bool PERM = true, AFTER_DRAIN = false;
    bf16_t* M; const bf16_t* Tm; const float* rowss;
    __device__ __forceinline__ void operator()(const f32x4 (&acc)[2][2][4][2], const pg8::Unit& u, int wr, int wc, int fr, int fq) const {
        const int row0 = u.pm * 256 + wr * 64 + fr, col0 = u.pn * 256 + wc * 32 + 8 * fq;
#pragma unroll
        for (int ai = 0; ai < 2; ++ai)
#pragma unroll
            for (int m = 0; m < 4; ++m) {
                const int row = row0 + ai * 128 + m * 16;
                const float s = rstd_of(rowss, row);
#pragma unroll
                for (int bj = 0; bj < 2; ++bj) {
                    const size_t off = (size_t)row * 1024 + col0 + bj * 128;
                    const u32x4 tv = *(const u32x4*)(Tm + off);
                    u32x4 pv = (u32x4){0u, 0u, 0u, 0u};
                    if (ACC) pv = *(const u32x4*)(M + off);
                    const f32x4 a0 = acc[ai][bj][m][0] * s, a1 = acc[ai][bj][m][1] * s;
                    float o[8];
                    o[0] = sigm(a0[0]) * lo16(tv.x); o[1] = sigm(a0[1]) * hi16(tv.x); o[2] = sigm(a0[2]) * lo16(tv.y); o[3] = sigm(a0[3]) * hi16(tv.y);
                    o[4] = sigm(a1[0]) * lo16(tv.z); o[5] = sigm(a1[1]) * hi16(tv.z); o[6] = sigm(a1[2]) * lo16(tv.w); o[7] = sigm(a1[3]) * hi16(tv.w);
                    if (ACC) { o[0] += lo16(pv.x); o[1] += hi16(pv.x); o[2] += lo16(pv.y); o[3] += hi16(pv.y); o[4] += lo16(pv.z); o[5] += hi16(pv.z); o[6] += lo16(pv.w); o[7] += hi16(pv.w); }
                    u32x4 w; w.x = cvt_pk_bf16(o[0], o[1]); w.y = cvt_pk_bf16(o[2], o[3]); w.z = cvt_pk_bf16(o[4], o[5]); w.w = cvt_pk_bf16(o[6], o[7]);
                    *(u32x4*)(M + off) = w; } }
    }
};
struct EpiResid {
    static constexpr bool PERM = false, AFTER_DRAIN = false;
    float* X; bf16_t* XB; float* rowss_out; const float* Xp0; const float* Xs0;
    __device__ __forceinline__ void operator()(const f32x4 (&acc)[2][2][4][2], const pg8::Unit& u, int wr, int wc, int fr, int fq) const {
        const int row0 = u.pm * 256 + wr * 64 + fr, col0 = u.pn * 256 + wc * 32 + 4 * fq;
#pragma unroll
        for (int ai = 0; ai < 2; ++ai)
#pragma unroll
            for (int m = 0; m < 4; ++m) {
                const int row = row0 + ai * 128 + m * 16;
                float* xp = X + (size_t)row * 1024 + col0; bf16_t* bp = XB + (size_t)row * 1024 + col0;
                const float* xi = Xp0 ? (row < T_P ? Xp0 + (size_t)row * 1024 + col0 : Xs0 + (size_t)(row - T_P) * 1024 + col0) : xp;
                float ss = 0.f;
#pragma unroll
                for (int bj = 0; bj < 2; ++bj)
#pragma unroll
                    for (int n = 0; n < 2; ++n) {
                        f32x4 xv = *(const f32x4*)(xi + bj * 128 + n * 16) + acc[ai][bj][m][n];
                        *(f32x4*)(xp + bj * 128 + n * 16) = xv;
                        ss += (xv[0] * xv[0] + xv[1] * xv[1]) + (xv[2] * xv[2] + xv[3] * xv[3]);
                        u32x2 w; w.x = cvt_pk_bf16(xv[0], xv[1]); w.y = cvt_pk_bf16(xv[2], xv[3]);
                        *(u32x2*)(bp + bj * 128 + n * 16) = w; }
                ss += __shfl_xor(ss, 16); ss += __shfl_xor(ss, 32);
                if (fq == 0) atomicAdd(rowss_out + row, ss); }
    }
};
template <class Epi> __device__ __forceinline__ void run_gemm(LAS unsigned char* lds, const bf16_t* A, const bf16_t* Bt, int N, int K, const Epi& E) {
    pg8::StaticOrder S; S.init(T_ALL, N, (int)gridDim.x, bidx());
    pg8::Gemm g; g.A = A; g.Bt = Bt; g.M = T_ALL; g.N = N; g.K = K; g.ld = K;
    pg8::gemm_phase<Epi, pg8::StaticOrder, false>(lds, g, S, E, nullptr);
}


struct OneUnit { int pm, pn, valid;
    __device__ bool next(int i, pg8::Unit& u) const { if (i != 0 || !valid) return false; u.pm = pm; u.pn = pn; return true; }
    __device__ __forceinline__ void a_ready(const pg8::Unit&) const {}
    __device__ __forceinline__ void done(const pg8::Unit&) const {} };
struct EpiPartial {
    static constexpr bool PERM = false, AFTER_DRAIN = false;
    float* PART;
    __device__ __forceinline__ void operator()(const f32x4 (&acc)[2][2][4][2], const pg8::Unit& u, int wr, int wc, int fr, int fq) const {
        const int row0 = (u.pm - 64) * 256 + wr * 64 + fr, col0 = u.pn * 256 + wc * 32 + 4 * fq;
#pragma unroll
        for (int ai = 0; ai < 2; ++ai)
#pragma unroll
            for (int m = 0; m < 4; ++m) { float* xp = PART + (size_t)(row0 + ai * 128 + m * 16) * 1024 + col0;
#pragma unroll
                for (int bj = 0; bj < 2; ++bj)
#pragma unroll
                    for (int n = 0; n < 2; ++n) *(f32x4*)(xp + bj * 128 + n * 16) = acc[ai][bj][m][n]; }
    }
};
constexpr size_t OFF_PART = OFF_B + 4 * SLOT;
__device__ __forceinline__ void run_ffn_down(LAS unsigned char* lds, const bf16_t* HID, const bf16_t* WDN, const EpiResid& E, float* PART) {
    { pg8::StaticOrder S; S.init(T_P, 1024, (int)gridDim.x, bidx());
      pg8::Gemm g; g.A = HID; g.Bt = WDN; g.M = T_P; g.N = 1024; g.K = 4096; g.ld = 4096;
      pg8::gemm_phase<EpiResid, pg8::StaticOrder, false>(lds, g, S, E, nullptr); }
    { const int t = bidx(); OneUnit S; S.valid = t < 128; const int sl = t & 7, u = (t >> 3) & 15; S.pm = 64 + (u >> 2); S.pn = u & 3;
      pg8::Gemm g; g.A = HID + sl * 512; g.Bt = WDN + sl * 512; g.M = T_ALL; g.N = 1024; g.K = 512; g.ld = 4096;
      EpiPartial EA; EA.PART = PART + (size_t)sl * 1024 * 1024;
      pg8::gemm_phase<EpiPartial, OneUnit, false>(lds, g, S, EA, nullptr); }
}
__device__ void finalize_sample(const Ctx& p, float* rowss_out) {
    unsigned char* ws = uptr(p.ws); bf16_t* XB = (bf16_t*)(ws + OFF_XB); const float* PART = (const float*)(ws + OFF_PART);
    const int tid = tidx(); const int wave = __builtin_amdgcn_readfirstlane(tid >> 6), lane = tid & 63;
    for (int row = T_P + bidx() * 8 + wave; row < T_ALL; row += gridDim.x * 8) {
        float* src = p.out + (size_t)row * 1024; const float* pr = PART + (size_t)(row - T_P) * 1024; float ss = 0.f;
#pragma unroll
        for (int i = 0; i < 4; ++i) { const int c = i * 256 + lane * 4; float4 v = *(const float4*)(src + c);
#pragma unroll
            for (int sl = 0; sl < 8; ++sl) { const float4 q = *(const float4*)(pr + (size_t)sl * 1024 * 1024 + c); v.x += q.x; v.y += q.y; v.z += q.z; v.w += q.w; }
            *(float4*)(src + c) = v;
            ss += v.x * v.x + v.y * v.y + v.z * v.z + v.w * v.w; u32x2 w; w.x = cvt_pk_bf16(v.x, v.y); w.y = cvt_pk_bf16(v.z, v.w); *(u32x2*)(XB + (size_t)row * 1024 + c) = w; }
        ss = wsum(ss); if (lane == 0) rowss_out[row] = ss;
    }
}
__device__ void conv_T(const float* __restrict__ src, int ld, int s0, int cnt, int K, const float* __restrict__ scale, bf16_t* __restrict__ dst, int d0, LAS unsigned char* lds, int vb, int nvb) {
    LAS float* ts = (LAS float*)lds;
    const int tid = tidx(); const int nkt = K / 256, ntile = (cnt / 32) * nkt;
    if (vb < 0) return;
    for (int tile = vb; tile < ntile; tile += nvb) {
        const int n0 = (tile / nkt) * 32, k0 = (tile % nkt) * 256;
        { const int kk = tid >> 3, nq = tid & 7; float4 v[4]; float sc[4];
#pragma unroll
          for (int r = 0; r < 4; ++r) { v[r] = *(const float4*)(src + (size_t)(k0 + r * 64 + kk) * ld + s0 + n0 + nq * 4); sc[r] = scale ? scale[k0 + r * 64 + kk] : 1.0f; }
#pragma unroll
          for (int r = 0; r < 4; ++r) { LAS float* q = ts + (nq * 4) * 257 + r * 64 + kk; q[0] = v[r].x * sc[r]; q[257] = v[r].y * sc[r]; q[514] = v[r].z * sc[r]; q[771] = v[r].w * sc[r]; } }
        __syncthreads();
        { const int n = tid >> 4, kq = tid & 15;
#pragma unroll
          for (int r = 0; r < 4; ++r) { const LAS float* q = ts + n * 257 + r * 64 + kq * 4; u32x2 w; w.x = cvt_pk_bf16(q[0], q[1]); w.y = cvt_pk_bf16(q[2], q[3]);
            *(u32x2*)(dst + (size_t)(d0 + n0 + n) * K + k0 + r * 64 + kq * 4) = w; } }
        __syncthreads();
    }
}
__device__ void conv_small(const float* __restrict__ src, int ld, int cnt, int K, bf16_t* __restrict__ dst, int vb, int nvb) {
    if (vb < 0) return;
    for (int i = vb * 512 + tidx(); i < cnt * K; i += nvb * 512) { const int c = i / K, j = i % K; dst[i] = f2bf(src[(size_t)j * ld + c]); }
}
__device__ void phase_convert_early(const Ctx& p, int l, LAS unsigned char* lds, int vb, int nvb) {
    unsigned char* ws = uptr(p.ws);
    const float* win = INP(p, 6) + (size_t)l * 1024 * 5920; const float* nm = INP(p, 5) + l * 1024;
    conv_T(win, 5920, 0, 1824, 1024, nm, (bf16_t*)(ws + OFF_WRW), 0, lds, vb, nvb);
    { u32x4* z = (u32x4*)(ws + OFF_WRW + (size_t)1824 * 1024 * 2); const int n = 224 * 1024 * 2 / 16;
      unsigned zz = 0u; asm volatile("" : "+v"(zz));
      if (vb >= 0) for (int i = vb * 512 + tidx(); i < n; i += nvb * 512) z[i] = (u32x4){zz, zz, zz, zz}; }
    conv_small(INP(p, 9) + (size_t)l * 64 * 512, 512, 512, 64, (bf16_t*)(ws + OFF_SM + SM_W2T), vb, nvb);
    conv_small(INP(p, 11) + (size_t)l * 64 * 512, 512, 512, 64, (bf16_t*)(ws + OFF_SM + SM_A2T), vb, nvb);
    conv_small(INP(p, 12) + (size_t)l * 160 * 512, 512, 512, 160, (bf16_t*)(ws + OFF_SM + SM_G2T), vb, nvb);
    if (l == 1) {
        conv_small(INP(p, 14), 32, 32, 512, (bf16_t*)(ws + OFF_SM + SM_V1T), vb, nvb);
        conv_small(INP(p, 15), 512, 512, 32, (bf16_t*)(ws + OFF_SM + SM_V2T), vb, nvb);
    }
}
__device__ void phase_convert_hg(const Ctx& p, int l, LAS unsigned char* lds, int vb, int nvb) {
    unsigned char* ws = uptr(p.ws);
    conv_T(INP(p, 6) + (size_t)l * 1024 * 5920, 5920, 1824, 2048, 1024, INP(p, 5) + l * 1024, (bf16_t*)(ws + OFF_WHG), 0, lds, vb, nvb);
}
__device__ void phase_convert_late(const Ctx& p, int l, LAS unsigned char* lds, int vb, int nvb) {
    unsigned char* ws = uptr(p.ws);
    const float* win = INP(p, 6) + (size_t)l * 1024 * 5920; const float* nm = INP(p, 5) + l * 1024;
    conv_T(win, 5920, 3872, 1024, 1024, nm, (bf16_t*)(ws + OFF_WGA), 0, lds, vb, nvb);
    conv_T(win, 5920, 4896, 1024, 1024, nm, (bf16_t*)(ws + OFF_WGB), 0, lds, vb, nvb);
    conv_T(INP(p, 23) + (size_t)l * 512 * 1024, 1024, 0, 1024, 512, nullptr, (bf16_t*)(ws + OFF_WOA), 0, lds, vb, nvb);
    conv_T(INP(p, 24) + (size_t)l * 512 * 1024, 1024, 0, 1024, 512, nullptr, (bf16_t*)(ws + OFF_WOB), 0, lds, vb, nvb);
    conv_T(INP(p, 25) + (size_t)l * 1024 * 1024, 1024, 0, 1024, 1024, nullptr, (bf16_t*)(ws + OFF_WO), 0, lds, vb, nvb);
    conv_T(INP(p, 27) + (size_t)l * 1024 * 4096, 4096, 0, 4096, 1024, INP(p, 26) + l * 1024, (bf16_t*)(ws + OFF_WUP), 0, lds, vb, nvb);
    conv_T(INP(p, 28) + (size_t)l * 4096 * 1024, 1024, 0, 1024, 4096, nullptr, (bf16_t*)(ws + OFF_WDN), 0, lds, vb, nvb);
}
__device__ void phase_x0(const Ctx& p) {
    const int tid = tidx(); const int wave = __builtin_amdgcn_readfirstlane(tid >> 6), lane = tid & 63;
    unsigned char* ws = uptr(p.ws);
    float* rowss = (float*)(ws + OFF_SM + SM_ROWSS); bf16_t* XB = (bf16_t*)(ws + OFF_XB);
    for (int row = bidx() * 8 + wave; row < T_ALL; row += gridDim.x * 8) {
        const float* src = row < T_P ? INP(p, 0) + (size_t)row * 1024 : INP(p, 1) + (size_t)(row - T_P) * 1024;
        float ss = 0.f;
#pragma unroll
        for (int i = 0; i < 4; ++i) { const int c = i * 256 + lane * 4; const float4 v = *(const float4*)(src + c);
            ss += v.x * v.x + v.y * v.y + v.z * v.z + v.w * v.w; u32x2 w; w.x = cvt_pk_bf16(v.x, v.y); w.y = cvt_pk_bf16(v.z, v.w); *(u32x2*)(XB + (size_t)row * 1024 + c) = w; }
        ss = wsum(ss); if (lane == 0) rowss[row] = ss;
    }
    for (int i = bidx() * 512 + tidx(); i < 4 * T_ALL; i += gridDim.x * 512) rowss[T_ALL + i] = 0.f;
}
__device__ __forceinline__ u32x2 pack4(float a, float b, float c, float d) { u32x2 w; w.x = cvt_pk_bf16(a, b); w.y = cvt_pk_bf16(c, d); return w; }
__device__ void phase_prep(const Ctx& p, int l, LAS unsigned char* lds) {
    constexpr int MXS = 1832, MIDS = 40;
    unsigned char* ws = uptr(p.ws);
    const bf16_t* PR = (const bf16_t*)(ws + OFF_A);
    LAS bf16_t* MX = (LAS bf16_t*)lds; LAS bf16_t* MID = (LAS bf16_t*)(lds + 32 * MXS * 2);
    const int tid = tidx(); const int wave = __builtin_amdgcn_readfirstlane(tid >> 6), lane = tid & 63, fr = lane & 15, fq = lane >> 4;
    const float* mu = INP(p, 7) + l * 1824;
    const bf16_t* w2T = (const bf16_t*)(ws + OFF_SM + SM_W2T); const bf16_t* a2T = (const bf16_t*)(ws + OFF_SM + SM_A2T); const bf16_t* g2T = (const bf16_t*)(ws + OFF_SM + SM_G2T);
    const bf16_t* v1T = (const bf16_t*)(ws + OFF_SM + SM_V1T); const bf16_t* v2T = (const bf16_t*)(ws + OFF_SM + SM_V2T);
    bf16_t* oR = (bf16_t*)(ws + OFF_B); bf16_t* oV = (bf16_t*)(l == 0 ? ws + OFF_V0 : ws + OFF_B + SLOT); bf16_t* oE = (bf16_t*)(ws + OFF_B + 2 * SLOT);
    bf16_t* oK = (bf16_t*)(ws + OFF_B + 3 * SLOT); bf16_t* oA = (bf16_t*)(ws + OFF_B + 4 * SLOT); bf16_t* oB = (bf16_t*)(ws + OFF_B + 5 * SLOT);
    bf16_t* oG = (bf16_t*)(ws + OFF_G); const bf16_t* V0 = (const bf16_t*)(ws + OFF_V0);
    float* bonus = (float*)(ws + OFF_SM + SM_BONUS);
    const float* w0 = INP(p, 8) + l * 512; const float* a0 = INP(p, 10) + l * 512; const float* kkp = INP(p, 16) + l * 512; const float* kap = INP(p, 17) + l * 512; const float* rkp = INP(p, 18) + l * 512;
    const float* v0p = INP(p, 13);
    for (int ti = bidx(); ti < T_ALL / 32; ti += gridDim.x) {
        const int t0 = ti * 32;
        if (tid < 456) {
            const int cgp = tid % 228, rh = tid / 228, c0 = cgp * 8, rstart = rh * 16;
            float prev[8], m8[8];
            { const float4 a = *(const float4*)(mu + c0), b = *(const float4*)(mu + c0 + 4); m8[0] = a.x; m8[1] = a.y; m8[2] = a.z; m8[3] = a.w; m8[4] = b.x; m8[5] = b.y; m8[6] = b.z; m8[7] = b.w; }
            const bool seq_start = (rh == 0) && (t0 >= T_P || (t0 % 8192) == 0);
            if (seq_start) {
                if (t0 >= T_P) { const float* sp = INP(p, 2) + ((size_t)l * 32 + (t0 - T_P) / 32) * 1824 + c0;
#pragma unroll
                    for (int j = 0; j < 8; ++j) prev[j] = sp[j]; }
                else {
#pragma unroll
                    for (int j = 0; j < 8; ++j) prev[j] = 0.f; }
            } else {
                const u32x4 w = *(const u32x4*)(PR + (size_t)(t0 + rstart - 1) * 2048 + c0);
                prev[0] = lo16(w.x); prev[1] = hi16(w.x); prev[2] = lo16(w.y); prev[3] = hi16(w.y); prev[4] = lo16(w.z); prev[5] = hi16(w.z); prev[6] = lo16(w.w); prev[7] = hi16(w.w);
            }
            const int fn = c0 < 1536 ? 0 : (c0 < 1600 ? 1 : (c0 < 1664 ? 0 : 2));
#pragma unroll 1
            for (int r8 = 0; r8 < 16; r8 += 8) {
            u32x4 wrow[8];
#pragma unroll
            for (int r = 0; r < 8; ++r) wrow[r] = *(const u32x4*)(PR + (size_t)(t0 + rstart + r8 + r) * 2048 + c0);
#pragma unroll
            for (int rr = 0; rr < 8; ++rr) {
                const int r = r8 + rr; const u32x4 w = wrow[rr];
                float cur[8], o[8];
                cur[0] = lo16(w.x); cur[1] = hi16(w.x); cur[2] = lo16(w.y); cur[3] = hi16(w.y); cur[4] = lo16(w.z); cur[5] = hi16(w.z); cur[6] = lo16(w.w); cur[7] = hi16(w.w);
#pragma unroll
                for (int j = 0; j < 8; ++j) { float x = cur[j] + (prev[j] - cur[j]) * m8[j]; if (fn == 1) x = tanh_fast(x); else if (fn == 2) x = sigm(x); o[j] = x; prev[j] = cur[j]; }
                u32x4 q; q.x = cvt_pk_bf16(o[0], o[1]); q.y = cvt_pk_bf16(o[2], o[3]); q.z = cvt_pk_bf16(o[4], o[5]); q.w = cvt_pk_bf16(o[6], o[7]);
                *(LAS u32x4*)(MX + (rstart + r) * MXS + c0) = q;
            }
            }
            if (rh == 1) {
                const bool last = t0 >= T_P || ((t0 + 32) % 8192) == 0;
                if (last) { float* dst = t0 >= T_P ? p.out + O_SHS + ((size_t)l * 32 + (t0 - T_P) / 32) * 1824 + c0 : p.out + O_SHP + ((size_t)l * 2 + t0 / 8192) * 1824 + c0;
#pragma unroll
                    for (int j = 0; j < 8; ++j) dst[j] = prev[j]; }
            }
        }
        __syncthreads();
        if (l == 1 && VRES && VRES != 2) {
            if (wave < 4) {
                const int tt = wave & 1, ot = wave >> 1; f32x4 acc = (f32x4){0.f, 0.f, 0.f, 0.f};
#pragma unroll 4
                for (int ks = 0; ks < 16; ++ks) {
                    const bf16x8 X = *(const bf16x8*)(v1T + (ot * 16 + fr) * 512 + ks * 32 + fq * 8);
                    const bf16x8 Y = *(const LAS bf16x8*)(MX + (tt * 16 + fr) * MXS + 1024 + ks * 32 + fq * 8);
                    acc = __builtin_amdgcn_mfma_f32_16x16x32_bf16(X, Y, acc, 0, 0, 0); }
                *(LAS u32x2*)(MID + (tt * 16 + fr) * MIDS + ot * 16 + 4 * fq) = pack4(acc[0], acc[1], acc[2], acc[3]);
            }
            __syncthreads();
        }
        const int h = wave;
        float ss[2] = {0.f, 0.f}, bon[2] = {0.f, 0.f};
#pragma unroll 1
        for (int ct = 0; ct < 4; ++ct) {
            const int crow = h * 64 + ct * 16 + fr, c = h * 64 + ct * 16 + 4 * fq;
            bf16x8 xw[2], xa[2], xg[5], xv;
#pragma unroll
            for (int ks = 0; ks < 2; ++ks) { xw[ks] = *(const bf16x8*)(w2T + crow * 64 + ks * 32 + fq * 8); xa[ks] = *(const bf16x8*)(a2T + crow * 64 + ks * 32 + fq * 8); }
#pragma unroll
            for (int ks = 0; ks < 5; ++ks) xg[ks] = *(const bf16x8*)(g2T + crow * 160 + ks * 32 + fq * 8);
            if (l == 1) xv = *(const bf16x8*)(v2T + crow * 32 + fq * 8); else xv = xw[0];
            const float4 w04 = *(const float4*)(w0 + c), a04 = *(const float4*)(a0 + c), kk_4 = *(const float4*)(kkp + c), ka4 = *(const float4*)(kap + c), rk4 = *(const float4*)(rkp + c);
            const float w0a[4] = {w04.x, w04.y, w04.z, w04.w}, a0a[4] = {a04.x, a04.y, a04.z, a04.w}, kka[4] = {kk_4.x, kk_4.y, kk_4.z, kk_4.w}, kaa[4] = {ka4.x, ka4.y, ka4.z, ka4.w}, rka[4] = {rk4.x, rk4.y, rk4.z, rk4.w};
            float v0a[4] = {0.f, 0.f, 0.f, 0.f};
            if (l == 1) { const float4 v04 = *(const float4*)(v0p + c); v0a[0] = v04.x; v0a[1] = v04.y; v0a[2] = v04.z; v0a[3] = v04.w; }
            u32x2 fwv[2] = {(u32x2){0u, 0u}, (u32x2){0u, 0u}};
            if (l == 1) { fwv[0] = *(const u32x2*)(V0 + (size_t)(t0 + fr) * 512 + c); fwv[1] = *(const u32x2*)(V0 + (size_t)(t0 + 16 + fr) * 512 + c); }
#pragma unroll
            for (int tt = 0; tt < 2; ++tt) {
                const LAS bf16_t* yrow = MX + (tt * 16 + fr) * MXS + fq * 8;
                f32x4 aW = (f32x4){0.f, 0.f, 0.f, 0.f}, aA = aW, aG = aW, aV = aW;
#pragma unroll
                for (int ks = 0; ks < 2; ++ks) { aW = __builtin_amdgcn_mfma_f32_16x16x32_bf16(xw[ks], *(const LAS bf16x8*)(yrow + 1536 + ks * 32), aW, 0, 0, 0);
                                                 aA = __builtin_amdgcn_mfma_f32_16x16x32_bf16(xa[ks], *(const LAS bf16x8*)(yrow + 1600 + ks * 32), aA, 0, 0, 0); }
#pragma unroll
                for (int ks = 0; ks < 5; ++ks) aG = __builtin_amdgcn_mfma_f32_16x16x32_bf16(xg[ks], *(const LAS bf16x8*)(yrow + 1664 + ks * 32), aG, 0, 0, 0);
                if (l == 1) aV = __builtin_amdgcn_mfma_f32_16x16x32_bf16(xv, *(const LAS bf16x8*)(MID + (tt * 16 + fr) * MIDS + fq * 8), aV, 0, 0, 0);
                const int j = tt * 16 + fr, t = t0 + j;
                LAS bf16_t* mrow = MX + j * MXS + c;
                const u32x2 rw = *(const LAS u32x2*)(mrow), kw = *(const LAS u32x2*)(mrow + 512), vw = *(const LAS u32x2*)(mrow + 1024);
                const float rr[4] = {lo16(rw.x), hi16(rw.x), lo16(rw.y), hi16(rw.y)}, kk4[4] = {lo16(kw.x), hi16(kw.x), lo16(kw.y), hi16(kw.y)};
                float vv[4] = {lo16(vw.x), hi16(vw.x), lo16(vw.y), hi16(vw.y)};
                if (l == 1) {
                    const u32x2 fw = fwv[tt]; const float vf[4] = {lo16(fw.x), hi16(fw.x), lo16(fw.y), hi16(fw.y)};
#pragma unroll
                    for (int e = 0; e < 4; ++e) { const float vg = sigm(v0a[e] + aV[e]); vv[e] = vv[e] + (vf[e] - vv[e]) * vg; }
                }
                float ew[4], kh[4], kr4[4], ag4[4];
#pragma unroll
                for (int e = 0; e < 4; ++e) {
                    ew[e] = 0.60653066f * sigm(w0a[e] + aW[e]);
                    const float a = sigm(a0a[e] + aA[e]); ag4[e] = a;
                    const float kr = kk4[e] * kka[e]; kr4[e] = kr; ss[tt] += kr * kr;
                    kh[e] = kk4[e] * (1.0f + (a - 1.0f) * kaa[e]);
                    bon[tt] += rr[e] * kh[e] * rka[e];
                }
                const size_t o = (size_t)t * 512 + c;
                *(u32x2*)(oR + o) = rw;
                *(u32x2*)(oV + o) = pack4(vv[0], vv[1], vv[2], vv[3]);
                *(u32x2*)(oE + o) = pack4(ew[0], ew[1], ew[2], ew[3]);
                *(u32x2*)(oK + o) = pack4(kh[0], kh[1], kh[2], kh[3]);
                *(u32x2*)(oG + o) = pack4(aG[0], aG[1], aG[2], aG[3]);
                *(LAS u32x2*)(mrow) = pack4(ag4[0], ag4[1], ag4[2], ag4[3]);
                *(LAS u32x2*)(mrow + 512) = pack4(kr4[0], kr4[1], kr4[2], kr4[3]);
            }
        }
#pragma unroll
        for (int tt = 0; tt < 2; ++tt) {
            float s1 = ss[tt], b1 = bon[tt];
            s1 += __shfl_xor(s1, 16); s1 += __shfl_xor(s1, 32); b1 += __shfl_xor(b1, 16); b1 += __shfl_xor(b1, 32);
            const float inv = rsqrtf(fmaxf(s1, 1e-24f));
            const int j = tt * 16 + fr, t = t0 + j;
#pragma unroll
            for (int ct = 0; ct < 4; ++ct) {
                const int c = h * 64 + ct * 16 + 4 * fq;
                const LAS bf16_t* mrow = MX + j * MXS + c;
                const u32x2 aw = *(const LAS u32x2*)(mrow), kw = *(const LAS u32x2*)(mrow + 512);
                const float ag4[4] = {lo16(aw.x), hi16(aw.x), lo16(aw.y), hi16(aw.y)}; float k4[4] = {lo16(kw.x) * inv, hi16(kw.x) * inv, lo16(kw.y) * inv, hi16(kw.y) * inv};
                const size_t o = (size_t)t * 512 + c;
                *(u32x2*)(oA + o) = pack4(-k4[0], -k4[1], -k4[2], -k4[3]);
                *(u32x2*)(oB + o) = pack4(k4[0] * ag4[0], k4[1] * ag4[1], k4[2] * ag4[2], k4[3] * ag4[3]);
            }
            if (fq == 0) bonus[(size_t)t * 8 + h] = b1;
        }
        __syncthreads();
    }
}

typedef float f2 __attribute__((ext_vector_type(2)));
__device__ __forceinline__ f2 pfma(f2 a, f2 b, f2 c) { return __builtin_elementwise_fma(a, b, c); }
template <bool ID> __device__ __forceinline__ void rwkv_scan(const bf16_t* __restrict__ R, const bf16_t* __restrict__ EW, const bf16_t* __restrict__ K, const bf16_t* __restrict__ V,
        const bf16_t* __restrict__ A, const bf16_t* __restrict__ B, unsigned base, int nsteps, f2 (&Sv)[32], f2 (&Si)[32], bf16_t* __restrict__ YH, bf16_t* __restrict__ QH, LAS float* L, int lane) {
    unsigned short q1[6], q2[6];
    { unsigned o = base; q1[0] = R[o]; q1[1] = EW[o]; q1[2] = K[o]; q1[3] = V[o]; q1[4] = A[o]; q1[5] = B[o];
      o = base + 512u; q2[0] = R[o]; q2[1] = EW[o]; q2[2] = K[o]; q2[3] = V[o]; q2[4] = A[o]; q2[5] = B[o]; }
    const LAS f32x4* pa = (const LAS f32x4*)L;
    float sav, sai;
    { L[lane] = bf2f(q1[4]);
      f2 av = {0.f, 0.f}, ai = {0.f, 0.f};
#pragma unroll
      for (int q = 0; q < 16; ++q) { const f32x4 a4 = pa[q]; const f2 a01 = {a4[0], a4[1]}, a23 = {a4[2], a4[3]};
          av = pfma(Sv[2 * q], a01, av); av = pfma(Sv[2 * q + 1], a23, av); if (ID) { ai = pfma(Si[2 * q], a01, ai); ai = pfma(Si[2 * q + 1], a23, ai); } }
      sav = av[0] + av[1]; sai = ai[0] + ai[1]; }
#pragma unroll 1
    for (int s = 0; s < nsteps; ++s) {
        L[lane] = bf2f(q2[4]); L[64 + lane] = __expf(-bf2f(q1[1])); L[128 + lane] = bf2f(q1[5]); L[192 + lane] = bf2f(q1[2]); L[256 + lane] = bf2f(q1[0]);
        const float v = bf2f(q1[3]);
#pragma unroll
        for (int j = 0; j < 6; ++j) q1[j] = q2[j];
        { const unsigned o = base + (unsigned)(s + 2 < nsteps ? s + 2 : nsteps - 1) * 512u; q2[0] = R[o]; q2[1] = EW[o]; q2[2] = K[o]; q2[3] = V[o]; q2[4] = A[o]; q2[5] = B[o]; }
        const f2 sav2 = {sav, sav}, sai2 = {sai, sai}, v2 = {v, v};
        f2 yv = {0.f, 0.f}, yi = {0.f, 0.f}, yv1 = {0.f, 0.f}, yi1 = {0.f, 0.f}, nv = {0.f, 0.f}, ni = {0.f, 0.f}, nv1 = {0.f, 0.f}, ni1 = {0.f, 0.f};
        f32x4 ca = pa[0], cw = pa[16], cb = pa[32], ck = pa[48], cr = pa[64];
#pragma unroll
        for (int q = 0; q < 16; ++q) {
            const f32x4 a4 = ca, w4 = cw, b4 = cb, k4 = ck, r4 = cr;
            if (q < 15) { ca = pa[1 + q]; cw = pa[17 + q]; cb = pa[33 + q]; ck = pa[49 + q]; cr = pa[65 + q]; }
            __builtin_amdgcn_sched_barrier(0);
            { const f2 a2 = {a4[0], a4[1]}, w2 = {w4[0], w4[1]}, b2 = {b4[0], b4[1]}, k2 = {k4[0], k4[1]}, r2 = {r4[0], r4[1]};
              f2 tv = sav2 * b2; tv = pfma(v2, k2, tv); Sv[2 * q] = pfma(Sv[2 * q], w2, tv); yv = pfma(Sv[2 * q], r2, yv); nv = pfma(Sv[2 * q], a2, nv);
              if (ID) { const f2 ti = sai2 * b2; Si[2 * q] = pfma(Si[2 * q], w2, ti); yi = pfma(Si[2 * q], r2, yi); ni = pfma(Si[2 * q], a2, ni); } }
            { const f2 a2 = {a4[2], a4[3]}, w2 = {w4[2], w4[3]}, b2 = {b4[2], b4[3]}, k2 = {k4[2], k4[3]}, r2 = {r4[2], r4[3]};
              f2 tv = sav2 * b2; tv = pfma(v2, k2, tv); Sv[2 * q + 1] = pfma(Sv[2 * q + 1], w2, tv); yv1 = pfma(Sv[2 * q + 1], r2, yv1); nv1 = pfma(Sv[2 * q + 1], a2, nv1);
              if (ID) { const f2 ti = sai2 * b2; Si[2 * q + 1] = pfma(Si[2 * q + 1], w2, ti); yi1 = pfma(Si[2 * q + 1], r2, yi1); ni1 = pfma(Si[2 * q + 1], a2, ni1); } }
        }
        sav = (nv[0] + nv[1]) + (nv1[0] + nv1[1]); sai = (ni[0] + ni[1]) + (ni1[0] + ni1[1]);
        const unsigned cbo = base + (unsigned)s * 512u;
        YH[cbo] = f2bf((yv[0] + yv[1]) + (yv1[0] + yv1[1])); if (ID) QH[cbo] = f2bf((yi[0] + yi[1]) + (yi1[0] + yi1[1]));
    }
}
__device__ void phase_rwkv_scan(const Ctx& p, int l, LAS unsigned char* lds) {
    unsigned char* ws = uptr(p.ws);
    const bf16_t* R = (const bf16_t*)(ws + OFF_B); const bf16_t* V = (const bf16_t*)(l == 0 ? ws + OFF_V0 : ws + OFF_B + SLOT); const bf16_t* EW = (const bf16_t*)(ws + OFF_B + 2 * SLOT);
    const bf16_t* K = (const bf16_t*)(ws + OFF_B + 3 * SLOT); const bf16_t* A = (const bf16_t*)(ws + OFF_B + 4 * SLOT); const bf16_t* B = (const bf16_t*)(ws + OFF_B + 5 * SLOT);
    bf16_t* YH = (bf16_t*)(ws + OFF_A); bf16_t* QH = (bf16_t*)(ws + OFF_A + SLOT); float* P = (float*)(ws + OFF_A + 34 * MiB); float* UC = (float*)(ws + OFF_A + 50 * MiB);
    const int tid = tidx(); const int wave = __builtin_amdgcn_readfirstlane(tid >> 6), lane = tid & 63;
    LAS float* L = (LAS float*)(lds + wave * 5120);
    if (wave < 4) {
        for (int item = bidx() * 4 + wave; item < 1024; item += gridDim.x * 4) {
            const int b = item >> 9, c = (item >> 3) & 63, h = item & 7;
            f2 Sv[32], Si[32]; const int li = tidx() & 63;
#pragma unroll
            for (int i = 0; i < 32; ++i) { Sv[i] = (f2){0.f, 0.f}; Si[i] = (f2){(2 * i == li) ? 1.f : 0.f, (2 * i + 1 == li) ? 1.f : 0.f}; }
            rwkv_scan<true>(R, EW, K, V, A, B, (unsigned)((b * 8192 + c * 128) * 512 + h * 64 + lane), 128, Sv, Si, YH, QH, L, lane);
            const int ln = tidx() & 63; int item2 = item; asm volatile("" : "+s"(item2));
            float* pp = P + (size_t)item2 * 4096 + ln * 64; float* up = UC + (size_t)item2 * 4096 + ln * 64;
#pragma unroll
            for (int i = 0; i < 32; i += 2) { *(float4*)(pp + 2 * i) = make_float4(Si[i][0], Si[i][1], Si[i + 1][0], Si[i + 1][1]); *(float4*)(up + 2 * i) = make_float4(Sv[i][0], Sv[i][1], Sv[i + 1][0], Sv[i + 1][1]); }
        }
    } else if (wave == 4) {
        for (int item = bidx(); item < 256; item += gridDim.x) {
            const int s = item >> 3, h = item & 7;
            const size_t so = (((size_t)l * 32 + s) * 8 + h) * 4096 + lane * 64;
            f2 Sv[32], Si[32];
            const float* sp = INP(p, 3) + so;
#pragma unroll
            for (int i = 0; i < 32; i += 2) { const float4 q = *(const float4*)(sp + 2 * i); Sv[i] = (f2){q.x, q.y}; Sv[i + 1] = (f2){q.z, q.w}; Si[i] = (f2){0.f, 0.f}; Si[i + 1] = (f2){0.f, 0.f}; }
            rwkv_scan<false>(R, EW, K, V, A, B, (unsigned)((T_P + s * 32) * 512 + h * 64 + lane), 32, Sv, Si, YH, QH, L, lane);
            float* op = p.out + O_RWS + so;
#pragma unroll
            for (int i = 0; i < 32; i += 2) *(float4*)(op + 2 * i) = make_float4(Sv[i][0], Sv[i][1], Sv[i + 1][0], Sv[i + 1][1]);
        }
    }
}
template <int CTRL> __device__ __forceinline__ float dpp_mov(float x) { return __uint_as_float(__builtin_amdgcn_update_dpp(0, __float_as_uint(x), CTRL, 0xF, 0xF, true)); }
__device__ __forceinline__ float wsum_fast(float x) {
    x += dpp_mov<0xB1>(x); x += dpp_mov<0x4E>(x); x += dpp_mov<0x141>(x); x += dpp_mov<0x140>(x);
    float t = rdl(x, 0); t += rdl(x, 16); t += rdl(x, 32); t += rdl(x, 48); return t; }
__device__ void phase_rwkv_chain(const Ctx& p, int l) {
    unsigned char* ws = uptr(p.ws);
    const float* P = (const float*)(ws + OFF_A + 34 * MiB); float* UC = (float*)(ws + OFF_A + 50 * MiB);
    const int tid = tidx(); const int wave = __builtin_amdgcn_readfirstlane(tid >> 6), lane = tid & 63;
    if (wave >= 4) return;
    for (int it = bidx() * 4 + wave; it < 1024; it += gridDim.x * 4) {
        const int b = it >> 9, h = (it >> 6) & 7, v = it & 63;
        const float* pb = P + (size_t)((b * 64) * 8 + h) * 4096 + lane;
        float* ub = UC + (size_t)((b * 64) * 8 + h) * 4096 + v * 64 + lane;
        float row = 0.f; float PA[64], PB[64];
#pragma unroll
        for (int i = 0; i < 64; ++i) PA[i] = pb[i * 64];
        float ucA = ub[0];
        for (int c = 0; c < 64; c += 2) {
            { const float* pc = pb + (size_t)(c + 1) * 32768;
#pragma unroll
              for (int i = 0; i < 64; ++i) PB[i] = pc[i * 64]; }
            const float ucB = ub[(size_t)(c + 1) * 32768];
            ub[(size_t)c * 32768] = row;
            { float n0 = ucA, n1 = 0.f;
#pragma unroll
              for (int i = 0; i < 64; i += 2) { n0 = fmaf(rdl(row, i), PA[i], n0); n1 = fmaf(rdl(row, i + 1), PA[i + 1], n1); }
              row = n0 + n1; }
            if (c + 2 < 64) { const float* pc = pb + (size_t)(c + 2) * 32768;
#pragma unroll
                for (int i = 0; i < 64; ++i) PA[i] = pc[i * 64];
                ucA = ub[(size_t)(c + 2) * 32768]; }
            ub[(size_t)(c + 1) * 32768] = row;
            { float n0 = ucB, n1 = 0.f;
#pragma unroll
              for (int i = 0; i < 64; i += 2) { n0 = fmaf(rdl(row, i), PB[i], n0); n1 = fmaf(rdl(row, i + 1), PB[i + 1], n1); }
              row = n0 + n1; }
        }
        p.out[O_RWP + (((size_t)l * 2 + b) * 8 + h) * 4096 + v * 64 + lane] = row;
    }
}
__device__ void phase_rwkv_fix(const Ctx& p, int l) {
    unsigned char* ws = uptr(p.ws);
    const bf16_t* YH = (const bf16_t*)(ws + OFF_A); const bf16_t* QH = (const bf16_t*)(ws + OFF_A + SLOT); const float* UC = (const float*)(ws + OFF_A + 50 * MiB);
    const bf16_t* V = (const bf16_t*)(l == 0 ? ws + OFF_V0 : ws + OFF_B + SLOT); const bf16_t* G = (const bf16_t*)(ws + OFF_G); const float* bonus = (const float*)(ws + OFF_SM + SM_BONUS);
    bf16_t* YA = (bf16_t*)(ws + OFF_B);
    const int tid = tidx(); const int wave = __builtin_amdgcn_readfirstlane(tid >> 6), lane = tid & 63, fr = lane & 15, fq = lane >> 4;
    const float* lnw = INP(p, 19) + l * 512; const float* lnb = INP(p, 20) + l * 512;
    for (int item = bidx() * 8 + wave; item < 4096 + 256; item += gridDim.x * 8) {
        const bool smp = item >= 4096;
        int h, t0, it = 0, ntile;
        if (!smp) { const int tq = item & 3; it = item >> 2; const int b = it >> 9, c = (it >> 3) & 63; h = it & 7; t0 = b * 8192 + c * 128 + tq * 32; ntile = 2; }
        else { const int si = item - 4096; h = si & 7; t0 = T_P + (si >> 3) * 32; ntile = 2; }
        bf16x8 X[4][2];
        if (!smp) {
#pragma unroll
            for (int vt = 0; vt < 4; ++vt)
#pragma unroll
                for (int ks = 0; ks < 2; ++ks) { const float* sp = UC + (size_t)it * 4096 + (vt * 16 + fr) * 64 + ks * 32 + fq * 8; const float4 a = *(const float4*)sp, b4 = *(const float4*)(sp + 4);
                    u32x4 w; w.x = cvt_pk_bf16(a.x, a.y); w.y = cvt_pk_bf16(a.z, a.w); w.z = cvt_pk_bf16(b4.x, b4.y); w.w = cvt_pk_bf16(b4.z, b4.w); X[vt][ks] = __builtin_bit_cast(bf16x8, w); }
        }
        float gw[4][4], gb[4][4];
#pragma unroll
        for (int vt = 0; vt < 4; ++vt) { const float4 a = *(const float4*)(lnw + h * 64 + vt * 16 + 4 * fq), b4 = *(const float4*)(lnb + h * 64 + vt * 16 + 4 * fq);
            gw[vt][0] = a.x; gw[vt][1] = a.y; gw[vt][2] = a.z; gw[vt][3] = a.w; gb[vt][0] = b4.x; gb[vt][1] = b4.y; gb[vt][2] = b4.z; gb[vt][3] = b4.w; }
        for (int tt = 0; tt < ntile; ++tt) {
            const int t = t0 + tt * 16 + fr; const size_t ob = (size_t)t * 512 + h * 64;
            float y[4][4];
            u32x2 yw[4], vw[4], gg[4];
#pragma unroll
            for (int vt = 0; vt < 4; ++vt) { yw[vt] = *(const u32x2*)(YH + ob + vt * 16 + 4 * fq); vw[vt] = *(const u32x2*)(V + ob + vt * 16 + 4 * fq); gg[vt] = *(const u32x2*)(G + ob + vt * 16 + 4 * fq); }
            const float bn = bonus[(size_t)t * 8 + h];
            if (!smp) {
                const bf16x8 Y0 = *(const bf16x8*)(QH + ob + fq * 8), Y1 = *(const bf16x8*)(QH + ob + 32 + fq * 8);
#pragma unroll
                for (int vt = 0; vt < 4; ++vt) { f32x4 acc = (f32x4){0.f, 0.f, 0.f, 0.f};
                    acc = __builtin_amdgcn_mfma_f32_16x16x32_bf16(X[vt][0], Y0, acc, 0, 0, 0); acc = __builtin_amdgcn_mfma_f32_16x16x32_bf16(X[vt][1], Y1, acc, 0, 0, 0);
                    y[vt][0] = acc[0] + lo16(yw[vt].x); y[vt][1] = acc[1] + hi16(yw[vt].x); y[vt][2] = acc[2] + lo16(yw[vt].y); y[vt][3] = acc[3] + hi16(yw[vt].y); }
            } else {
#pragma unroll
                for (int vt = 0; vt < 4; ++vt) { y[vt][0] = lo16(yw[vt].x); y[vt][1] = hi16(yw[vt].x); y[vt][2] = lo16(yw[vt].y); y[vt][3] = hi16(yw[vt].y); }
            }
            float sm = 0.f;
#pragma unroll
            for (int vt = 0; vt < 4; ++vt) sm += (y[vt][0] + y[vt][1]) + (y[vt][2] + y[vt][3]);
            sm += __shfl_xor(sm, 16); sm += __shfl_xor(sm, 32);
            const float mean = sm * (1.0f / 64.0f); float sq = 0.f;
#pragma unroll
            for (int vt = 0; vt < 4; ++vt)
#pragma unroll
                for (int e = 0; e < 4; ++e) { y[vt][e] -= mean; sq += y[vt][e] * y[vt][e]; }
            sq += __shfl_xor(sq, 16); sq += __shfl_xor(sq, 32);
            const float rs = rsqrtf(sq * (1.0f / 64.0f) + 64e-5f);
#pragma unroll
            for (int vt = 0; vt < 4; ++vt) {
                const float vv[4] = {lo16(vw[vt].x), hi16(vw[vt].x), lo16(vw[vt].y), hi16(vw[vt].y)}, g4[4] = {lo16(gg[vt].x), hi16(gg[vt].x), lo16(gg[vt].y), hi16(gg[vt].y)};
                float o[4];
#pragma unroll
                for (int e = 0; e < 4; ++e) o[e] = (y[vt][e] * rs * gw[vt][e] + gb[vt][e] + bn * vv[e]) * g4[e];
                *(u32x2*)(YA + ob + vt * 16 + 4 * fq) = pack4(o[0], o[1], o[2], o[3]);
            }
        }
    }
}
__device__ __forceinline__ float lb_of(const Ctx& p, int l, int c) { if (l == 0) return 0.f; const float* z = INP(p, 21); const float z0 = z[c], z1 = z[512 + c]; return __builtin_amdgcn_rcpf(1.0f + __expf(z0 - z1)); }
__device__ __forceinline__ void hgrn_scan(const bf16_t* __restrict__ PH, int t0, int nsteps, int h, int half, int kh, int lane, float lb, f2 (&S)[32], float& cp, bf16_t* __restrict__ OHp, float* __restrict__ ckp, LAS float* L) {
    const bf16_t* row = PH + (size_t)t0 * 2048 + h * 128 + kh * 64 + lane; const int voff = 1024 + (half - kh) * 64;
    unsigned short q1[3], q2[3], q3[3];
    { const bf16_t* r = row; q1[0] = r[0]; q1[1] = r[512]; q1[2] = r[voff];
      r = row + 2048; q2[0] = r[0]; q2[1] = r[512]; q2[2] = r[voff];
      r = row + 4096; q3[0] = r[0]; q3[1] = r[512]; q3[2] = r[voff]; }
    const LAS f32x4* pf = (const LAS f32x4*)L;
#pragma unroll 1
    for (int s = 0; s < nsteps; ++s) {
        const float ql = bf2f(q1[0]), fz = bf2f(q1[1]), v = bf2f(q1[2]);
#pragma unroll
        for (int j = 0; j < 3; ++j) { q1[j] = q2[j]; q2[j] = q3[j]; }
        { const bf16_t* r = row + (size_t)(s + 3 < nsteps ? s + 3 : nsteps - 1) * 2048; q3[0] = r[0]; q3[1] = r[512]; q3[2] = r[voff]; }
        const float fl = lb + (1.0f - lb) * sigm(fz);
        cp *= fl;
        if (ckp && (s & 31) == 31 && s < 127) ckp[(s >> 5) * 128 + lane] = cp;
        L[lane] = fl; L[64 + lane] = ql * sigm(ql);
        f32x4 F[2][4], Q[2][4];
#pragma unroll
        for (int i = 0; i < 4; ++i) { F[0][i] = pf[i]; Q[0][i] = pf[16 + i]; }
        const f2 v2 = {v, v}; f2 o2 = {0.f, 0.f}, o3 = {0.f, 0.f};
#pragma unroll
        for (int g = 0; g < 4; ++g) {
            if (g < 3) {
#pragma unroll
                for (int i = 0; i < 4; ++i) { F[(g + 1) & 1][i] = pf[(g + 1) * 4 + i]; Q[(g + 1) & 1][i] = pf[16 + (g + 1) * 4 + i]; } }
            __builtin_amdgcn_sched_barrier(0);
#pragma unroll
            for (int i = 0; i < 4; ++i) {
                const f32x4 f4 = F[g & 1][i], q4 = Q[g & 1][i]; const int idx = (g * 4 + i) * 2;
                const f2 f01 = {f4[0], f4[1]}, f23 = {f4[2], f4[3]}, q01 = {q4[0], q4[1]}, q23 = {q4[2], q4[3]};
                S[idx] = pfma(f01, S[idx] - v2, v2); o2 = pfma(S[idx], q01, o2);
                S[idx + 1] = pfma(f23, S[idx + 1] - v2, v2); o3 = pfma(S[idx + 1], q23, o3);
            }
        }
        OHp[(size_t)(t0 + s) * 512 + h * 128 + half * 64 + lane] = f2bf((o2[0] + o2[1]) + (o3[0] + o3[1]));
    }
}
constexpr size_t OFF_PGC = OFF_B + 3 * SLOT + 32 * MiB;
__device__ void phase_hgrn_scan(const Ctx& p, int l, LAS unsigned char* lds) {
    unsigned char* ws = uptr(p.ws);
    const bf16_t* PH = (const bf16_t*)(ws + OFF_A); bf16_t* OH0 = (bf16_t*)(ws + OFF_B + 2 * SLOT); bf16_t* OH1 = (bf16_t*)(ws + OFF_B + 5 * SLOT);
    float* UCH = (float*)(ws + OFF_B + 3 * SLOT); float* PGH = (float*)(ws + OFF_SM + SM_PGH); float* PGC = (float*)(ws + OFF_PGC);
    const int tid = tidx(); const int wave = __builtin_amdgcn_readfirstlane(tid >> 6), lane = tid & 63;
    LAS float* L = (LAS float*)(lds + wave * 1024);
    for (int item = bidx() * 8 + wave; item < 2048; item += gridDim.x * 8) {
        const int kh = item & 1, half = (item >> 1) & 1, h = (item >> 2) & 3, c = (item >> 4) & 63, b = item >> 10, idx = item >> 2;
        f2 S[32];
#pragma unroll
        for (int k = 0; k < 32; ++k) S[k] = (f2){0.f, 0.f};
        float cp = 1.f;
        hgrn_scan(PH, b * 8192 + c * 128, 128, h, half, kh, lane, lb_of(p, l, h * 128 + kh * 64 + lane), S, cp, kh ? OH1 : OH0, half == 0 ? PGC + (size_t)idx * 384 + kh * 64 : nullptr, L);
        float* up = UCH + (size_t)idx * 16384 + (size_t)(kh * 64) * 128 + half * 64 + lane;
#pragma unroll
        for (int k = 0; k < 32; ++k) { up[(2 * k) * 128] = S[k][0]; up[(2 * k + 1) * 128] = S[k][1]; }
        if (half == 0) PGH[idx * 128 + kh * 64 + lane] = cp;
    }
    if (wave < 2) {
        for (int item = bidx() * 2 + wave; item < 512; item += gridDim.x * 2) {
            const int kh = item & 1, half = (item >> 1) & 1, h = (item >> 2) & 3, s = item >> 4;
            const size_t so = (((size_t)l * 32 + s) * 4 + h) * 16384 + (size_t)(kh * 64) * 128 + half * 64 + lane;
            f2 S[32];
            const float* stp = INP(p, 4) + so;
#pragma unroll
            for (int k = 0; k < 32; ++k) S[k] = (f2){stp[(2 * k) * 128], stp[(2 * k + 1) * 128]};
            float cp = 1.f;
            hgrn_scan(PH, T_P + s * 32, 32, h, half, kh, lane, lb_of(p, l, h * 128 + kh * 64 + lane), S, cp, kh ? OH1 : OH0, nullptr, L);
#pragma unroll
            for (int k = 0; k < 32; ++k) { p.out[O_HGS + so + (2 * k) * 128] = S[k][0]; p.out[O_HGS + so + (2 * k + 1) * 128] = S[k][1]; }
        }
    }
}
__device__ void phase_hgrn_chain(const Ctx& p, int l) {
    unsigned char* ws = uptr(p.ws);
    float* UCH = (float*)(ws + OFF_B + 3 * SLOT); const float* PGH = (const float*)(ws + OFF_SM + SM_PGH);
    for (int gid = bidx() * 512 + tidx(); gid < 131072; gid += gridDim.x * 512) {
        const int b = gid >> 16, h = (gid >> 14) & 3, k = (gid >> 7) & 127, v = gid & 127;
        float s = 0.f;
        for (int c0 = 0; c0 < 64; c0 += 8) {
            float u[8], pg[8];
#pragma unroll
            for (int j = 0; j < 8; ++j) { const size_t idx = (size_t)(b * 64 + c0 + j) * 4 + h; u[j] = UCH[idx * 16384 + k * 128 + v]; pg[j] = PGH[idx * 128 + k]; }
#pragma unroll
            for (int j = 0; j < 8; ++j) { const size_t idx = (size_t)(b * 64 + c0 + j) * 4 + h; UCH[idx * 16384 + k * 128 + v] = s; s = fmaf(pg[j], s, u[j]); }
        }
        p.out[O_HGP + (((size_t)l * 2 + b) * 4 + h) * 16384 + k * 128 + v] = s;
    }
}
__device__ void phase_hgrn_fix(const Ctx& p, int l, LAS unsigned char* lds) {
    unsigned char* ws = uptr(p.ws);
    const bf16_t* PH = (const bf16_t*)(ws + OFF_A); const bf16_t* OH = (const bf16_t*)(ws + OFF_B + 2 * SLOT); const float* UCH = (const float*)(ws + OFF_B + 3 * SLOT);
    const float* PGC = (const float*)(ws + OFF_PGC); const bf16_t* OH1 = (const bf16_t*)(ws + OFF_B + 5 * SLOT);
    bf16_t* YB = (bf16_t*)(ws + OFF_B + SLOT);
    const int tid = tidx(); const int wave = __builtin_amdgcn_readfirstlane(tid >> 6), lane = tid & 63, fr = lane & 15, fq = lane >> 4;
    const float* nw = INP(p, 22) + l * 512;
    constexpr int QS = 136;
    LAS bf16_t* QT = (LAS bf16_t*)(lds + wave * 16384);
    for (int item = bidx() * 8 + wave; item < 2048; item += gridDim.x * 8) {
        const int tq = item & 3, idx = item >> 2, h = idx & 3, c = (idx >> 2) & 63, b = idx >> 8;
        const float lbl = lb_of(p, l, h * 128 + lane), lbh = lb_of(p, l, h * 128 + 64 + lane);
        const int tbase = b * 8192 + c * 128 + tq * 32;
        float rl = 1.f, rh = 1.f;
        if (tq) { rl = PGC[(size_t)idx * 384 + (tq - 1) * 128 + lane]; rh = PGC[(size_t)idx * 384 + (tq - 1) * 128 + 64 + lane]; }
        const bf16_t* row = PH + (size_t)tbase * 2048 + h * 128 + lane;
#pragma unroll 1
        for (int t8 = 0; t8 < 32; t8 += 8) {
            unsigned short rq[8][4];
#pragma unroll
            for (int j = 0; j < 8; ++j) { const bf16_t* r = row + (size_t)(t8 + j) * 2048; rq[j][0] = r[0]; rq[j][1] = r[64]; rq[j][2] = r[512]; rq[j][3] = r[576]; }
#pragma unroll
            for (int j = 0; j < 8; ++j) {
                const float ql = bf2f(rq[j][0]), qh = bf2f(rq[j][1]);
                rl *= lbl + (1.0f - lbl) * sigm(bf2f(rq[j][2])); rh *= lbh + (1.0f - lbh) * sigm(bf2f(rq[j][3]));
                QT[(t8 + j) * QS + lane] = f2bf(ql * sigm(ql) * rl); QT[(t8 + j) * QS + 64 + lane] = f2bf(qh * sigm(qh) * rh);
            }
        }
        f32x4 acc[8][2];
        const float* sb = UCH + (size_t)idx * 16384 + fr;
#pragma unroll
        for (int vt = 0; vt < 8; ++vt) {
            acc[vt][0] = (f32x4){0.f, 0.f, 0.f, 0.f}; acc[vt][1] = (f32x4){0.f, 0.f, 0.f, 0.f};
#pragma unroll
            for (int ks = 0; ks < 4; ++ks) {
                const float* sp = sb + (size_t)(ks * 32 + fq * 8) * 128 + vt * 16;
                u32x4 w; w.x = cvt_pk_bf16(sp[0], sp[128]); w.y = cvt_pk_bf16(sp[256], sp[384]); w.z = cvt_pk_bf16(sp[512], sp[640]); w.w = cvt_pk_bf16(sp[768], sp[896]);
                const bf16x8 X = __builtin_bit_cast(bf16x8, w);
                acc[vt][0] = __builtin_amdgcn_mfma_f32_16x16x32_bf16(X, *(const LAS bf16x8*)(QT + fr * QS + ks * 32 + fq * 8), acc[vt][0], 0, 0, 0);
                acc[vt][1] = __builtin_amdgcn_mfma_f32_16x16x32_bf16(X, *(const LAS bf16x8*)(QT + (16 + fr) * QS + ks * 32 + fq * 8), acc[vt][1], 0, 0, 0);
            }
        }
#pragma unroll
        for (int tt = 0; tt < 2; ++tt) {
            const int t = tbase + tt * 16 + fr;
            const bf16_t* op = OH + (size_t)t * 512 + h * 128 + 4 * fq; const bf16_t* op1 = OH1 + (size_t)t * 512 + h * 128 + 4 * fq; const bf16_t* gp = PH + (size_t)t * 2048 + 1536 + h * 128 + 4 * fq;
            float o[8][4]; float ss = 0.f;
#pragma unroll
            for (int vt = 0; vt < 8; ++vt) { const u32x2 ow = *(const u32x2*)(op + vt * 16), ox = *(const u32x2*)(op1 + vt * 16);
                o[vt][0] = acc[vt][tt][0] + (lo16(ow.x) + lo16(ox.x)); o[vt][1] = acc[vt][tt][1] + (hi16(ow.x) + hi16(ox.x)); o[vt][2] = acc[vt][tt][2] + (lo16(ow.y) + lo16(ox.y)); o[vt][3] = acc[vt][tt][3] + (hi16(ow.y) + hi16(ox.y));
                ss += (o[vt][0] * o[vt][0] + o[vt][1] * o[vt][1]) + (o[vt][2] * o[vt][2] + o[vt][3] * o[vt][3]); }
            ss += __shfl_xor(ss, 16); ss += __shfl_xor(ss, 32);
            const float rs = rsqrtf(ss * (1.0f / 128.0f) + 1e-6f);
#pragma unroll
            for (int vt = 0; vt < 8; ++vt) { const u32x2 gw = *(const u32x2*)(gp + vt * 16); const float4 n4 = *(const float4*)(nw + h * 128 + vt * 16 + 4 * fq);
                const float g4[4] = {lo16(gw.x), hi16(gw.x), lo16(gw.y), hi16(gw.y)}, nn[4] = {n4.x, n4.y, n4.z, n4.w}; float r[4];
#pragma unroll
                for (int e = 0; e < 4; ++e) r[e] = o[vt][e] * rs * nn[e] * g4[e] * sigm(g4[e]);
                *(u32x2*)(YB + (size_t)t * 512 + h * 128 + vt * 16 + 4 * fq) = pack4(r[0], r[1], r[2], r[3]); }
        }
    }
    if (wave == 0) {
        for (int item = bidx(); item < 128; item += gridDim.x) {
            const int s = item >> 2, h = item & 3;
            const float nw0 = nw[h * 128 + lane], nw1 = nw[h * 128 + 64 + lane];
#pragma unroll 4
            for (int tt = 0; tt < 32; ++tt) {
                const int t = T_P + s * 32 + tt;
                const float o0 = bf2f(OH[(size_t)t * 512 + h * 128 + lane]) + bf2f(OH1[(size_t)t * 512 + h * 128 + lane]), o1 = bf2f(OH[(size_t)t * 512 + h * 128 + 64 + lane]) + bf2f(OH1[(size_t)t * 512 + h * 128 + 64 + lane]);
                const float g0 = bf2f(PH[(size_t)t * 2048 + 1536 + h * 128 + lane]), g1 = bf2f(PH[(size_t)t * 2048 + 1536 + h * 128 + 64 + lane]);
                const float rs = rsqrtf(wsum_fast(o0 * o0 + o1 * o1) * (1.0f / 128.0f) + 1e-6f);
                YB[(size_t)t * 512 + h * 128 + lane] = f2bf(o0 * rs * nw0 * g0 * sigm(g0));
                YB[(size_t)t * 512 + h * 128 + 64 + lane] = f2bf(o1 * rs * nw1 * g1 * sigm(g1));
            }
        }
    }
}
__device__ void phase_final(const Ctx& p) {
    const int tid = tidx(); const int wave = __builtin_amdgcn_readfirstlane(tid >> 6), lane = tid & 63;
    const float* nf = INP(p, 29); const float* PART = (const float*)(uptr(p.ws) + OFF_PART);
    for (int row = bidx() * 8 + wave; row < T_ALL; row += gridDim.x * 8) {
        float* xp = p.out + (size_t)row * 1024; float4 v[4]; float ss = 0.f;
#pragma unroll
        for (int i = 0; i < 4; ++i) { v[i] = *(const float4*)(xp + i * 256 + lane * 4);
            if (row >= T_P) { const float* pr = PART + (size_t)(row - T_P) * 1024 + i * 256 + lane * 4;
#pragma unroll
                for (int sl = 0; sl < 8; ++sl) { const float4 q = *(const float4*)(pr + (size_t)sl * 1024 * 1024); v[i].x += q.x; v[i].y += q.y; v[i].z += q.z; v[i].w += q.w; } }
            ss += v[i].x * v[i].x + v[i].y * v[i].y + v[i].z * v[i].z + v[i].w * v[i].w; }
        const float s = rsqrtf(wsum(ss) * (1.0f / 1024.0f) + 1e-6f);
#pragma unroll
        for (int i = 0; i < 4; ++i) { const int c = i * 256 + lane * 4; const float4 w = *(const float4*)(nf + c);
            v[i].x *= s * w.x; v[i].y *= s * w.y; v[i].z *= s * w.z; v[i].w *= s * w.w; *(float4*)(xp + c) = v[i]; }
    }
}
#define VRES 1
#define GEMM_PRO unsigned char* ws = uptr(p.ws); float* rowss = (float*)(ws + OFF_SM + SM_ROWSS); bf16_t* XB = (bf16_t*)(ws + OFF_XB); \
    const float* rs_mix = rowss + (size_t)(2 * l) * T_ALL; float* rs_ffn = rowss + (size_t)(2 * l + 1) * T_ALL; float* rs_next = rowss + (size_t)(2 * l + 2) * T_ALL; (void)rs_mix; (void)rs_ffn; (void)rs_next; (void)XB
__global__ void __launch_bounds__(512, 2) mega_fwd(Params prm) {
    extern __shared__ __attribute__((aligned(16))) unsigned char lds_raw[];
    LAS unsigned char* lds = (LAS unsigned char*)lds_raw;
    cg::grid_group grid = cg::this_grid();
    Ctx p; p.ws = prm.ws; p.out = prm.out;
    { unsigned long long* tb = (unsigned long long*)(prm.ws + OFF_SM + SM_TBL + (size_t)blockIdx.x * 256);
      if (threadIdx.x == 0) {
#define TB(i) tb[i] = (unsigned long long)prm.in[i];
          TB(0) TB(1) TB(2) TB(3) TB(4) TB(5) TB(6) TB(7) TB(8) TB(9) TB(10) TB(11) TB(12) TB(13) TB(14) TB(15) TB(16) TB(17) TB(18) TB(19) TB(20) TB(21) TB(22) TB(23) TB(24) TB(25) TB(26) TB(27) TB(28) TB(29)
#undef TB
      }
      __threadfence_block(); __syncthreads();
      p.tbl = tb; }
    volatile LAS unsigned* xst = (volatile LAS unsigned*)(lds + 131072);
    if (threadIdx.x < 2) xst[threadIdx.x] = 0u;
    __syncthreads();
    XcdBarrier xb = xcd_barrier_post((unsigned*)(prm.ws + OFF_SM + SM_BAR), xst);
    grid.sync();
    phase_x0(p);
#pragma unroll 1
    for (int ph = 0; ph < 28; ++ph) {
        const int l = ph >= 14 ? 1 : 0, k = ph - 14 * l;
        switch (k) {
        case 0: if (l == 1) { GEMM_PRO; finalize_sample(p, rowss + (size_t)2 * T_ALL); } else phase_convert_early(p, 0, lds, bidx(), (int)gridDim.x); break;
        case 1: { GEMM_PRO; EpiBf<0> E; E.O = (bf16_t*)(ws + OFF_A); E.ldc = 2048; E.rowss = rs_mix; run_gemm(lds, XB, (const bf16_t*)(ws + OFF_WRW), 2048, 1024, E);
                  { const int b = bidx(); phase_convert_hg(p, l, lds, b >= 32 ? b - 32 : -1, (int)gridDim.x - 32); } } break;
        case 2: phase_prep(p, l, lds); break;
        case 3: phase_rwkv_scan(p, l, lds); break;
        case 4: phase_rwkv_chain(p, l); break;
        case 5: phase_rwkv_fix(p, l); break;
        case 6: { GEMM_PRO; EpiBf<0> E; E.O = (bf16_t*)(ws + OFF_A); E.ldc = 2048; E.rowss = rs_mix; run_gemm(lds, XB, (const bf16_t*)(ws + OFF_WHG), 2048, 1024, E);
                  { const int b = bidx(); phase_convert_late(p, l, lds, b >= 32 ? b - 32 : -1, (int)gridDim.x - 32); } } break;
        case 7: phase_hgrn_scan(p, l, lds); break;
        case 8: phase_hgrn_chain(p, l); break;
        case 9: phase_hgrn_fix(p, l, lds); break;
        case 10: {
            GEMM_PRO; bf16_t* TA = (bf16_t*)(ws + OFF_A); bf16_t* TB = (bf16_t*)(ws + OFF_A + 34 * MiB);
            { EpiBf<2> E; E.O = TA; E.ldc = 1024; E.rowss = nullptr; run_gemm(lds, (const bf16_t*)(ws + OFF_B), (const bf16_t*)(ws + OFF_WOA), 1024, 512, E); }
            { EpiGate<0> E; E.M = TA; E.Tm = TA; E.rowss = rs_mix; run_gemm(lds, XB, (const bf16_t*)(ws + OFF_WGA), 1024, 1024, E); }
            { EpiBf<2> E; E.O = TB; E.ldc = 1024; E.rowss = nullptr; run_gemm(lds, (const bf16_t*)(ws + OFF_B + SLOT), (const bf16_t*)(ws + OFF_WOB), 1024, 512, E); }
            { EpiGate<1> E; E.M = TA; E.Tm = TB; E.rowss = rs_mix; run_gemm(lds, XB, (const bf16_t*)(ws + OFF_WGB), 1024, 1024, E); }
        } break;
        case 11: { GEMM_PRO; EpiResid E; E.X = p.out; E.XB = XB; E.rowss_out = rs_ffn; E.Xp0 = l == 0 ? INP(p, 0) : nullptr; E.Xs0 = l == 0 ? INP(p, 1) : nullptr; run_gemm(lds, (const bf16_t*)(ws + OFF_A), (const bf16_t*)(ws + OFF_WO), 1024, 1024, E);
                   if (l == 0) { const int b = bidx(); phase_convert_early(p, 1, lds, b >= 16 ? b - 16 : -1, (int)gridDim.x - 16); } } break;
        case 12: { GEMM_PRO; EpiBf<1> E; E.O = (bf16_t*)(ws + OFF_A); E.ldc = 4096; E.rowss = rs_ffn; run_gemm(lds, XB, (const bf16_t*)(ws + OFF_WUP), 4096, 1024, E); } break;
        default: { GEMM_PRO; EpiResid E; E.X = p.out; E.XB = XB; E.rowss_out = rs_next; E.Xp0 = nullptr; E.Xs0 = nullptr; run_ffn_down(lds, (const bf16_t*)(ws + OFF_A), (const bf16_t*)(ws + OFF_WDN), E, (float*)(ws + OFF_PART)); } break;
        }
        xcd_barrier(xb);
    }
    phase_final(p);
}

extern "C" void kernel_launch(void* const* d_in, const int* in_sizes, int n_in, void* d_out, int out_size, void* d_ws, size_t ws_size, hipStream_t stream) {
    constexpr int LDS_BYTES = 131072 + 64;
    static int grid_blocks = 0;
    if (grid_blocks == 0) {
        int dev = 0, cus = 0, per_cu = 0;
        hipGetDevice(&dev);
        hipDeviceGetAttribute(&cus, hipDeviceAttributeMultiprocessorCount, dev);
        hipFuncSetAttribute((const void*)mega_fwd, hipFuncAttributeMaxDynamicSharedMemorySize, LDS_BYTES);
        hipOccupancyMaxActiveBlocksPerMultiprocessor(&per_cu, (const void*)mega_fwd, 512, LDS_BYTES);
        if (per_cu < 1) per_cu = 1;
        grid_blocks = cus;
        if (n_in != 30 || ws_size < WS_NEED) { fprintf(stderr, "kernel_launch: unexpected n_in %d / ws_size %zu\n", n_in, ws_size); }
    }
    if (hipMemsetAsync((unsigned char*)d_ws + OFF_SM + SM_BAR, 0, XCD_BAR_WORDS * 4, stream) != hipSuccess) fprintf(stderr, "memset failed\n");
    Params p{};
    for (int i = 0; i < 30; ++i) p.in[i] = (const float*)d_in[i];
    p.out = (float*)d_out; p.ws = (unsigned char*)d_ws;
    void* args[] = {&p};
    hipError_t e = hipLaunchCooperativeKernel((const void*)mega_fwd, dim3(grid_blocks), dim3(512), args, LDS_BYTES, stream);
    if (e != hipSuccess) fprintf(stderr, "cooperative launch failed: %s (grid %d)\n", hipGetErrorString(e), grid_blocks);
}
```

```cpp
#include <hip/hip_runtime.h>
#include <hip/hip_cooperative_groups.h>
#include <cstdio>
namespace cg = cooperative_groups;
#define VRES 1
namespace pg8 {
#define PG8_LAS __attribute__((address_space(3)))
typedef unsigned short bf16_t;
typedef short bf16x8 __attribute__((ext_vector_type(8)));
typedef float f32x4 __attribute__((ext_vector_type(4)));
typedef unsigned u32x4 __attribute__((ext_vector_type(4)));
constexpr int BM = 256, BK = 64, HALF = 128, HTB = HALF * BK * 2  , STAGE_BYTES = 8 * HTB, NXCD = 8, WGM = 8;

__host__ __device__ __forceinline__ int lds_byte(int r, int c) { const int st = (r >> 4) * 2 + (c >> 5), rr = r & 15, cc = c & 31, ob = rr * 64 + cc * 2; return st * 1024 + (ob ^ (((ob >> 9) & 1) << 5)); }
__host__ __device__ __forceinline__ void stage_rc(int b, int& R, int& C) { const int st = b / 1024, sb = b % 1024, swz = sb ^ (((sb >> 9) & 1) << 5); R = (st >> 1) * 16 + swz / 64; C = (st & 1) * 32 + (swz % 64) / 2; }
__host__ __device__ __forceinline__ int perm32(int rho) { const int n = rho >> 4, i = rho & 15; return 8 * (i >> 2) + 4 * n + (i & 3); }

struct Unit { int pm, pn; };
struct Gemm { const bf16_t* A; const bf16_t* Bt; int M, N, K, ld; };

struct StaticOrder {
    int nM, nN, nwg, G, c;
    __host__ __device__ void init(int M, int N, int G_, int c_) { nM = M / BM; nN = N / BM; nwg = nM * nN; G = G_; c = c_; }
    __host__ __device__ bool next(int i, Unit& u) const {
        const long L = (long)i * G + c; if (L >= nwg) return false;
        int wgid = (int)L; { const int q = nwg / NXCD, r = nwg % NXCD, xcd = wgid % NXCD, off = wgid / NXCD; wgid = (xcd < r ? xcd * (q + 1) : r * (q + 1) + (xcd - r) * q) + off; }
        const int nig = WGM * nN, gid = wgid / nig, fm = gid * WGM, gsz = (nM - fm) < WGM ? (nM - fm) : WGM;
        u.pm = fm + ((wgid % nig) % gsz); u.pn = (wgid % nig) / gsz; return true;
    }
    __device__ __forceinline__ void a_ready(const Unit&) const {}
    __device__ __forceinline__ void done(const Unit&) const {}
};
typedef float f32x2_cv __attribute__((ext_vector_type(2)));
typedef __bf16 bf16x2_cv __attribute__((ext_vector_type(2)));
__device__ __forceinline__ unsigned cvt_pk_bf16(float lo, float hi) { const f32x2_cv v = {lo, hi}; const bf16x2_cv b = __builtin_convertvector(v, bf16x2_cv); return __builtin_bit_cast(unsigned, b); }
template <class Epi, class Sched, bool STAMP = false>
__device__ __forceinline__ void gemm_phase(PG8_LAS unsigned char* lds, const Gemm g, const Sched& S, const Epi& E, unsigned long long* stamps) {
    int tid_ = threadIdx.x; asm volatile("" : "+v"(tid_)); const int tid = tid_, wid = __builtin_amdgcn_readfirstlane(tid >> 6), lane = tid & 63, wr = wid >> 2, wc = wid & 3, fr = lane & 15, fq = lane >> 4;
    const int K = g.K, nt = K / BK, LD = g.ld;
    unsigned voffA[2], voffB[2];
#pragma unroll
    for (int i = 0; i < 2; ++i) { int R, C; stage_rc(tid * 16 + i * 8192, R, C); const int Rb = Epi::PERM ? ((R & ~31) + perm32(R & 31)) : R;
        voffA[i] = (unsigned)(R * LD + C) * 2u; voffB[i] = (unsigned)(Rb * LD + C) * 2u; }
    const size_t kstep = (size_t)(BK * 2);
    const size_t hstep = (size_t)HALF * LD * 2;
    const size_t tstep = 2 * hstep;
    const unsigned ldsw = (unsigned)wid * 1024u;
    const int aoff = lds_byte(wr * 64 + fr, fq * 8), boff = lds_byte(wc * 32 + fr, fq * 8);
#define PG8_SA(b, h) (((b) * 2 + (h)) * HTB)
#define PG8_SB(b, h) ((4 + (b) * 2 + (h)) * HTB)
#define PG8_STAGE(bufoff, gbase, voff) do { _Pragma("unroll") for (int _i = 0; _i < 2; ++_i) \
        __builtin_amdgcn_global_load_lds((const unsigned*)((const char*)(gbase) + (voff)[_i]), (PG8_LAS unsigned*)(lds + (bufoff) + ldsw + _i * 8192), 16, 0, 0); } while (0)
#define PG8_LDA(dst, b, h) do { _Pragma("unroll") for (int m = 0; m < 4; ++m) _Pragma("unroll") for (int k = 0; k < 2; ++k) dst[m][k] = *(const PG8_LAS bf16x8*)(lds + PG8_SA(b, h) + aoff + m * 2048 + k * 1024); } while (0)
#define PG8_LDB(dst, b, h) do { _Pragma("unroll") for (int n = 0; n < 2; ++n) _Pragma("unroll") for (int k = 0; k < 2; ++k) dst[n][k] = *(const PG8_LAS bf16x8*)(lds + PG8_SB(b, h) + boff + n * 2048 + k * 1024); } while (0)
#define PG8_MMA(ai, bj, At, Bt) do { __builtin_amdgcn_s_setprio(1); _Pragma("unroll") for (int m = 0; m < 4; ++m) _Pragma("unroll") for (int n = 0; n < 2; ++n) _Pragma("unroll") for (int k = 0; k < 2; ++k) \
        acc[ai][bj][m][n] = __builtin_amdgcn_mfma_f32_16x16x32_bf16(Bt[n][k], At[m][k], acc[ai][bj][m][n], 0, 0, 0); __builtin_amdgcn_s_setprio(0); } while (0)
#define PG8_WAIT_V(n) asm volatile("s_waitcnt vmcnt(" #n ")" ::: "memory")
#define PG8_WAIT_L(n) asm volatile("s_waitcnt lgkmcnt(" #n ")" ::: "memory")
#define PG8_BAR __builtin_amdgcn_s_barrier()
#define PG8_SCHED __builtin_amdgcn_sched_barrier(0)
    Unit cur, nxt; int ui = 0;
    if (!S.next(0, cur)) return;
    f32x4 acc[2][2][4][2];
#pragma unroll
    for (int a = 0; a < 2; ++a)
#pragma unroll
        for (int b = 0; b < 2; ++b)
#pragma unroll
            for (int m = 0; m < 4; ++m)
#pragma unroll
                for (int n = 0; n < 2; ++n) acc[a][b][m][n] = (f32x4){0.f, 0.f, 0.f, 0.f};
    bf16x8 At[4][2], B0[2][2], B1[2][2];
    const char* cA = (const char*)g.A + (size_t)cur.pm * tstep; const char* cB = (const char*)g.Bt + (size_t)cur.pn * tstep;
    S.a_ready(cur);
    PG8_STAGE(PG8_SB(0, 0), cB, voffB); PG8_STAGE(PG8_SA(0, 0), cA, voffA); PG8_STAGE(PG8_SB(0, 1), cB + hstep, voffB); PG8_STAGE(PG8_SA(0, 1), cA + hstep, voffA);
    if (wr == 1) PG8_BAR;
    PG8_WAIT_V(4); PG8_BAR;
    PG8_STAGE(PG8_SB(1, 0), cB + kstep, voffB); PG8_STAGE(PG8_SA(1, 0), cA + kstep, voffA); PG8_STAGE(PG8_SB(1, 1), cB + hstep + kstep, voffB);
    PG8_WAIT_V(6); PG8_BAR;
    for (;;) {
        const bool has_next = S.next(ui + 1, nxt);
        const char* nA = has_next ? (const char*)g.A + (size_t)nxt.pm * tstep : cA; const char* nB = has_next ? (const char*)g.Bt + (size_t)nxt.pn * tstep : cB;
        for (int t = 0; t < nt; t += 2) {
            const bool last = (t == nt - 2);
            const char* a1 = cA + (size_t)(t + 1) * kstep;
            const char* a2 = last ? nA : cA + (size_t)(t + 2) * kstep; const char* b2 = last ? nB : cB + (size_t)(t + 2) * kstep;
            const char* a3 = a2 + kstep; const char* b3 = b2 + kstep;
            if (last && has_next) S.a_ready(nxt);
            PG8_LDB(B0, 0, 0); PG8_SCHED; PG8_LDA(At, 0, 0); PG8_STAGE(PG8_SA(1, 1), a1 + hstep, voffA);
            PG8_WAIT_L(8); PG8_BAR; PG8_WAIT_L(0); PG8_MMA(0, 0, At, B0); PG8_BAR; PG8_SCHED;
            PG8_LDB(B1, 0, 1); PG8_STAGE(PG8_SB(0, 0), b2, voffB);
            PG8_BAR; PG8_WAIT_L(0); PG8_MMA(0, 1, At, B1); PG8_BAR;
            PG8_LDA(At, 0, 1); PG8_STAGE(PG8_SA(0, 0), a2, voffA);
            PG8_BAR; PG8_WAIT_L(0); PG8_MMA(1, 0, At, B0); PG8_BAR; PG8_SCHED;
            PG8_STAGE(PG8_SB(0, 1), b2 + hstep, voffB);
            PG8_WAIT_V(6); PG8_BAR; PG8_MMA(1, 1, At, B1); PG8_BAR;
            PG8_LDB(B0, 1, 0); PG8_SCHED; PG8_LDA(At, 1, 0); PG8_STAGE(PG8_SA(0, 1), a2 + hstep, voffA);
            PG8_WAIT_L(8); PG8_BAR; PG8_WAIT_L(0); PG8_MMA(0, 0, At, B0); PG8_BAR; PG8_SCHED;
            PG8_LDB(B1, 1, 1); PG8_STAGE(PG8_SB(1, 0), b3, voffB);
            PG8_BAR; PG8_WAIT_L(0); PG8_MMA(0, 1, At, B1); PG8_BAR;
            PG8_LDA(At, 1, 1); PG8_STAGE(PG8_SA(1, 0), a3, voffA);
            PG8_BAR; PG8_WAIT_L(0); PG8_MMA(1, 0, At, B0); PG8_BAR; PG8_SCHED;
            PG8_STAGE(PG8_SB(1, 1), b3 + hstep, voffB);
            PG8_WAIT_V(6); PG8_BAR; PG8_MMA(1, 1, At, B1); PG8_BAR;
        }
        if constexpr (!Epi::AFTER_DRAIN) { E(acc, cur, wr, wc, fr, fq); S.done(cur); }
        if (!has_next) break;
#pragma unroll
        for (int a = 0; a < 2; ++a)
#pragma unroll
            for (int b = 0; b < 2; ++b)
#pragma unroll
                for (int m = 0; m < 4; ++m)
#pragma unroll
                    for (int n = 0; n < 2; ++n) acc[a][b][m][n] = (f32x4){0.f, 0.f, 0.f, 0.f};
        cur = nxt; cA = nA; cB = nB; ++ui;
    }
    PG8_WAIT_V(0);
    if (wr == 0) PG8_BAR;
    PG8_BAR;
    if constexpr (Epi::AFTER_DRAIN) { E.fused(acc, cur, wr, wc, fr, fq, lds, wid, lane); S.done(cur); }
#undef PG8_SA
#undef PG8_SB
#undef PG8_STAGE
#undef PG8_LDA
#undef PG8_LDB
#undef PG8_MMA
#undef PG8_WAIT_V
#undef PG8_WAIT_L
#undef PG8_BAR
#undef PG8_SCHED
}
}
using pg8::bf16_t; using pg8::bf16x8; using pg8::f32x4; using pg8::u32x4; using pg8::cvt_pk_bf16;
typedef unsigned u32x2 __attribute__((ext_vector_type(2)));
#define LAS PG8_LAS

constexpr int T_ALL = 17408, T_P = 16384;
constexpr size_t MiB = (size_t)1 << 20;
constexpr size_t OFF_WRW = 0, OFF_WHG = 4 * MiB, OFF_WGA = 8 * MiB, OFF_WGB = 10 * MiB, OFF_WOA = 12 * MiB, OFF_WOB = 13 * MiB, OFF_WO = 14 * MiB, OFF_WUP = 16 * MiB, OFF_WDN = 24 * MiB;
constexpr size_t OFF_G = 8 * MiB;
constexpr size_t OFF_SM = 32 * MiB;
constexpr size_t SM_W2T = 0, SM_A2T = 65536, SM_G2T = 131072, SM_V1T = 294912, SM_V2T = 327680, SM_ROWSS = 393216, SM_BONUS = 786432, SM_PGH = 1376256;
constexpr size_t OFF_XB = 34 * MiB, OFF_V0 = 68 * MiB, OFF_A = 85 * MiB, OFF_B = 153 * MiB, SLOT = 17 * MiB;
constexpr size_t WS_NEED = 255 * MiB;
constexpr size_t O_SHP = 17825792, O_RWP = 17833088, O_HGP = 17964160, O_SHS = 18226304, O_RWS = 18343040, O_HGS = 20440192;

__device__ __forceinline__ int tidx() { int t = threadIdx.x; asm volatile("" : "+v"(t)); return t; }
__device__ __forceinline__ int bidx() { int b = blockIdx.x; asm volatile("" : "+s"(b)); return b; }
#define GAS __attribute__((address_space(1)))
__device__ __forceinline__ unsigned char* uptr(unsigned char* q) {
    const unsigned long long v = (unsigned long long)q; unsigned lo = __builtin_amdgcn_readfirstlane((unsigned)v), hi = __builtin_amdgcn_readfirstlane((unsigned)(v >> 32));
    asm volatile("" : "+s"(lo), "+s"(hi));
    return (unsigned char*)(GAS unsigned char*)(((unsigned long long)hi << 32) | lo); }
struct Params { const float* in[30]; float* out; unsigned char* ws; };
struct Ctx { unsigned char* ws; float* out; const unsigned long long* tbl; };
__device__ __forceinline__ const float* ldp(const unsigned long long* tbl, int i) {
    const unsigned long long v = *(const volatile unsigned long long*)(tbl + i);
    const unsigned lo = __builtin_amdgcn_readfirstlane((unsigned)v), hi = __builtin_amdgcn_readfirstlane((unsigned)(v >> 32));
    return (const float*)(GAS const float*)(((unsigned long long)hi << 32) | lo); }
#define INP(p, i) ldp((p).tbl, i)
constexpr size_t SM_TBL = 1703936, SM_BAR = 1769472;
#define XB_TMO      128
#define XB_XCNT(j)  (256  + 64 * (j))
#define XB_XSUB(j)  (1280 + 64 * (j))
#define XB_XGEN(j)  (2304 + 64 * (j))
#define XB_TOP      3328
#define XB_TOPGEN   3392
#define XCD_BAR_WORDS 3456
#define XB_SPIN_CAP (1u << 18)

__device__ __forceinline__ unsigned xb_ld(unsigned* p)              { return __hip_atomic_load(p, __ATOMIC_RELAXED, __HIP_MEMORY_SCOPE_AGENT); }
__device__ __forceinline__ unsigned xb_add(unsigned* p, unsigned v) { return __hip_atomic_fetch_add(p, v, __ATOMIC_RELAXED, __HIP_MEMORY_SCOPE_AGENT); }
__device__ __forceinline__ unsigned xb_xcc_id() { return (unsigned)__builtin_amdgcn_s_getreg((3 << 11) | 20) & 0xFu; }
#define XB_SPIN(cond, bar) do { unsigned _sp = 0; while (cond) { __builtin_amdgcn_s_sleep(1); \
    if ((++_sp & 255u) == 0u) { if (xb_ld(&(bar)[XB_TMO])) break; if (_sp > XB_SPIN_CAP) { atomicAdd(&(bar)[XB_TMO], 1u); break; } } } } while (0)

struct XcdBarrier {
    unsigned* bar; unsigned x;
    volatile LAS unsigned* st;
};

__device__ __forceinline__ XcdBarrier xcd_barrier_post(unsigned* bar, volatile LAS unsigned* st) {
    XcdBarrier b; b.bar = bar; b.x = xb_xcc_id(); b.st = st;
    if (threadIdx.x == 0) (void)xb_add(&bar[XB_XCNT(b.x)], 1u);
    return b;
}
__device__ __forceinline__ void xcd_barrier_complete(unsigned* bar, unsigned x, unsigned& nloc, unsigned& nx) {
    const unsigned G = gridDim.x * gridDim.y * gridDim.z;
    unsigned sum, cnt, mine, sp = 0u;
    for (;;) {
        sum = 0u; cnt = 0u; mine = 0u;
#pragma unroll
        for (unsigned j = 0; j < 16; ++j) { const unsigned c = xb_ld(&bar[XB_XCNT(j)]); sum += c; cnt += (c > 0u) ? 1u : 0u; mine = (j == x) ? c : mine; }
        if (sum == G) break;
        __builtin_amdgcn_s_sleep(1);
        if ((++sp & 255u) == 0u) { if (xb_ld(&bar[XB_TMO])) break; if (sp > XB_SPIN_CAP) { atomicAdd(&bar[XB_TMO], 1u); break; } }
    }
    nloc = mine > 0u ? mine : 1u; nx = cnt > 0u ? cnt : 1u;
}

__device__ __forceinline__ void xcd_barrier(const XcdBarrier& b) {
    asm volatile("s_waitcnt vmcnt(0)" ::: "memory");
    __syncthreads();
    if (threadIdx.x == 0) {
        unsigned* bar = b.bar;
        __builtin_amdgcn_s_waitcnt(0);
        unsigned nloc = b.st[0], nx = b.st[1];
        if (nloc == 0u) { xcd_barrier_complete(bar, b.x, nloc, nx); b.st[0] = nloc; b.st[1] = nx; }
        const unsigned old = xb_add(&bar[XB_XSUB(b.x)], 1u);
        const unsigned gen = old / nloc;
        if (old + 1u == (gen + 1u) * nloc) {
            __builtin_amdgcn_fence(__ATOMIC_RELEASE, "agent");
            asm volatile("s_waitcnt vmcnt(0)" ::: "memory");
            const unsigned og = xb_add(&bar[XB_TOP], 1u);
            const unsigned tg = og / nx;
            if (og + 1u == (tg + 1u) * nx) xb_add(&bar[XB_TOPGEN], 1u);
            else XB_SPIN(xb_ld(&bar[XB_TOPGEN]) == tg, bar);
            __builtin_amdgcn_fence(__ATOMIC_ACQUIRE, "agent");
            xb_add(&bar[XB_XGEN(b.x)], 1u);
            asm volatile("s_waitcnt vmcnt(0)" ::: "memory");
        } else {
            XB_SPIN(xb_ld(&bar[XB_XGEN(b.x)]) == gen, bar);
            __builtin_amdgcn_fence(__ATOMIC_ACQUIRE, "agent");
            asm volatile("s_waitcnt vmcnt(0)" ::: "memory");
        }
    }
    __syncthreads();
}


__device__ __forceinline__ float bf2f(unsigned short b) { return __uint_as_float((unsigned)b << 16); }
__device__ __forceinline__ unsigned short f2bf(float f) { unsigned u = __float_as_uint(f); u += 0x7FFFu + ((u >> 16) & 1u); return (unsigned short)(u >> 16); }
__device__ __forceinline__ float sigm(float x) { return __builtin_amdgcn_rcpf(1.0f + __expf(-x)); }
__device__ __forceinline__ float tanh_fast(float x) { return 1.0f - 2.0f * __builtin_amdgcn_rcpf(1.0f + __expf(2.0f * x)); }
__device__ __forceinline__ float rdl(float x, int i) { return __uint_as_float(__builtin_amdgcn_readlane(__float_as_uint(x), i)); }
__device__ __forceinline__ float wsum(float x) {
#pragma unroll
    for (int o = 32; o; o >>= 1) x += __shfl_xor(x, o);
    return x; }
__device__ __forceinline__ float lo16(unsigned w) { return __uint_as_float(w << 16); }
__device__ __forceinline__ float hi16(unsigned w) { return __uint_as_float(w & 0xffff0000u); }
__device__ __forceinline__ float rstd_of(const float* rowss, int row) { return rsqrtf(rowss[row] * (1.0f / 1024.0f) + 1e-6f); }

template <int MODE> struct EpiBf {
    static constexpr bool PERM = true, AFTER_DRAIN = false;
    bf16_t* O; int ldc; const float* rowss;
    __device__ __forceinline__ void operator()(const f32x4 (&acc)[2][2][4][2], const pg8::Unit& u, int wr, int wc, int fr, int fq) const {
        const int row0 = u.pm * 256 + wr * 64 + fr, col0 = u.pn * 256 + wc * 32 + 8 * fq;
#pragma unroll
        for (int ai = 0; ai < 2; ++ai)
#pragma unroll
            for (int m = 0; m < 4; ++m) {
                const int row = row0 + ai * 128 + m * 16;
                const float s = (MODE == 2) ? 1.0f : rstd_of(rowss, row);
                bf16_t* rowp = O + (size_t)row * ldc + col0;
#pragma unroll
                for (int bj = 0; bj < 2; ++bj) {
                    f32x4 v0 = acc[ai][bj][m][0] * s, v1 = acc[ai][bj][m][1] * s;
                    if (MODE == 1) {
#pragma unroll
                        for (int j = 0; j < 4; ++j) { const float a = fmaxf(v0[j], 0.f), b = fmaxf(v1[j], 0.f); v0[j] = a * a; v1[j] = b * b; } }
                    u32x4 w; w.x = cvt_pk_bf16(v0[0], v0[1]); w.y = cvt_pk_bf16(v0[2], v0[3]); w.z = cvt_pk_bf16(v1[0], v1[1]); w.w = cvt_pk_bf16(v1[2], v1[3]);
                    *(u32x4*)(rowp + bj * 128) = w; } }
    }
};
template <int ACC> struct EpiGate {
    static constexpr bool PERM = true, AFTER_DRAIN = false;
    bf16_t* M; const bf16_t* Tm; const float* rowss;
    __device__ __forceinline__ void operator()(const f32x4 (&acc)[2][2][4][2], const pg8::Unit& u, int wr, int wc, int fr, int fq) const {
        const int row0 = u.pm * 256 + wr * 64 + fr, col0 = u.pn * 256 + wc * 32 + 8 * fq;
#pragma unroll
        for (int ai = 0; ai < 2; ++ai)
#pragma unroll
            for (int m = 0; m < 4; ++m) {
                const int row = row0 + ai * 128 + m * 16;
                const float s = rstd_of(rowss, row);
#pragma unroll
                for (int bj = 0; bj < 2; ++bj) {
                    const size_t off = (size_t)row * 1024 + col0 + bj * 128;
                    const u32x4 tv = *(const u32x4*)(Tm + off);
                    u32x4 pv = (u32x4){0u, 0u, 0u, 0u};
                    if (ACC) pv = *(const u32x4*)(M + off);
                    const f32x4 a0 = acc[ai][bj][m][0] * s, a1 = acc[ai][bj][m][1] * s;
                    float o[8];
                    o[0] = sigm(a0[0]) * lo16(tv.x); o[1] = sigm(a0[1]) * hi16(tv.x); o[2] = sigm(a0[2]) * lo16(tv.y); o[3] = sigm(a0[3]) * hi16(tv.y);
                    o[4] = sigm(a1[0]) * lo16(tv.z); o[5] = sigm(a1[1]) * hi16(tv.z); o[6] = sigm(a1[2]) * lo16(tv.w); o[7] = sigm(a1[3]) * hi16(tv.w);
                    if (ACC) { o[0] += lo16(pv.x); o[1] += hi16(pv.x); o[2] += lo16(pv.y); o[3] += hi16(pv.y); o[4] += lo16(pv.z); o[5] += hi16(pv.z); o[6] += lo16(pv.w); o[7] += hi16(pv.w); }
                    u32x4 w; w.x = cvt_pk_bf16(o[0], o[1]); w.y = cvt_pk_bf16(o[2], o[3]); w.z = cvt_pk_bf16(o[4], o[5]); w.w = cvt_pk_bf16(o[6], o[7]);
                    *(u32x4*)(M + off) = w; } }
    }
};
struct EpiResid {
    static constexpr bool PERM = false, AFTER_DRAIN = false;
    float* X; bf16_t* XB; float* rowss_out; const float* Xp0; const float* Xs0;
    __device__ __forceinline__ void operator()(const f32x4 (&acc)[2][2][4][2], const pg8::Unit& u, int wr, int wc, int fr, int fq) const {
        const int row0 = u.pm * 256 + wr * 64 + fr, col0 = u.pn * 256 + wc * 32 + 4 * fq;
#pragma unroll
        for (int ai = 0; ai < 2; ++ai)
#pragma unroll
            for (int m = 0; m < 4; ++m) {
                const int row = row0 + ai * 128 + m * 16;
                float* xp = X + (size_t)row * 1024 + col0; bf16_t* bp = XB + (size_t)row * 1024 + col0;
                const float* xi = Xp0 ? (row < T_P ? Xp0 + (size_t)row * 1024 + col0 : Xs0 + (size_t)(row - T_P) * 1024 + col0) : xp;
                float ss = 0.f;
#pragma unroll
                for (int bj = 0; bj < 2; ++bj)
#pragma unroll
                    for (int n = 0; n < 2; ++n) {
                        f32x4 xv = *(const f32x4*)(xi + bj * 128 + n * 16) + acc[ai][bj][m][n];
                        *(f32x4*)(xp + bj * 128 + n * 16) = xv;
                        ss += (xv[0] * xv[0] + xv[1] * xv[1]) + (xv[2] * xv[2] + xv[3] * xv[3]);
                        u32x2 w; w.x = cvt_pk_bf16(xv[0], xv[1]); w.y = cvt_pk_bf16(xv[2], xv[3]);
                        *(u32x2*)(bp + bj * 128 + n * 16) = w; }
                ss += __shfl_xor(ss, 16); ss += __shfl_xor(ss, 32);
                if (fq == 0) atomicAdd(rowss_out + row, ss); }
    }
};
template <class Epi> __device__ __forceinline__ void run_gemm(LAS unsigned char* lds, const bf16_t* A, const bf16_t* Bt, int N, int K, const Epi& E, int Mrows = T_ALL) {
    pg8::StaticOrder S; S.init(Mrows, N, (int)gridDim.x, bidx());
    pg8::Gemm g; g.A = A; g.Bt = Bt; g.M = Mrows; g.N = N; g.K = K; g.ld = K;
    pg8::gemm_phase<Epi, pg8::StaticOrder, false>(lds, g, S, E, nullptr);
}


struct OneUnit { int pm, pn, valid;
    __device__ bool next(int i, pg8::Unit& u) const { if (i != 0 || !valid) return false; u.pm = pm; u.pn = pn; return true; }
    __device__ __forceinline__ void a_ready(const pg8::Unit&) const {}
    __device__ __forceinline__ void done(const pg8::Unit&) const {} };
struct EpiPartial {
    static constexpr bool PERM = false, AFTER_DRAIN = false;
    float* PART;
    __device__ __forceinline__ void operator()(const f32x4 (&acc)[2][2][4][2], const pg8::Unit& u, int wr, int wc, int fr, int fq) const {
        const int row0 = (u.pm - 64) * 256 + wr * 64 + fr, col0 = u.pn * 256 + wc * 32 + 4 * fq;
#pragma unroll
        for (int ai = 0; ai < 2; ++ai)
#pragma unroll
            for (int m = 0; m < 4; ++m) { float* xp = PART + (size_t)(row0 + ai * 128 + m * 16) * 1024 + col0;
#pragma unroll
                for (int bj = 0; bj < 2; ++bj)
#pragma unroll
                    for (int n = 0; n < 2; ++n) *(f32x4*)(xp + bj * 128 + n * 16) = acc[ai][bj][m][n]; }
    }
};
constexpr size_t OFF_PART = OFF_B + 4 * SLOT;
__device__ __forceinline__ void run_ffn_down(LAS unsigned char* lds, const bf16_t* HID, const bf16_t* WDN, const EpiResid& E, float* PART) {
    { pg8::StaticOrder S; S.init(T_P, 1024, (int)gridDim.x, bidx());
      pg8::Gemm g; g.A = HID; g.Bt = WDN; g.M = T_P; g.N = 1024; g.K = 4096; g.ld = 4096;
      pg8::gemm_phase<EpiResid, pg8::StaticOrder, false>(lds, g, S, E, nullptr); }
    { const int t = bidx(); OneUnit S; S.valid = t < 128; const int sl = t & 7, u = (t >> 3) & 15; S.pm = 64 + (u >> 2); S.pn = u & 3;
      pg8::Gemm g; g.A = HID + sl * 512; g.Bt = WDN + sl * 512; g.M = T_ALL; g.N = 1024; g.K = 512; g.ld = 4096;
      EpiPartial EA; EA.PART = PART + (size_t)sl * 1024 * 1024;
      pg8::gemm_phase<EpiPartial, OneUnit, false>(lds, g, S, EA, nullptr); }
}
constexpr size_t OFF_GPART = OFF_B + 2 * SLOT;
__device__ __forceinline__ void run_gate_sample_tasks(LAS unsigned char* lds, unsigned char* ws) {
    const int t = bidx(); OneUnit S; S.valid = t < 192;
    const bf16_t* A; const bf16_t* Bt; int ld, slot, u, sl;
    if (t < 32)       { u = t >> 1; sl = t & 1; A = (const bf16_t*)(ws + OFF_B); Bt = (const bf16_t*)(ws + OFF_WOA); ld = 512; slot = sl; }
    else if (t < 64)  { u = (t - 32) >> 1; sl = t & 1; A = (const bf16_t*)(ws + OFF_B + SLOT); Bt = (const bf16_t*)(ws + OFF_WOB); ld = 512; slot = 2 + sl; }
    else if (t < 128) { u = (t - 64) >> 2; sl = t & 3; A = (const bf16_t*)(ws + OFF_XB); Bt = (const bf16_t*)(ws + OFF_WGA); ld = 1024; slot = 4 + sl; }
    else              { u = ((t - 128) >> 2) & 15; sl = t & 3; A = (const bf16_t*)(ws + OFF_XB); Bt = (const bf16_t*)(ws + OFF_WGB); ld = 1024; slot = 8 + sl; }
    S.pm = 64 + (u >> 2); S.pn = u & 3;
    pg8::Gemm g; g.A = A + sl * 256; g.Bt = Bt + sl * 256; g.M = T_ALL; g.N = 1024; g.K = 256; g.ld = ld;
    EpiPartial EA; EA.PART = (float*)(ws + OFF_GPART) + (size_t)slot * 1024 * 1024;
    pg8::gemm_phase<EpiPartial, OneUnit, false>(lds, g, S, EA, nullptr);
}
__device__ void gate_combine(unsigned char* ws, const float* rs_mix) {
    const float* P = (const float*)(ws + OFF_GPART); bf16_t* TA = (bf16_t*)(ws + OFF_A);
    constexpr size_t MM = (size_t)1024 * 1024;
    for (int idx = bidx() * 512 + tidx(); idx < 131072; idx += gridDim.x * 512) {
        const int row = idx >> 7, c8 = (idx & 127) * 8; const size_t o = (size_t)row * 1024 + c8;
        const float s = rstd_of(rs_mix, T_P + row);
        float m[8];
#pragma unroll
        for (int hf = 0; hf < 2; ++hf) {
            const size_t oo = o + hf * 4;
            const float4 ta0 = *(const float4*)(P + oo), ta1 = *(const float4*)(P + MM + oo), tb0 = *(const float4*)(P + 2 * MM + oo), tb1 = *(const float4*)(P + 3 * MM + oo);
            float4 ga = *(const float4*)(P + 4 * MM + oo), gb = *(const float4*)(P + 8 * MM + oo);
#pragma unroll
            for (int j = 1; j < 4; ++j) { const float4 x = *(const float4*)(P + (4 + j) * MM + oo), y = *(const float4*)(P + (8 + j) * MM + oo);
                ga.x += x.x; ga.y += x.y; ga.z += x.z; ga.w += x.w; gb.x += y.x; gb.y += y.y; gb.z += y.z; gb.w += y.w; }
            m[hf * 4 + 0] = sigm(ga.x * s) * (ta0.x + ta1.x) + sigm(gb.x * s) * (tb0.x + tb1.x);
            m[hf * 4 + 1] = sigm(ga.y * s) * (ta0.y + ta1.y) + sigm(gb.y * s) * (tb0.y + tb1.y);
            m[hf * 4 + 2] = sigm(ga.z * s) * (ta0.z + ta1.z) + sigm(gb.z * s) * (tb0.z + tb1.z);
            m[hf * 4 + 3] = sigm(ga.w * s) * (ta0.w + ta1.w) + sigm(gb.w * s) * (tb0.w + tb1.w);
        }
        u32x4 w; w.x = cvt_pk_bf16(m[0], m[1]); w.y = cvt_pk_bf16(m[2], m[3]); w.z = cvt_pk_bf16(m[4], m[5]); w.w = cvt_pk_bf16(m[6], m[7]);
        *(u32x4*)(TA + (size_t)(T_P + row) * 1024 + c8) = w;
    }
}
__device__ void finalize_sample(const Ctx& p, float* rowss_out) {
    unsigned char* ws = uptr(p.ws); bf16_t* XB = (bf16_t*)(ws + OFF_XB); const float* PART = (const float*)(ws + OFF_PART);
    const int tid = tidx(); const int wave = __builtin_amdgcn_readfirstlane(tid >> 6), lane = tid & 63;
    for (int row = T_P + bidx() * 8 + wave; row < T_ALL; row += gridDim.x * 8) {
        float* src = p.out + (size_t)row * 1024; const float* pr = PART + (size_t)(row - T_P) * 1024; float ss = 0.f;
#pragma unroll
        for (int i = 0; i < 4; ++i) { const int c = i * 256 + lane * 4; float4 v = *(const float4*)(src + c);
#pragma unroll
            for (int sl = 0; sl < 8; ++sl) { const float4 q = *(const float4*)(pr + (size_t)sl * 1024 * 1024 + c); v.x += q.x; v.y += q.y; v.z += q.z; v.w += q.w; }
            *(float4*)(src + c) = v;
            ss += v.x * v.x + v.y * v.y + v.z * v.z + v.w * v.w; u32x2 w; w.x = cvt_pk_bf16(v.x, v.y); w.y = cvt_pk_bf16(v.z, v.w); *(u32x2*)(XB + (size_t)row * 1024 + c) = w; }
        ss = wsum(ss); if (lane == 0) rowss_out[row] = ss;
    }
}
__device__ void conv_T(const float* __restrict__ src, int ld, int s0, int cnt, int K, const float* __restrict__ scale, bf16_t* __restrict__ dst, int d0, LAS unsigned char* lds, int vb, int nvb) {
    LAS float* ts = (LAS float*)lds;
    const int tid = tidx(); const int nkt = K / 256, ntile = (cnt / 32) * nkt;
    if (vb < 0) return;
    for (int tile = vb; tile < ntile; tile += nvb) {
        const int n0 = (tile / nkt) * 32, k0 = (tile % nkt) * 256;
        { const int kk = tid >> 3, nq = tid & 7; float4 v[4]; float sc[4];
#pragma unroll
          for (int r = 0; r < 4; ++r) { v[r] = *(const float4*)(src + (size_t)(k0 + r * 64 + kk) * ld + s0 + n0 + nq * 4); sc[r] = scale ? scale[k0 + r * 64 + kk] : 1.0f; }
#pragma unroll
          for (int r = 0; r < 4; ++r) { LAS float* q = ts + (nq * 4) * 257 + r * 64 + kk; q[0] = v[r].x * sc[r]; q[257] = v[r].y * sc[r]; q[514] = v[r].z * sc[r]; q[771] = v[r].w * sc[r]; } }
        __syncthreads();
        { const int n = tid >> 4, kq = tid & 15;
#pragma unroll
          for (int r = 0; r < 4; ++r) { const LAS float* q = ts + n * 257 + r * 64 + kq * 4; u32x2 w; w.x = cvt_pk_bf16(q[0], q[1]); w.y = cvt_pk_bf16(q[2], q[3]);
            *(u32x2*)(dst + (size_t)(d0 + n0 + n) * K + k0 + r * 64 + kq * 4) = w; } }
        __syncthreads();
    }
}
__device__ void conv_small(const float* __restrict__ src, int ld, int cnt, int K, bf16_t* __restrict__ dst, int vb, int nvb) {
    if (vb < 0) return;
    for (int i = vb * 512 + tidx(); i < cnt * K; i += nvb * 512) { const int c = i / K, j = i % K; dst[i] = f2bf(src[(size_t)j * ld + c]); }
}
__device__ void phase_convert_early(const Ctx& p, int l, LAS unsigned char* lds, int vb, int nvb) {
    unsigned char* ws = uptr(p.ws);
    const float* win = INP(p, 6) + (size_t)l * 1024 * 5920; const float* nm = INP(p, 5) + l * 1024;
    conv_T(win, 5920, 0, 1824, 1024, nm, (bf16_t*)(ws + OFF_WRW), 0, lds, vb, nvb);
    { u32x4* z = (u32x4*)(ws + OFF_WRW + (size_t)1824 * 1024 * 2); const int n = 224 * 1024 * 2 / 16;
      unsigned zz = 0u; asm volatile("" : "+v"(zz));
      if (vb >= 0) for (int i = vb * 512 + tidx(); i < n; i += nvb * 512) z[i] = (u32x4){zz, zz, zz, zz}; }
    conv_small(INP(p, 9) + (size_t)l * 64 * 512, 512, 512, 64, (bf16_t*)(ws + OFF_SM + SM_W2T), vb, nvb);
    conv_small(INP(p, 11) + (size_t)l * 64 * 512, 512, 512, 64, (bf16_t*)(ws + OFF_SM + SM_A2T), vb, nvb);
    conv_small(INP(p, 12) + (size_t)l * 160 * 512, 512, 512, 160, (bf16_t*)(ws + OFF_SM + SM_G2T), vb, nvb);
    if (l == 1) {
        conv_small(INP(p, 14), 32, 32, 512, (bf16_t*)(ws + OFF_SM + SM_V1T), vb, nvb);
        conv_small(INP(p, 15), 512, 512, 32, (bf16_t*)(ws + OFF_SM + SM_V2T), vb, nvb);
    }
}
__device__ void phase_convert_hg(const Ctx& p, int l, LAS unsigned char* lds, int vb, int nvb) {
    unsigned char* ws = uptr(p.ws);
    conv_T(INP(p, 6) + (size_t)l * 1024 * 5920, 5920, 1824, 2048, 1024, INP(p, 5) + l * 1024, (bf16_t*)(ws + OFF_WHG), 0, lds, vb, nvb);
}
__device__ void phase_convert_late(const Ctx& p, int l, LAS unsigned char* lds, int vb, int nvb) {
    unsigned char* ws = uptr(p.ws);
    const float* win = INP(p, 6) + (size_t)l * 1024 * 5920; const float* nm = INP(p, 5) + l * 1024;
    conv_T(win, 5920, 3872, 1024, 1024, nm, (bf16_t*)(ws + OFF_WGA), 0, lds, vb, nvb);
    conv_T(win, 5920, 4896, 1024, 1024, nm, (bf16_t*)(ws + OFF_WGB), 0, lds, vb, nvb);
    conv_T(INP(p, 23) + (size_t)l * 512 * 1024, 1024, 0, 1024, 512, nullptr, (bf16_t*)(ws + OFF_WOA), 0, lds, vb, nvb);
    conv_T(INP(p, 24) + (size_t)l * 512 * 1024, 1024, 0, 1024, 512, nullptr, (bf16_t*)(ws + OFF_WOB), 0, lds, vb, nvb);
    conv_T(INP(p, 25) + (size_t)l * 1024 * 1024, 1024, 0, 1024, 1024, nullptr, (bf16_t*)(ws + OFF_WO), 0, lds, vb, nvb);
    conv_T(INP(p, 27) + (size_t)l * 1024 * 4096, 4096, 0, 4096, 1024, INP(p, 26) + l * 1024, (bf16_t*)(ws + OFF_WUP), 0, lds, vb, nvb);
    conv_T(INP(p, 28) + (size_t)l * 4096 * 1024, 1024, 0, 1024, 4096, nullptr, (bf16_t*)(ws + OFF_WDN), 0, lds, vb, nvb);
}
__device__ void phase_x0(const Ctx& p) {
    const int tid = tidx(); const int wave = __builtin_amdgcn_readfirstlane(tid >> 6), lane = tid & 63;
    unsigned char* ws = uptr(p.ws);
    float* rowss = (float*)(ws + OFF_SM + SM_ROWSS); bf16_t* XB = (bf16_t*)(ws + OFF_XB);
    for (int row = bidx() * 8 + wave; row < T_ALL; row += gridDim.x * 8) {
        const float* src = row < T_P ? INP(p, 0) + (size_t)row * 1024 : INP(p, 1) + (size_t)(row - T_P) * 1024;
        float ss = 0.f;
#pragma unroll
        for (int i = 0; i < 4; ++i) { const int c = i * 256 + lane * 4; const float4 v = *(const float4*)(src + c);
            ss += v.x * v.x + v.y * v.y + v.z * v.z + v.w * v.w; u32x2 w; w.x = cvt_pk_bf16(v.x, v.y); w.y = cvt_pk_bf16(v.z, v.w); *(u32x2*)(XB + (size_t)row * 1024 + c) = w; }
        ss = wsum(ss); if (lane == 0) rowss[row] = ss;
    }
    for (int i = bidx() * 512 + tidx(); i < 4 * T_ALL; i += gridDim.x * 512) rowss[T_ALL + i] = 0.f;
}
__device__ __forceinline__ u32x2 pack4(float a, float b, float c, float d) { u32x2 w; w.x = cvt_pk_bf16(a, b); w.y = cvt_pk_bf16(c, d); return w; }
__device__ void phase_prep(const Ctx& p, int l, LAS unsigned char* lds) {
    constexpr int MXS = 1832, MIDS = 40;
    unsigned char* ws = uptr(p.ws);
    const bf16_t* PR = (const bf16_t*)(ws + OFF_A);
    LAS bf16_t* MX = (LAS bf16_t*)lds; LAS bf16_t* MID = (LAS bf16_t*)(lds + 32 * MXS * 2);
    const int tid = tidx(); const int wave = __builtin_amdgcn_readfirstlane(tid >> 6), lane = tid & 63, fr = lane & 15, fq = lane >> 4;
    const float* mu = INP(p, 7) + l * 1824;
    const bf16_t* w2T = (const bf16_t*)(ws + OFF_SM + SM_W2T); const bf16_t* a2T = (const bf16_t*)(ws + OFF_SM + SM_A2T); const bf16_t* g2T = (const bf16_t*)(ws + OFF_SM + SM_G2T);
    const bf16_t* v1T = (const bf16_t*)(ws + OFF_SM + SM_V1T); const bf16_t* v2T = (const bf16_t*)(ws + OFF_SM + SM_V2T);
    bf16_t* oR = (bf16_t*)(ws + OFF_B); bf16_t* oV = (bf16_t*)(l == 0 ? ws + OFF_V0 : ws + OFF_B + SLOT); bf16_t* oE = (bf16_t*)(ws + OFF_B + 2 * SLOT);
    bf16_t* oK = (bf16_t*)(ws + OFF_B + 3 * SLOT); bf16_t* oA = (bf16_t*)(ws + OFF_B + 4 * SLOT); bf16_t* oB = (bf16_t*)(ws + OFF_B + 5 * SLOT);
    bf16_t* oG = (bf16_t*)(ws + OFF_G); const bf16_t* V0 = (const bf16_t*)(ws + OFF_V0);
    float* bonus = (float*)(ws + OFF_SM + SM_BONUS);
    const float* w0 = INP(p, 8) + l * 512; const float* a0 = INP(p, 10) + l * 512; const float* kkp = INP(p, 16) + l * 512; const float* kap = INP(p, 17) + l * 512; const float* rkp = INP(p, 18) + l * 512;
    const float* v0p = INP(p, 13);
    for (int ti = bidx(); ti < T_ALL / 32; ti += gridDim.x) {
        const int t0 = ti * 32;
        if (tid < 456) {
            const int cgp = tid % 228, rh = tid / 228, c0 = cgp * 8, rstart = rh * 16;
            float prev[8], m8[8];
            { const float4 a = *(const float4*)(mu + c0), b = *(const float4*)(mu + c0 + 4); m8[0] = a.x; m8[1] = a.y; m8[2] = a.z; m8[3] = a.w; m8[4] = b.x; m8[5] = b.y; m8[6] = b.z; m8[7] = b.w; }
            const bool seq_start = (rh == 0) && (t0 >= T_P || (t0 % 8192) == 0);
            if (seq_start) {
                if (t0 >= T_P) { const float* sp = INP(p, 2) + ((size_t)l * 32 + (t0 - T_P) / 32) * 1824 + c0;
#pragma unroll
                    for (int j = 0; j < 8; ++j) prev[j] = sp[j]; }
                else {
#pragma unroll
                    for (int j = 0; j < 8; ++j) prev[j] = 0.f; }
            } else {
                const u32x4 w = *(const u32x4*)(PR + (size_t)(t0 + rstart - 1) * 2048 + c0);
                prev[0] = lo16(w.x); prev[1] = hi16(w.x); prev[2] = lo16(w.y); prev[3] = hi16(w.y); prev[4] = lo16(w.z); prev[5] = hi16(w.z); prev[6] = lo16(w.w); prev[7] = hi16(w.w);
            }
            const int fn = c0 < 1536 ? 0 : (c0 < 1600 ? 1 : (c0 < 1664 ? 0 : 2));
#pragma unroll 1
            for (int r8 = 0; r8 < 16; r8 += 8) {
            u32x4 wrow[8];
#pragma unroll
            for (int r = 0; r < 8; ++r) wrow[r] = *(const u32x4*)(PR + (size_t)(t0 + rstart + r8 + r) * 2048 + c0);
#pragma unroll
            for (int rr = 0; rr < 8; ++rr) {
                const int r = r8 + rr; const u32x4 w = wrow[rr];
                float cur[8], o[8];
                cur[0] = lo16(w.x); cur[1] = hi16(w.x); cur[2] = lo16(w.y); cur[3] = hi16(w.y); cur[4] = lo16(w.z); cur[5] = hi16(w.z); cur[6] = lo16(w.w); cur[7] = hi16(w.w);
#pragma unroll
                for (int j = 0; j < 8; ++j) { float x = cur[j] + (prev[j] - cur[j]) * m8[j]; if (fn == 1) x = tanh_fast(x); else if (fn == 2) x = sigm(x); o[j] = x; prev[j] = cur[j]; }
                u32x4 q; q.x = cvt_pk_bf16(o[0], o[1]); q.y = cvt_pk_bf16(o[2], o[3]); q.z = cvt_pk_bf16(o[4], o[5]); q.w = cvt_pk_bf16(o[6], o[7]);
                *(LAS u32x4*)(MX + (rstart + r) * MXS + c0) = q;
            }
            }
            if (rh == 1) {
                const bool last = t0 >= T_P || ((t0 + 32) % 8192) == 0;
                if (last) { float* dst = t0 >= T_P ? p.out + O_SHS + ((size_t)l * 32 + (t0 - T_P) / 32) * 1824 + c0 : p.out + O_SHP + ((size_t)l * 2 + t0 / 8192) * 1824 + c0;
#pragma unroll
                    for (int j = 0; j < 8; ++j) dst[j] = prev[j]; }
            }
        }
        __syncthreads();
        if (l == 1 && VRES && VRES != 2) {
            if (wave < 4) {
                const int tt = wave & 1, ot = wave >> 1; f32x4 acc = (f32x4){0.f, 0.f, 0.f, 0.f};
#pragma unroll 4
                for (int ks = 0; ks < 16; ++ks) {
                    const bf16x8 X = *(const bf16x8*)(v1T + (ot * 16 + fr) * 512 + ks * 32 + fq * 8);
                    const bf16x8 Y = *(const LAS bf16x8*)(MX + (tt * 16 + fr) * MXS + 1024 + ks * 32 + fq * 8);
                    acc = __builtin_amdgcn_mfma_f32_16x16x32_bf16(X, Y, acc, 0, 0, 0); }
                *(LAS u32x2*)(MID + (tt * 16 + fr) * MIDS + ot * 16 + 4 * fq) = pack4(acc[0], acc[1], acc[2], acc[3]);
            }
            __syncthreads();
        }
        const int h = wave;
        float ss[2] = {0.f, 0.f}, bon[2] = {0.f, 0.f};
#pragma unroll 1
        for (int ct = 0; ct < 4; ++ct) {
            const int crow = h * 64 + ct * 16 + fr, c = h * 64 + ct * 16 + 4 * fq;
            bf16x8 xw[2], xa[2], xg[5], xv;
#pragma unroll
            for (int ks = 0; ks < 2; ++ks) { xw[ks] = *(const bf16x8*)(w2T + crow * 64 + ks * 32 + fq * 8); xa[ks] = *(const bf16x8*)(a2T + crow * 64 + ks * 32 + fq * 8); }
#pragma unroll
            for (int ks = 0; ks < 5; ++ks) xg[ks] = *(const bf16x8*)(g2T + crow * 160 + ks * 32 + fq * 8);
            if (l == 1) xv = *(const bf16x8*)(v2T + crow * 32 + fq * 8); else xv = xw[0];
            const float4 w04 = *(const float4*)(w0 + c), a04 = *(const float4*)(a0 + c), kk_4 = *(const float4*)(kkp + c), ka4 = *(const float4*)(kap + c), rk4 = *(const float4*)(rkp + c);
            const float w0a[4] = {w04.x, w04.y, w04.z, w04.w}, a0a[4] = {a04.x, a04.y, a04.z, a04.w}, kka[4] = {kk_4.x, kk_4.y, kk_4.z, kk_4.w}, kaa[4] = {ka4.x, ka4.y, ka4.z, ka4.w}, rka[4] = {rk4.x, rk4.y, rk4.z, rk4.w};
            float v0a[4] = {0.f, 0.f, 0.f, 0.f};
            if (l == 1) { const float4 v04 = *(const float4*)(v0p + c); v0a[0] = v04.x; v0a[1] = v04.y; v0a[2] = v04.z; v0a[3] = v04.w; }
            u32x2 fwv[2] = {(u32x2){0u, 0u}, (u32x2){0u, 0u}};
            if (l == 1) { fwv[0] = *(const u32x2*)(V0 + (size_t)(t0 + fr) * 512 + c); fwv[1] = *(const u32x2*)(V0 + (size_t)(t0 + 16 + fr) * 512 + c); }
#pragma unroll
            for (int tt = 0; tt < 2; ++tt) {
                const LAS bf16_t* yrow = MX + (tt * 16 + fr) * MXS + fq * 8;
                f32x4 aW = (f32x4){0.f, 0.f, 0.f, 0.f}, aA = aW, aG = aW, aV = aW;
#pragma unroll
                for (int ks = 0; ks < 2; ++ks) { aW = __builtin_amdgcn_mfma_f32_16x16x32_bf16(xw[ks], *(const LAS bf16x8*)(yrow + 1536 + ks * 32), aW, 0, 0, 0);
                                                 aA = __builtin_amdgcn_mfma_f32_16x16x32_bf16(xa[ks], *(const LAS bf16x8*)(yrow + 1600 + ks * 32), aA, 0, 0, 0); }
#pragma unroll
                for (int ks = 0; ks < 5; ++ks) aG = __builtin_amdgcn_mfma_f32_16x16x32_bf16(xg[ks], *(const LAS bf16x8*)(yrow + 1664 + ks * 32), aG, 0, 0, 0);
                if (l == 1) aV = __builtin_amdgcn_mfma_f32_16x16x32_bf16(xv, *(const LAS bf16x8*)(MID + (tt * 16 + fr) * MIDS + fq * 8), aV, 0, 0, 0);
                const int j = tt * 16 + fr, t = t0 + j;
                LAS bf16_t* mrow = MX + j * MXS + c;
                const u32x2 rw = *(const LAS u32x2*)(mrow), kw = *(const LAS u32x2*)(mrow + 512), vw = *(const LAS u32x2*)(mrow + 1024);
                const float rr[4] = {lo16(rw.x), hi16(rw.x), lo16(rw.y), hi16(rw.y)}, kk4[4] = {lo16(kw.x), hi16(kw.x), lo16(kw.y), hi16(kw.y)};
                float vv[4] = {lo16(vw.x), hi16(vw.x), lo16(vw.y), hi16(vw.y)};
                if (l == 1) {
                    const u32x2 fw = fwv[tt]; const float vf[4] = {lo16(fw.x), hi16(fw.x), lo16(fw.y), hi16(fw.y)};
#pragma unroll
                    for (int e = 0; e < 4; ++e) { const float vg = sigm(v0a[e] + aV[e]); vv[e] = vv[e] + (vf[e] - vv[e]) * vg; }
                }
                float ew[4], kh[4], kr4[4], ag4[4];
#pragma unroll
                for (int e = 0; e < 4; ++e) {
                    ew[e] = 0.60653066f * sigm(w0a[e] + aW[e]);
                    const float a = sigm(a0a[e] + aA[e]); ag4[e] = a;
                    const float kr = kk4[e] * kka[e]; kr4[e] = kr; ss[tt] += kr * kr;
                    kh[e] = kk4[e] * (1.0f + (a - 1.0f) * kaa[e]);
                    bon[tt] += rr[e] * kh[e] * rka[e];
                }
                const size_t o = (size_t)t * 512 + c;
                *(u32x2*)(oR + o) = rw;
                *(u32x2*)(oV + o) = pack4(vv[0], vv[1], vv[2], vv[3]);
                *(u32x2*)(oE + o) = pack4(ew[0], ew[1], ew[2], ew[3]);
                *(u32x2*)(oK + o) = pack4(kh[0], kh[1], kh[2], kh[3]);
                *(u32x2*)(oG + o) = pack4(aG[0], aG[1], aG[2], aG[3]);
                *(LAS u32x2*)(mrow) = pack4(ag4[0], ag4[1], ag4[2], ag4[3]);
                *(LAS u32x2*)(mrow + 512) = pack4(kr4[0], kr4[1], kr4[2], kr4[3]);
            }
        }
#pragma unroll
        for (int tt = 0; tt < 2; ++tt) {
            float s1 = ss[tt], b1 = bon[tt];
            s1 += __shfl_xor(s1, 16); s1 += __shfl_xor(s1, 32); b1 += __shfl_xor(b1, 16); b1 += __shfl_xor(b1, 32);
            const float inv = rsqrtf(fmaxf(s1, 1e-24f));
            const int j = tt * 16 + fr, t = t0 + j;
#pragma unroll
            for (int ct = 0; ct < 4; ++ct) {
                const int c = h * 64 + ct * 16 + 4 * fq;
                const LAS bf16_t* mrow = MX + j * MXS + c;
                const u32x2 aw = *(const LAS u32x2*)(mrow), kw = *(const LAS u32x2*)(mrow + 512);
                const float ag4[4] = {lo16(aw.x), hi16(aw.x), lo16(aw.y), hi16(aw.y)}; float k4[4] = {lo16(kw.x) * inv, hi16(kw.x) * inv, lo16(kw.y) * inv, hi16(kw.y) * inv};
                const size_t o = (size_t)t * 512 + c;
                *(u32x2*)(oA + o) = pack4(-k4[0], -k4[1], -k4[2], -k4[3]);
                *(u32x2*)(oB + o) = pack4(k4[0] * ag4[0], k4[1] * ag4[1], k4[2] * ag4[2], k4[3] * ag4[3]);
            }
            if (fq == 0) bonus[(size_t)t * 8 + h] = b1;
        }
        __syncthreads();
    }
}

typedef float f2 __attribute__((ext_vector_type(2)));
__device__ __forceinline__ f2 pfma(f2 a, f2 b, f2 c) { return __builtin_elementwise_fma(a, b, c); }
template <bool ID> __device__ __forceinline__ void rwkv_scan(const bf16_t* __restrict__ R, const bf16_t* __restrict__ EW, const bf16_t* __restrict__ K, const bf16_t* __restrict__ V,
        const bf16_t* __restrict__ A, const bf16_t* __restrict__ B, unsigned base, int nsteps, f2 (&Sv)[32], f2 (&Si)[32], bf16_t* __restrict__ YH, bf16_t* __restrict__ QH, LAS float* L, int lane) {
    unsigned short q1[6], q2[6];
    { unsigned o = base; q1[0] = R[o]; q1[1] = EW[o]; q1[2] = K[o]; q1[3] = V[o]; q1[4] = A[o]; q1[5] = B[o];
      o = base + 512u; q2[0] = R[o]; q2[1] = EW[o]; q2[2] = K[o]; q2[3] = V[o]; q2[4] = A[o]; q2[5] = B[o]; }
    const LAS f32x4* pa = (const LAS f32x4*)L;
    float sav, sai;
    { L[lane] = bf2f(q1[4]);
      f2 av = {0.f, 0.f}, ai = {0.f, 0.f};
#pragma unroll
      for (int q = 0; q < 16; ++q) { const f32x4 a4 = pa[q]; const f2 a01 = {a4[0], a4[1]}, a23 = {a4[2], a4[3]};
          av = pfma(Sv[2 * q], a01, av); av = pfma(Sv[2 * q + 1], a23, av); if (ID) { ai = pfma(Si[2 * q], a01, ai); ai = pfma(Si[2 * q + 1], a23, ai); } }
      sav = av[0] + av[1]; sai = ai[0] + ai[1]; }
#pragma unroll 1
    for (int s = 0; s < nsteps; ++s) {
        L[lane] = bf2f(q2[4]); L[64 + lane] = __expf(-bf2f(q1[1])); L[128 + lane] = bf2f(q1[5]); L[192 + lane] = bf2f(q1[2]); L[256 + lane] = bf2f(q1[0]);
        const float v = bf2f(q1[3]);
#pragma unroll
        for (int j = 0; j < 6; ++j) q1[j] = q2[j];
        { const unsigned o = base + (unsigned)(s + 2 < nsteps ? s + 2 : nsteps - 1) * 512u; q2[0] = R[o]; q2[1] = EW[o]; q2[2] = K[o]; q2[3] = V[o]; q2[4] = A[o]; q2[5] = B[o]; }
        const f2 sav2 = {sav, sav}, sai2 = {sai, sai}, v2 = {v, v};
        f2 yv = {0.f, 0.f}, yi = {0.f, 0.f}, yv1 = {0.f, 0.f}, yi1 = {0.f, 0.f}, nv = {0.f, 0.f}, ni = {0.f, 0.f}, nv1 = {0.f, 0.f}, ni1 = {0.f, 0.f};
        f32x4 ca = pa[0], cw = pa[16], cb = pa[32], ck = pa[48], cr = pa[64];
#pragma unroll
        for (int q = 0; q < 16; ++q) {
            const f32x4 a4 = ca, w4 = cw, b4 = cb, k4 = ck, r4 = cr;
            if (q < 15) { ca = pa[1 + q]; cw = pa[17 + q]; cb = pa[33 + q]; ck = pa[49 + q]; cr = pa[65 + q]; }
            __builtin_amdgcn_sched_barrier(0);
            { const f2 a2 = {a4[0], a4[1]}, w2 = {w4[0], w4[1]}, b2 = {b4[0], b4[1]}, k2 = {k4[0], k4[1]}, r2 = {r4[0], r4[1]};
              f2 tv = sav2 * b2; tv = pfma(v2, k2, tv); Sv[2 * q] = pfma(Sv[2 * q], w2, tv); yv = pfma(Sv[2 * q], r2, yv); nv = pfma(Sv[2 * q], a2, nv);
              if (ID) { const f2 ti = sai2 * b2; Si[2 * q] = pfma(Si[2 * q], w2, ti); yi = pfma(Si[2 * q], r2, yi); ni = pfma(Si[2 * q], a2, ni); } }
            { const f2 a2 = {a4[2], a4[3]}, w2 = {w4[2], w4[3]}, b2 = {b4[2], b4[3]}, k2 = {k4[2], k4[3]}, r2 = {r4[2], r4[3]};
              f2 tv = sav2 * b2; tv = pfma(v2, k2, tv); Sv[2 * q + 1] = pfma(Sv[2 * q + 1], w2, tv); yv1 = pfma(Sv[2 * q + 1], r2, yv1); nv1 = pfma(Sv[2 * q + 1], a2, nv1);
              if (ID) { const f2 ti = sai2 * b2; Si[2 * q + 1] = pfma(Si[2 * q + 1], w2, ti); yi1 = pfma(Si[2 * q + 1], r2, yi1); ni1 = pfma(Si[2 * q + 1], a2, ni1); } }
        }
        sav = (nv[0] + nv[1]) + (nv1[0] + nv1[1]); sai = (ni[0] + ni[1]) + (ni1[0] + ni1[1]);
        const unsigned cbo = base + (unsigned)s * 512u;
        YH[cbo] = f2bf((yv[0] + yv[1]) + (yv1[0] + yv1[1])); if (ID) QH[cbo] = f2bf((yi[0] + yi[1]) + (yi1[0] + yi1[1]));
    }
}
__device__ void phase_rwkv_scan(const Ctx& p, int l, LAS unsigned char* lds) {
    unsigned char* ws = uptr(p.ws);
    const bf16_t* R = (const bf16_t*)(ws + OFF_B); const bf16_t* V = (const bf16_t*)(l == 0 ? ws + OFF_V0 : ws + OFF_B + SLOT); const bf16_t* EW = (const bf16_t*)(ws + OFF_B + 2 * SLOT);
    const bf16_t* K = (const bf16_t*)(ws + OFF_B + 3 * SLOT); const bf16_t* A = (const bf16_t*)(ws + OFF_B + 4 * SLOT); const bf16_t* B = (const bf16_t*)(ws + OFF_B + 5 * SLOT);
    bf16_t* YH = (bf16_t*)(ws + OFF_A); bf16_t* QH = (bf16_t*)(ws + OFF_A + SLOT); float* P = (float*)(ws + OFF_A + 34 * MiB); float* UC = (float*)(ws + OFF_A + 50 * MiB);
    const int tid = tidx(); const int wave = __builtin_amdgcn_readfirstlane(tid >> 6), lane = tid & 63;
    LAS float* L = (LAS float*)(lds + wave * 5120);
    if (wave < 4) {
        for (int item = bidx() * 4 + wave; item < 1024; item += gridDim.x * 4) {
            const int b = item >> 9, c = (item >> 3) & 63, h = item & 7;
            f2 Sv[32], Si[32]; const int li = tidx() & 63;
#pragma unroll
            for (int i = 0; i < 32; ++i) { Sv[i] = (f2){0.f, 0.f}; Si[i] = (f2){(2 * i == li) ? 1.f : 0.f, (2 * i + 1 == li) ? 1.f : 0.f}; }
            rwkv_scan<true>(R, EW, K, V, A, B, (unsigned)((b * 8192 + c * 128) * 512 + h * 64 + lane), 128, Sv, Si, YH, QH, L, lane);
            const int ln = tidx() & 63; int item2 = item; asm volatile("" : "+s"(item2));
            float* pp = P + (size_t)item2 * 4096 + ln * 64; float* up = UC + (size_t)item2 * 4096 + ln * 64;
#pragma unroll
            for (int i = 0; i < 32; i += 2) { *(float4*)(pp + 2 * i) = make_float4(Si[i][0], Si[i][1], Si[i + 1][0], Si[i + 1][1]); *(float4*)(up + 2 * i) = make_float4(Sv[i][0], Sv[i][1], Sv[i + 1][0], Sv[i + 1][1]); }
        }
    } else if (wave == 4) {
        for (int item = bidx(); item < 256; item += gridDim.x) {
            const int s = item >> 3, h = item & 7;
            const size_t so = (((size_t)l * 32 + s) * 8 + h) * 4096 + lane * 64;
            f2 Sv[32], Si[32];
            const float* sp = INP(p, 3) + so;
#pragma unroll
            for (int i = 0; i < 32; i += 2) { const float4 q = *(const float4*)(sp + 2 * i); Sv[i] = (f2){q.x, q.y}; Sv[i + 1] = (f2){q.z, q.w}; Si[i] = (f2){0.f, 0.f}; Si[i + 1] = (f2){0.f, 0.f}; }
            rwkv_scan<false>(R, EW, K, V, A, B, (unsigned)((T_P + s * 32) * 512 + h * 64 + lane), 32, Sv, Si, YH, QH, L, lane);
            float* op = p.out + O_RWS + so;
#pragma unroll
            for (int i = 0; i < 32; i += 2) *(float4*)(op + 2 * i) = make_float4(Sv[i][0], Sv[i][1], Sv[i + 1][0], Sv[i + 1][1]);
        }
    }
}
template <int CTRL> __device__ __forceinline__ float dpp_mov(float x) { return __uint_as_float(__builtin_amdgcn_update_dpp(0, __float_as_uint(x), CTRL, 0xF, 0xF, true)); }
__device__ __forceinline__ float wsum_fast(float x) {
    x += dpp_mov<0xB1>(x); x += dpp_mov<0x4E>(x); x += dpp_mov<0x141>(x); x += dpp_mov<0x140>(x);
    float t = rdl(x, 0); t += rdl(x, 16); t += rdl(x, 32); t += rdl(x, 48); return t; }
__device__ void phase_rwkv_chain(const Ctx& p, int l) {
    unsigned char* ws = uptr(p.ws);
    const float* P = (const float*)(ws + OFF_A + 34 * MiB); float* UC = (float*)(ws + OFF_A + 50 * MiB);
    const int tid = tidx(); const int wave = __builtin_amdgcn_readfirstlane(tid >> 6), lane = tid & 63;
    if (wave >= 4) return;
    for (int it = bidx() * 4 + wave; it < 1024; it += gridDim.x * 4) {
        const int b = it >> 9, h = (it >> 6) & 7, v = it & 63;
        const float* pb = P + (size_t)((b * 64) * 8 + h) * 4096 + lane;
        float* ub = UC + (size_t)((b * 64) * 8 + h) * 4096 + v * 64 + lane;
        float row = 0.f; float PA[64], PB[64];
#pragma unroll
        for (int i = 0; i < 64; ++i) PA[i] = pb[i * 64];
        float ucA = ub[0];
        for (int c = 0; c < 64; c += 2) {
            { const float* pc = pb + (size_t)(c + 1) * 32768;
#pragma unroll
              for (int i = 0; i < 64; ++i) PB[i] = pc[i * 64]; }
            const float ucB = ub[(size_t)(c + 1) * 32768];
            ub[(size_t)c * 32768] = row;
            { float n0 = ucA, n1 = 0.f;
#pragma unroll
              for (int i = 0; i < 64; i += 2) { n0 = fmaf(rdl(row, i), PA[i], n0); n1 = fmaf(rdl(row, i + 1), PA[i + 1], n1); }
              row = n0 + n1; }
            if (c + 2 < 64) { const float* pc = pb + (size_t)(c + 2) * 32768;
#pragma unroll
                for (int i = 0; i < 64; ++i) PA[i] = pc[i * 64];
                ucA = ub[(size_t)(c + 2) * 32768]; }
            ub[(size_t)(c + 1) * 32768] = row;
            { float n0 = ucB, n1 = 0.f;
#pragma unroll
              for (int i = 0; i < 64; i += 2) { n0 = fmaf(rdl(row, i), PB[i], n0); n1 = fmaf(rdl(row, i + 1), PB[i + 1], n1); }
              row = n0 + n1; }
        }
        p.out[O_RWP + (((size_t)l * 2 + b) * 8 + h) * 4096 + v * 64 + lane] = row;
    }
}
__device__ void phase_rwkv_fix(const Ctx& p, int l) {
    unsigned char* ws = uptr(p.ws);
    const bf16_t* YH = (const bf16_t*)(ws + OFF_A); const bf16_t* QH = (const bf16_t*)(ws + OFF_A + SLOT); const float* UC = (const float*)(ws + OFF_A + 50 * MiB);
    const bf16_t* V = (const bf16_t*)(l == 0 ? ws + OFF_V0 : ws + OFF_B + SLOT); const bf16_t* G = (const bf16_t*)(ws + OFF_G); const float* bonus = (const float*)(ws + OFF_SM + SM_BONUS);
    bf16_t* YA = (bf16_t*)(ws + OFF_B);
    const int tid = tidx(); const int wave = __builtin_amdgcn_readfirstlane(tid >> 6), lane = tid & 63, fr = lane & 15, fq = lane >> 4;
    const float* lnw = INP(p, 19) + l * 512; const float* lnb = INP(p, 20) + l * 512;
    for (int item = bidx() * 8 + wave; item < 4096 + 256; item += gridDim.x * 8) {
        const bool smp = item >= 4096;
        int h, t0, it = 0, ntile;
        if (!smp) { const int tq = item & 3; it = item >> 2; const int b = it >> 9, c = (it >> 3) & 63; h = it & 7; t0 = b * 8192 + c * 128 + tq * 32; ntile = 2; }
        else { const int si = item - 4096; h = si & 7; t0 = T_P + (si >> 3) * 32; ntile = 2; }
        bf16x8 X[4][2];
        if (!smp) {
#pragma unroll
            for (int vt = 0; vt < 4; ++vt)
#pragma unroll
                for (int ks = 0; ks < 2; ++ks) { const float* sp = UC + (size_t)it * 4096 + (vt * 16 + fr) * 64 + ks * 32 + fq * 8; const float4 a = *(const float4*)sp, b4 = *(const float4*)(sp + 4);
                    u32x4 w; w.x = cvt_pk_bf16(a.x, a.y); w.y = cvt_pk_bf16(a.z, a.w); w.z = cvt_pk_bf16(b4.x, b4.y); w.w = cvt_pk_bf16(b4.z, b4.w); X[vt][ks] = __builtin_bit_cast(bf16x8, w); }
        }
        float gw[4][4], gb[4][4];
#pragma unroll
        for (int vt = 0; vt < 4; ++vt) { const float4 a = *(const float4*)(lnw + h * 64 + vt * 16 + 4 * fq), b4 = *(const float4*)(lnb + h * 64 + vt * 16 + 4 * fq);
            gw[vt][0] = a.x; gw[vt][1] = a.y; gw[vt][2] = a.z; gw[vt][3] = a.w; gb[vt][0] = b4.x; gb[vt][1] = b4.y; gb[vt][2] = b4.z; gb[vt][3] = b4.w; }
        for (int tt = 0; tt < ntile; ++tt) {
            const int t = t0 + tt * 16 + fr; const size_t ob = (size_t)t * 512 + h * 64;
            float y[4][4];
            u32x2 yw[4], vw[4], gg[4];
#pragma unroll
            for (int vt = 0; vt < 4; ++vt) { yw[vt] = *(const u32x2*)(YH + ob + vt * 16 + 4 * fq); vw[vt] = *(const u32x2*)(V + ob + vt * 16 + 4 * fq); gg[vt] = *(const u32x2*)(G + ob + vt * 16 + 4 * fq); }
            const float bn = bonus[(size_t)t * 8 + h];
            if (!smp) {
                const bf16x8 Y0 = *(const bf16x8*)(QH + ob + fq * 8), Y1 = *(const bf16x8*)(QH + ob + 32 + fq * 8);
#pragma unroll
                for (int vt = 0; vt < 4; ++vt) { f32x4 acc = (f32x4){0.f, 0.f, 0.f, 0.f};
                    acc = __builtin_amdgcn_mfma_f32_16x16x32_bf16(X[vt][0], Y0, acc, 0, 0, 0); acc = __builtin_amdgcn_mfma_f32_16x16x32_bf16(X[vt][1], Y1, acc, 0, 0, 0);
                    y[vt][0] = acc[0] + lo16(yw[vt].x); y[vt][1] = acc[1] + hi16(yw[vt].x); y[vt][2] = acc[2] + lo16(yw[vt].y); y[vt][3] = acc[3] + hi16(yw[vt].y); }
            } else {
#pragma unroll
                for (int vt = 0; vt < 4; ++vt) { y[vt][0] = lo16(yw[vt].x); y[vt][1] = hi16(yw[vt].x); y[vt][2] = lo16(yw[vt].y); y[vt][3] = hi16(yw[vt].y); }
            }
            float sm = 0.f;
#pragma unroll
            for (int vt = 0; vt < 4; ++vt) sm += (y[vt][0] + y[vt][1]) + (y[vt][2] + y[vt][3]);
            sm += __shfl_xor(sm, 16); sm += __shfl_xor(sm, 32);
            const float mean = sm * (1.0f / 64.0f); float sq = 0.f;
#pragma unroll
            for (int vt = 0; vt < 4; ++vt)
#pragma unroll
                for (int e = 0; e < 4; ++e) { y[vt][e] -= mean; sq += y[vt][e] * y[vt][e]; }
            sq += __shfl_xor(sq, 16); sq += __shfl_xor(sq, 32);
            const float rs = rsqrtf(sq * (1.0f / 64.0f) + 64e-5f);
#pragma unroll
            for (int vt = 0; vt < 4; ++vt) {
                const float vv[4] = {lo16(vw[vt].x), hi16(vw[vt].x), lo16(vw[vt].y), hi16(vw[vt].y)}, g4[4] = {lo16(gg[vt].x), hi16(gg[vt].x), lo16(gg[vt].y), hi16(gg[vt].y)};
                float o[4];
#pragma unroll
                for (int e = 0; e < 4; ++e) o[e] = (y[vt][e] * rs * gw[vt][e] + gb[vt][e] + bn * vv[e]) * g4[e];
                *(u32x2*)(YA + ob + vt * 16 + 4 * fq) = pack4(o[0], o[1], o[2], o[3]);
            }
        }
    }
}
__device__ __forceinline__ float lb_of(const Ctx& p, int l, int c) { if (l == 0) return 0.f; const float* z = INP(p, 21); const float z0 = z[c], z1 = z[512 + c]; return __builtin_amdgcn_rcpf(1.0f + __expf(z0 - z1)); }
__device__ __forceinline__ void hgrn_scan(const bf16_t* __restrict__ PH, int t0, int nsteps, int h, int half, int kh, int lane, float lb, f2 (&S)[32], float& cp, bf16_t* __restrict__ OHp, float* __restrict__ ckp, LAS float* L) {
    const bf16_t* row = PH + (size_t)t0 * 2048 + h * 128 + kh * 64 + lane; const int voff = 1024 + (half - kh) * 64;
    unsigned short q1[3], q2[3], q3[3];
    { const bf16_t* r = row; q1[0] = r[0]; q1[1] = r[512]; q1[2] = r[voff];
      r = row + 2048; q2[0] = r[0]; q2[1] = r[512]; q2[2] = r[voff];
      r = row + 4096; q3[0] = r[0]; q3[1] = r[512]; q3[2] = r[voff]; }
    const LAS f32x4* pf = (const LAS f32x4*)L;
#pragma unroll 1
    for (int s = 0; s < nsteps; ++s) {
        const float ql = bf2f(q1[0]), fz = bf2f(q1[1]), v = bf2f(q1[2]);
#pragma unroll
        for (int j = 0; j < 3; ++j) { q1[j] = q2[j]; q2[j] = q3[j]; }
        { const bf16_t* r = row + (size_t)(s + 3 < nsteps ? s + 3 : nsteps - 1) * 2048; q3[0] = r[0]; q3[1] = r[512]; q3[2] = r[voff]; }
        const float fl = lb + (1.0f - lb) * sigm(fz);
        cp *= fl;
        if (ckp && (s & 31) == 31 && s < 127) ckp[(s >> 5) * 128 + lane] = cp;
        L[lane] = fl; L[64 + lane] = ql * sigm(ql);
        f32x4 F[2][4], Q[2][4];
#pragma unroll
        for (int i = 0; i < 4; ++i) { F[0][i] = pf[i]; Q[0][i] = pf[16 + i]; }
        const f2 v2 = {v, v}; f2 o2 = {0.f, 0.f}, o3 = {0.f, 0.f};
#pragma unroll
        for (int g = 0; g < 4; ++g) {
            if (g < 3) {
#pragma unroll
                for (int i = 0; i < 4; ++i) { F[(g + 1) & 1][i] = pf[(g + 1) * 4 + i]; Q[(g + 1) & 1][i] = pf[16 + (g + 1) * 4 + i]; } }
            __builtin_amdgcn_sched_barrier(0);
#pragma unroll
            for (int i = 0; i < 4; ++i) {
                const f32x4 f4 = F[g & 1][i], q4 = Q[g & 1][i]; const int idx = (g * 4 + i) * 2;
                const f2 f01 = {f4[0], f4[1]}, f23 = {f4[2], f4[3]}, q01 = {q4[0], q4[1]}, q23 = {q4[2], q4[3]};
                S[idx] = pfma(f01, S[idx] - v2, v2); o2 = pfma(S[idx], q01, o2);
                S[idx + 1] = pfma(f23, S[idx + 1] - v2, v2); o3 = pfma(S[idx + 1], q23, o3);
            }
        }
        OHp[(size_t)(t0 + s) * 512 + h * 128 + half * 64 + lane] = f2bf((o2[0] + o2[1]) + (o3[0] + o3[1]));
    }
}
constexpr size_t OFF_PGC = OFF_B + 3 * SLOT + 32 * MiB;
__device__ void phase_hgrn_scan(const Ctx& p, int l, LAS unsigned char* lds) {
    unsigned char* ws = uptr(p.ws);
    const bf16_t* PH = (const bf16_t*)(ws + OFF_A); bf16_t* OH0 = (bf16_t*)(ws + OFF_B + 2 * SLOT); bf16_t* OH1 = (bf16_t*)(ws + OFF_B + 5 * SLOT);
    float* UCH = (float*)(ws + OFF_B + 3 * SLOT); float* PGH = (float*)(ws + OFF_SM + SM_PGH); float* PGC = (float*)(ws + OFF_PGC);
    const int tid = tidx(); const int wave = __builtin_amdgcn_readfirstlane(tid >> 6), lane = tid & 63;
    LAS float* L = (LAS float*)(lds + wave * 1024);
    for (int item = bidx() * 8 + wave; item < 2048; item += gridDim.x * 8) {
        const int kh = item & 1, half = (item >> 1) & 1, h = (item >> 2) & 3, c = (item >> 4) & 63, b = item >> 10, idx = item >> 2;
        f2 S[32];
#pragma unroll
        for (int k = 0; k < 32; ++k) S[k] = (f2){0.f, 0.f};
        float cp = 1.f;
        hgrn_scan(PH, b * 8192 + c * 128, 128, h, half, kh, lane, lb_of(p, l, h * 128 + kh * 64 + lane), S, cp, kh ? OH1 : OH0, half == 0 ? PGC + (size_t)idx * 384 + kh * 64 : nullptr, L);
        float* up = UCH + (size_t)idx * 16384 + (size_t)(kh * 64) * 128 + half * 64 + lane;
#pragma unroll
        for (int k = 0; k < 32; ++k) { up[(2 * k) * 128] = S[k][0]; up[(2 * k + 1) * 128] = S[k][1]; }
        if (half == 0) PGH[idx * 128 + kh * 64 + lane] = cp;
    }
    if (wave < 2) {
        for (int item = bidx() * 2 + wave; item < 512; item += gridDim.x * 2) {
            const int kh = item & 1, half = (item >> 1) & 1, h = (item >> 2) & 3, s = item >> 4;
            const size_t so = (((size_t)l * 32 + s) * 4 + h) * 16384 + (size_t)(kh * 64) * 128 + half * 64 + lane;
            f2 S[32];
            const float* stp = INP(p, 4) + so;
#pragma unroll
            for (int k = 0; k < 32; ++k) S[k] = (f2){stp[(2 * k) * 128], stp[(2 * k + 1) * 128]};
            float cp = 1.f;
            hgrn_scan(PH, T_P + s * 32, 32, h, half, kh, lane, lb_of(p, l, h * 128 + kh * 64 + lane), S, cp, kh ? OH1 : OH0, nullptr, L);
#pragma unroll
            for (int k = 0; k < 32; ++k) { p.out[O_HGS + so + (2 * k) * 128] = S[k][0]; p.out[O_HGS + so + (2 * k + 1) * 128] = S[k][1]; }
        }
    }
}
__device__ void phase_hgrn_chain(const Ctx& p, int l) {
    unsigned char* ws = uptr(p.ws);
    float* UCH = (float*)(ws + OFF_B + 3 * SLOT); const float* PGH = (const float*)(ws + OFF_SM + SM_PGH);
    for (int gid = bidx() * 512 + tidx(); gid < 131072; gid += gridDim.x * 512) {
        const int b = gid >> 16, h = (gid >> 14) & 3, k = (gid >> 7) & 127, v = gid & 127;
        float s = 0.f;
        for (int c0 = 0; c0 < 64; c0 += 8) {
            float u[8], pg[8];
#pragma unroll
            for (int j = 0; j < 8; ++j) { const size_t idx = (size_t)(b * 64 + c0 + j) * 4 + h; u[j] = UCH[idx * 16384 + k * 128 + v]; pg[j] = PGH[idx * 128 + k]; }
#pragma unroll
            for (int j = 0; j < 8; ++j) { const size_t idx = (size_t)(b * 64 + c0 + j) * 4 + h; UCH[idx * 16384 + k * 128 + v] = s; s = fmaf(pg[j], s, u[j]); }
        }
        p.out[O_HGP + (((size_t)l * 2 + b) * 4 + h) * 16384 + k * 128 + v] = s;
    }
}
__device__ void phase_hgrn_fix(const Ctx& p, int l, LAS unsigned char* lds) {
    unsigned char* ws = uptr(p.ws);
    const bf16_t* PH = (const bf16_t*)(ws + OFF_A); const bf16_t* OH = (const bf16_t*)(ws + OFF_B + 2 * SLOT); const float* UCH = (const float*)(ws + OFF_B + 3 * SLOT);
    const float* PGC = (const float*)(ws + OFF_PGC); const bf16_t* OH1 = (const bf16_t*)(ws + OFF_B + 5 * SLOT);
    bf16_t* YB = (bf16_t*)(ws + OFF_B + SLOT);
    const int tid = tidx(); const int wave = __builtin_amdgcn_readfirstlane(tid >> 6), lane = tid & 63, fr = lane & 15, fq = lane >> 4;
    const float* nw = INP(p, 22) + l * 512;
    constexpr int QS = 136;
    LAS bf16_t* QT = (LAS bf16_t*)(lds + wave * 16384);
    for (int item = bidx() * 8 + wave; item < 2048; item += gridDim.x * 8) {
        const int tq = item & 3, idx = item >> 2, h = idx & 3, c = (idx >> 2) & 63, b = idx >> 8;
        const float lbl = lb_of(p, l, h * 128 + lane), lbh = lb_of(p, l, h * 128 + 64 + lane);
        const int tbase = b * 8192 + c * 128 + tq * 32;
        float rl = 1.f, rh = 1.f;
        if (tq) { rl = PGC[(size_t)idx * 384 + (tq - 1) * 128 + lane]; rh = PGC[(size_t)idx * 384 + (tq - 1) * 128 + 64 + lane]; }
        const bf16_t* row = PH + (size_t)tbase * 2048 + h * 128 + lane;
#pragma unroll 1
        for (int t8 = 0; t8 < 32; t8 += 8) {
            unsigned short rq[8][4];
#pragma unroll
            for (int j = 0; j < 8; ++j) { const bf16_t* r = row + (size_t)(t8 + j) * 2048; rq[j][0] = r[0]; rq[j][1] = r[64]; rq[j][2] = r[512]; rq[j][3] = r[576]; }
#pragma unroll
            for (int j = 0; j < 8; ++j) {
                const float ql = bf2f(rq[j][0]), qh = bf2f(rq[j][1]);
                rl *= lbl + (1.0f - lbl) * sigm(bf2f(rq[j][2])); rh *= lbh + (1.0f - lbh) * sigm(bf2f(rq[j][3]));
                QT[(t8 + j) * QS + lane] = f2bf(ql * sigm(ql) * rl); QT[(t8 + j) * QS + 64 + lane] = f2bf(qh * sigm(qh) * rh);
            }
        }
        f32x4 acc[8][2];
        const float* sb = UCH + (size_t)idx * 16384 + fr;
#pragma unroll
        for (int vt = 0; vt < 8; ++vt) {
            acc[vt][0] = (f32x4){0.f, 0.f, 0.f, 0.f}; acc[vt][1] = (f32x4){0.f, 0.f, 0.f, 0.f};
#pragma unroll
            for (int ks = 0; ks < 4; ++ks) {
                const float* sp = sb + (size_t)(ks * 32 + fq * 8) * 128 + vt * 16;
                u32x4 w; w.x = cvt_pk_bf16(sp[0], sp[128]); w.y = cvt_pk_bf16(sp[256], sp[384]); w.z = cvt_pk_bf16(sp[512], sp[640]); w.w = cvt_pk_bf16(sp[768], sp[896]);
                const bf16x8 X = __builtin_bit_cast(bf16x8, w);
                acc[vt][0] = __builtin_amdgcn_mfma_f32_16x16x32_bf16(X, *(const LAS bf16x8*)(QT + fr * QS + ks * 32 + fq * 8), acc[vt][0], 0, 0, 0);
                acc[vt][1] = __builtin_amdgcn_mfma_f32_16x16x32_bf16(X, *(const LAS bf16x8*)(QT + (16 + fr) * QS + ks * 32 + fq * 8), acc[vt][1], 0, 0, 0);
            }
        }
#pragma unroll
        for (int tt = 0; tt < 2; ++tt) {
            const int t = tbase + tt * 16 + fr;
            const bf16_t* op = OH + (size_t)t * 512 + h * 128 + 4 * fq; const bf16_t* op1 = OH1 + (size_t)t * 512 + h * 128 + 4 * fq; const bf16_t* gp = PH + (size_t)t * 2048 + 1536 + h * 128 + 4 * fq;
            float o[8][4]; float ss = 0.f;
#pragma unroll
            for (int vt = 0; vt < 8; ++vt) { const u32x2 ow = *(const u32x2*)(op + vt * 16), ox = *(const u32x2*)(op1 + vt * 16);
                o[vt][0] = acc[vt][tt][0] + (lo16(ow.x) + lo16(ox.x)); o[vt][1] = acc[vt][tt][1] + (hi16(ow.x) + hi16(ox.x)); o[vt][2] = acc[vt][tt][2] + (lo16(ow.y) + lo16(ox.y)); o[vt][3] = acc[vt][tt][3] + (hi16(ow.y) + hi16(ox.y));
                ss += (o[vt][0] * o[vt][0] + o[vt][1] * o[vt][1]) + (o[vt][2] * o[vt][2] + o[vt][3] * o[vt][3]); }
            ss += __shfl_xor(ss, 16); ss += __shfl_xor(ss, 32);
            const float rs = rsqrtf(ss * (1.0f / 128.0f) + 1e-6f);
#pragma unroll
            for (int vt = 0; vt < 8; ++vt) { const u32x2 gw = *(const u32x2*)(gp + vt * 16); const float4 n4 = *(const float4*)(nw + h * 128 + vt * 16 + 4 * fq);
                const float g4[4] = {lo16(gw.x), hi16(gw.x), lo16(gw.y), hi16(gw.y)}, nn[4] = {n4.x, n4.y, n4.z, n4.w}; float r[4];
#pragma unroll
                for (int e = 0; e < 4; ++e) r[e] = o[vt][e] * rs * nn[e] * g4[e] * sigm(g4[e]);
                *(u32x2*)(YB + (size_t)t * 512 + h * 128 + vt * 16 + 4 * fq) = pack4(r[0], r[1], r[2], r[3]); }
        }
    }
    if (wave == 0) {
        for (int item = bidx(); item < 128; item += gridDim.x) {
            const int s = item >> 2, h = item & 3;
            const float nw0 = nw[h * 128 + lane], nw1 = nw[h * 128 + 64 + lane];
#pragma unroll 4
            for (int tt = 0; tt < 32; ++tt) {
                const int t = T_P + s * 32 + tt;
                const float o0 = bf2f(OH[(size_t)t * 512 + h * 128 + lane]) + bf2f(OH1[(size_t)t * 512 + h * 128 + lane]), o1 = bf2f(OH[(size_t)t * 512 + h * 128 + 64 + lane]) + bf2f(OH1[(size_t)t * 512 + h * 128 + 64 + lane]);
                const float g0 = bf2f(PH[(size_t)t * 2048 + 1536 + h * 128 + lane]), g1 = bf2f(PH[(size_t)t * 2048 + 1536 + h * 128 + 64 + lane]);
                const float rs = rsqrtf(wsum_fast(o0 * o0 + o1 * o1) * (1.0f / 128.0f) + 1e-6f);
                YB[(size_t)t * 512 + h * 128 + lane] = f2bf(o0 * rs * nw0 * g0 * sigm(g0));
                YB[(size_t)t * 512 + h * 128 + 64 + lane] = f2bf(o1 * rs * nw1 * g1 * sigm(g1));
            }
        }
    }
}
__device__ void phase_final(const Ctx& p) {
    const int tid = tidx(); const int wave = __builtin_amdgcn_readfirstlane(tid >> 6), lane = tid & 63;
    const float* nf = INP(p, 29); const float* PART = (const float*)(uptr(p.ws) + OFF_PART);
    for (int row = bidx() * 8 + wave; row < T_ALL; row += gridDim.x * 8) {
        float* xp = p.out + (size_t)row * 1024; float4 v[4]; float ss = 0.f;
#pragma unroll
        for (int i = 0; i < 4; ++i) { v[i] = *(const float4*)(xp + i * 256 + lane * 4);
            if (row >= T_P) { const float* pr = PART + (size_t)(row - T_P) * 1024 + i * 256 + lane * 4;
#pragma unroll
                for (int sl = 0; sl < 8; ++sl) { const float4 q = *(const float4*)(pr + (size_t)sl * 1024 * 1024); v[i].x += q.x; v[i].y += q.y; v[i].z += q.z; v[i].w += q.w; } }
            ss += v[i].x * v[i].x + v[i].y * v[i].y + v[i].z * v[i].z + v[i].w * v[i].w; }
        const float s = rsqrtf(wsum(ss) * (1.0f / 1024.0f) + 1e-6f);
#pragma unroll
        for (int i = 0; i < 4; ++i) { const int c = i * 256 + lane * 4; const float4 w = *(const float4*)(nf + c);
            v[i].x *= s * w.x; v[i].y *= s * w.y; v[i].z *= s * w.z; v[i].w *= s * w.w; *(float4*)(xp + c) = v[i]; }
    }
}
#define VRES 1
#define GEMM_PRO unsigned char* ws = uptr(p.ws); float* rowss = (float*)(ws + OFF_SM + SM_ROWSS); bf16_t* XB = (bf16_t*)(ws + OFF_XB); \
    const float* rs_mix = rowss + (size_t)(2 * l) * T_ALL; float* rs_ffn = rowss + (size_t)(2 * l + 1) * T_ALL; float* rs_next = rowss + (size_t)(2 * l + 2) * T_ALL; (void)rs_mix; (void)rs_ffn; (void)rs_next; (void)XB
__global__ void __launch_bounds__(512, 2) mega_fwd(Params prm) {
    extern __shared__ __attribute__((aligned(16))) unsigned char lds_raw[];
    LAS unsigned char* lds = (LAS unsigned char*)lds_raw;
    cg::grid_group grid = cg::this_grid();
    Ctx p; p.ws = prm.ws; p.out = prm.out;
    { unsigned long long* tb = (unsigned long long*)(prm.ws + OFF_SM + SM_TBL + (size_t)blockIdx.x * 256);
      if (threadIdx.x == 0) {
#define TB(i) tb[i] = (unsigned long long)prm.in[i];
          TB(0) TB(1) TB(2) TB(3) TB(4) TB(5) TB(6) TB(7) TB(8) TB(9) TB(10) TB(11) TB(12) TB(13) TB(14) TB(15) TB(16) TB(17) TB(18) TB(19) TB(20) TB(21) TB(22) TB(23) TB(24) TB(25) TB(26) TB(27) TB(28) TB(29)
#undef TB
      }
      __threadfence_block(); __syncthreads();
      p.tbl = tb; }
    volatile LAS unsigned* xst = (volatile LAS unsigned*)(lds + 131072);
    if (threadIdx.x < 2) xst[threadIdx.x] = 0u;
    __syncthreads();
    XcdBarrier xb = xcd_barrier_post((unsigned*)(prm.ws + OFF_SM + SM_BAR), xst);
    grid.sync();
    phase_x0(p);
#pragma unroll 1
    for (int ph = 0; ph < 28; ++ph) {
        const int l = ph >= 14 ? 1 : 0, k = ph - 14 * l;
        switch (k) {
        case 0: if (l == 1) { GEMM_PRO; finalize_sample(p, rowss + (size_t)2 * T_ALL); } else phase_convert_early(p, 0, lds, bidx(), (int)gridDim.x); break;
        case 1: { GEMM_PRO; EpiBf<0> E; E.O = (bf16_t*)(ws + OFF_A); E.ldc = 2048; E.rowss = rs_mix; run_gemm(lds, XB, (const bf16_t*)(ws + OFF_WRW), 2048, 1024, E);
                  { const int b = bidx(); phase_convert_hg(p, l, lds, b >= 32 ? b - 32 : -1, (int)gridDim.x - 32); } } break;
        case 2: phase_prep(p, l, lds); break;
        case 3: phase_rwkv_scan(p, l, lds); break;
        case 4: phase_rwkv_chain(p, l); break;
        case 5: phase_rwkv_fix(p, l); break;
        case 6: { GEMM_PRO; EpiBf<0> E; E.O = (bf16_t*)(ws + OFF_A); E.ldc = 2048; E.rowss = rs_mix; run_gemm(lds, XB, (const bf16_t*)(ws + OFF_WHG), 2048, 1024, E);
                  { const int b = bidx(); phase_convert_late(p, l, lds, b >= 32 ? b - 32 : -1, (int)gridDim.x - 32); } } break;
        case 7: phase_hgrn_scan(p, l, lds); break;
        case 8: phase_hgrn_chain(p, l); break;
        case 9: phase_hgrn_fix(p, l, lds); break;
        case 10: {
            GEMM_PRO; bf16_t* TA = (bf16_t*)(ws + OFF_A); bf16_t* TB = (bf16_t*)(ws + OFF_A + 34 * MiB);
            { EpiBf<2> E; E.O = TA; E.ldc = 1024; E.rowss = nullptr; run_gemm(lds, (const bf16_t*)(ws + OFF_B), (const bf16_t*)(ws + OFF_WOA), 1024, 512, E, T_P); }
            { EpiGate<0> E; E.M = TA; E.Tm = TA; E.rowss = rs_mix; run_gemm(lds, XB, (const bf16_t*)(ws + OFF_WGA), 1024, 1024, E, T_P); }
            { EpiBf<2> E; E.O = TB; E.ldc = 1024; E.rowss = nullptr; run_gemm(lds, (const bf16_t*)(ws + OFF_B + SLOT), (const bf16_t*)(ws + OFF_WOB), 1024, 512, E, T_P); }
            { EpiGate<1> E; E.M = TA; E.Tm = TB; E.rowss = rs_mix; run_gemm(lds, XB, (const bf16_t*)(ws + OFF_WGB), 1024, 1024, E, T_P); }
            run_gate_sample_tasks(lds, ws);
            xcd_barrier(xb);
            gate_combine(ws, rs_mix);
        } break;
        case 11: { GEMM_PRO; EpiResid E; E.X = p.out; E.XB = XB; E.rowss_out = rs_ffn; E.Xp0 = l == 0 ? INP(p, 0) : nullptr; E.Xs0 = l == 0 ? INP(p, 1) : nullptr; run_gemm(lds, (const bf16_t*)(ws + OFF_A), (const bf16_t*)(ws + OFF_WO), 1024, 1024, E);
                   if (l == 0) { const int b = bidx(); phase_convert_early(p, 1, lds, b >= 16 ? b - 16 : -1, (int)gridDim.x - 16); } } break;
        case 12: { GEMM_PRO; EpiBf<1> E; E.O = (bf16_t*)(ws + OFF_A); E.ldc = 4096; E.rowss = rs_ffn; run_gemm(lds, XB, (const bf16_t*)(ws + OFF_WUP), 4096, 1024, E); } break;
        default: { GEMM_PRO; EpiResid E; E.X = p.out; E.XB = XB; E.rowss_out = rs_next; E.Xp0 = nullptr; E.Xs0 = nullptr; run_ffn_down(lds, (const bf16_t*)(ws + OFF_A), (const bf16_t*)(ws + OFF_WDN), E, (float*)(ws + OFF_PART)); } break;
        }
        xcd_barrier(xb);
    }
    phase_final(p);
}

extern "C" void kernel_launch(void* const* d_in, const int* in_sizes, int n_in, void* d_out, int out_size, void* d_ws, size_t ws_size, hipStream_t stream) {
    constexpr int LDS_BYTES = 131072 + 64;
    static int grid_blocks = 0;
    if (grid_blocks == 0) {
        int dev = 0, cus = 0, per_cu = 0;
        hipGetDevice(&dev);
        hipDeviceGetAttribute(&cus, hipDeviceAttributeMultiprocessorCount, dev);
        hipFuncSetAttribute((const void*)mega_fwd, hipFuncAttributeMaxDynamicSharedMemorySize, LDS_BYTES);
        hipOccupancyMaxActiveBlocksPerMultiprocessor(&per_cu, (const void*)mega_fwd, 512, LDS_BYTES);
        if (per_cu < 1) per_cu = 1;
        grid_blocks = cus;
        if (n_in != 30 || ws_size < WS_NEED) { fprintf(stderr, "kernel_launch: unexpected n_in %d / ws_size %zu\n", n_in, ws_size); }
    }
    if (hipMemsetAsync((unsigned char*)d_ws + OFF_SM + SM_BAR, 0, XCD_BAR_WORDS * 4, stream) != hipSuccess) fprintf(stderr, "memset failed\n");
    Params p{};
    for (int i = 0; i < 30; ++i) p.in[i] = (const float*)d_in[i];
    p.out = (float*)d_out; p.ws = (unsigned char*)d_ws;
    void* args[] = {&p};
    hipError_t e = hipLaunchCooperativeKernel((const void*)mega_fwd, dim3(grid_blocks), dim3(512), args, LDS_BYTES, stream);
    if (e != hipSuccess) fprintf(stderr, "cooperative launch failed: %s (grid %d)\n", hipGetErrorString(e), grid_blocks);
}
```

```cpp
#include <hip/hip_runtime.h>
#include <hip/hip_cooperative_groups.h>
#include <cstdio>
namespace cg = cooperative_groups;
#define VRES 1
namespace pg8 {
#define PG8_LAS __attribute__((address_space(3)))
typedef unsigned short bf16_t;
typedef short bf16x8 __attribute__((ext_vector_type(8)));
typedef float f32x4 __attribute__((ext_vector_type(4)));
typedef unsigned u32x4 __attribute__((ext_vector_type(4)));
constexpr int BM = 256, BK = 64, HALF = 128, HTB = HALF * BK * 2  , STAGE_BYTES = 8 * HTB, NXCD = 8, WGM = 8;

__host__ __device__ __forceinline__ int lds_byte(int r, int c) { const int st = (r >> 4) * 2 + (c >> 5), rr = r & 15, cc = c & 31, ob = rr * 64 + cc * 2; return st * 1024 + (ob ^ (((ob >> 9) & 1) << 5)); }
__host__ __device__ __forceinline__ void stage_rc(int b, int& R, int& C) { const int st = b / 1024, sb = b % 1024, swz = sb ^ (((sb >> 9) & 1) << 5); R = (st >> 1) * 16 + swz / 64; C = (st & 1) * 32 + (swz % 64) / 2; }
__host__ __device__ __forceinline__ int perm32(int rho) { const int n = rho >> 4, i = rho & 15; return 8 * (i >> 2) + 4 * n + (i & 3); }

struct Unit { int pm, pn; };
struct Gemm { const bf16_t* A; const bf16_t* Bt; int M, N, K, ld; };

struct StaticOrder {
    int nM, nN, nwg, G, c;
    __host__ __device__ void init(int M, int N, int G_, int c_) { nM = M / BM; nN = N / BM; nwg = nM * nN; G = G_; c = c_; }
    __host__ __device__ bool next(int i, Unit& u) const {
        const long L = (long)i * G + c; if (L >= nwg) return false;
        int wgid = (int)L; { const int q = nwg / NXCD, r = nwg % NXCD, xcd = wgid % NXCD, off = wgid / NXCD; wgid = (xcd < r ? xcd * (q + 1) : r * (q + 1) + (xcd - r) * q) + off; }
        const int nig = WGM * nN, gid = wgid / nig, fm = gid * WGM, gsz = (nM - fm) < WGM ? (nM - fm) : WGM;
        u.pm = fm + ((wgid % nig) % gsz); u.pn = (wgid % nig) / gsz; return true;
    }
    __device__ __forceinline__ void a_ready(const Unit&) const {}
    __device__ __forceinline__ void done(const Unit&) const {}
};
typedef float f32x2_cv __attribute__((ext_vector_type(2)));
typedef __bf16 bf16x2_cv __attribute__((ext_vector_type(2)));
__device__ __forceinline__ unsigned cvt_pk_bf16(float lo, float hi) { const f32x2_cv v = {lo, hi}; const bf16x2_cv b = __builtin_convertvector(v, bf16x2_cv); return __builtin_bit_cast(unsigned, b); }
template <class Epi, class Sched, bool STAMP = false>
__device__ __forceinline__ void gemm_phase(PG8_LAS unsigned char* lds, const Gemm g, const Sched& S, const Epi& E, unsigned long long* stamps) {
    int tid_ = threadIdx.x; asm volatile("" : "+v"(tid_)); const int tid = tid_, wid = __builtin_amdgcn_readfirstlane(tid >> 6), lane = tid & 63, wr = wid >> 2, wc = wid & 3, fr = lane & 15, fq = lane >> 4;
    const int K = g.K, nt = K / BK, LD = g.ld;
    unsigned voffA[2], voffB[2];
#pragma unroll
    for (int i = 0; i < 2; ++i) { int R, C; stage_rc(tid * 16 + i * 8192, R, C); const int Rb = Epi::PERM ? ((R & ~31) + perm32(R & 31)) : R;
        voffA[i] = (unsigned)(R * LD + C) * 2u; voffB[i] = (unsigned)(Rb * LD + C) * 2u; }
    const size_t kstep = (size_t)(BK * 2);
    const size_t hstep = (size_t)HALF * LD * 2;
    const size_t tstep = 2 * hstep;
    const unsigned ldsw = (unsigned)wid * 1024u;
    const int aoff = lds_byte(wr * 64 + fr, fq * 8), boff = lds_byte(wc * 32 + fr, fq * 8);
#define PG8_SA(b, h) (((b) * 2 + (h)) * HTB)
#define PG8_SB(b, h) ((4 + (b) * 2 + (h)) * HTB)
#define PG8_STAGE(bufoff, gbase, voff) do { _Pragma("unroll") for (int _i = 0; _i < 2; ++_i) \
        __builtin_amdgcn_global_load_lds((const unsigned*)((const char*)(gbase) + (voff)[_i]), (PG8_LAS unsigned*)(lds + (bufoff) + ldsw + _i * 8192), 16, 0, 0); } while (0)
#define PG8_LDA(dst, b, h) do { _Pragma("unroll") for (int m = 0; m < 4; ++m) _Pragma("unroll") for (int k = 0; k < 2; ++k) dst[m][k] = *(const PG8_LAS bf16x8*)(lds + PG8_SA(b, h) + aoff + m * 2048 + k * 1024); } while (0)
#define PG8_LDB(dst, b, h) do { _Pragma("unroll") for (int n = 0; n < 2; ++n) _Pragma("unroll") for (int k = 0; k < 2; ++k) dst[n][k] = *(const PG8_LAS bf16x8*)(lds + PG8_SB(b, h) + boff + n * 2048 + k * 1024); } while (0)
#define PG8_MMA(ai, bj, At, Bt) do { __builtin_amdgcn_s_setprio(1); _Pragma("unroll") for (int m = 0; m < 4; ++m) _Pragma("unroll") for (int n = 0; n < 2; ++n) _Pragma("unroll") for (int k = 0; k < 2; ++k) \
        acc[ai][bj][m][n] = __builtin_amdgcn_mfma_f32_16x16x32_bf16(Bt[n][k], At[m][k], acc[ai][bj][m][n], 0, 0, 0); __builtin_amdgcn_s_setprio(0); } while (0)
#define PG8_WAIT_V(n) asm volatile("s_waitcnt vmcnt(" #n ")" ::: "memory")
#define PG8_WAIT_L(n) asm volatile("s_waitcnt lgkmcnt(" #n ")" ::: "memory")
#define PG8_BAR __builtin_amdgcn_s_barrier()
#define PG8_SCHED __builtin_amdgcn_sched_barrier(0)
    Unit cur, nxt; int ui = 0;
    if (!S.next(0, cur)) return;
    f32x4 acc[2][2][4][2];
#pragma unroll
    for (int a = 0; a < 2; ++a)
#pragma unroll
        for (int b = 0; b < 2; ++b)
#pragma unroll
            for (int m = 0; m < 4; ++m)
#pragma unroll
                for (int n = 0; n < 2; ++n) acc[a][b][m][n] = (f32x4){0.f, 0.f, 0.f, 0.f};
    bf16x8 At[4][2], B0[2][2], B1[2][2];
    const char* cA = (const char*)g.A + (size_t)cur.pm * tstep; const char* cB = (const char*)g.Bt + (size_t)cur.pn * tstep;
    S.a_ready(cur);
    PG8_STAGE(PG8_SB(0, 0), cB, voffB); PG8_STAGE(PG8_SA(0, 0), cA, voffA); PG8_STAGE(PG8_SB(0, 1), cB + hstep, voffB); PG8_STAGE(PG8_SA(0, 1), cA + hstep, voffA);
    if (wr == 1) PG8_BAR;
    PG8_WAIT_V(4); PG8_BAR;
    PG8_STAGE(PG8_SB(1, 0), cB + kstep, voffB); PG8_STAGE(PG8_SA(1, 0), cA + kstep, voffA); PG8_STAGE(PG8_SB(1, 1), cB + hstep + kstep, voffB);
    PG8_WAIT_V(6); PG8_BAR;
    for (;;) {
        const bool has_next = S.next(ui + 1, nxt);
        const char* nA = has_next ? (const char*)g.A + (size_t)nxt.pm * tstep : cA; const char* nB = has_next ? (const char*)g.Bt + (size_t)nxt.pn * tstep : cB;
        for (int t = 0; t < nt; t += 2) {
            const bool last = (t == nt - 2);
            const char* a1 = cA + (size_t)(t + 1) * kstep;
            const char* a2 = last ? nA : cA + (size_t)(t + 2) * kstep; const char* b2 = last ? nB : cB + (size_t)(t + 2) * kstep;
            const char* a3 = a2 + kstep; const char* b3 = b2 + kstep;
            if (last && has_next) S.a_ready(nxt);
            PG8_LDB(B0, 0, 0); PG8_SCHED; PG8_LDA(At, 0, 0); PG8_STAGE(PG8_SA(1, 1), a1 + hstep, voffA);
            PG8_WAIT_L(8); PG8_BAR; PG8_WAIT_L(0); PG8_MMA(0, 0, At, B0); PG8_BAR; PG8_SCHED;
            PG8_LDB(B1, 0, 1); PG8_STAGE(PG8_SB(0, 0), b2, voffB);
            PG8_BAR; PG8_WAIT_L(0); PG8_MMA(0, 1, At, B1); PG8_BAR;
            PG8_LDA(At, 0, 1); PG8_STAGE(PG8_SA(0, 0), a2, voffA);
            PG8_BAR; PG8_WAIT_L(0); PG8_MMA(1, 0, At, B0); PG8_BAR; PG8_SCHED;
            PG8_STAGE(PG8_SB(0, 1), b2 + hstep, voffB);
            PG8_WAIT_V(6); PG8_BAR; PG8_MMA(1, 1, At, B1); PG8_BAR;
            PG8_LDB(B0, 1, 0); PG8_SCHED; PG8_LDA(At, 1, 0); PG8_STAGE(PG8_SA(0, 1), a2 + hstep, voffA);
            PG8_WAIT_L(8); PG8_BAR; PG8_WAIT_L(0); PG8_MMA(0, 0, At, B0); PG8_BAR; PG8_SCHED;
            PG8_LDB(B1, 1, 1); PG8_STAGE(PG8_SB(1, 0), b3, voffB);
            PG8_BAR; PG8_WAIT_L(0); PG8_MMA(0, 1, At, B1); PG8_BAR;
            PG8_LDA(At, 1, 1); PG8_STAGE(PG8_SA(1, 0), a3, voffA);
            PG8_BAR; PG8_WAIT_L(0); PG8_MMA(1, 0, At, B0); PG8_BAR; PG8_SCHED;
            PG8_STAGE(PG8_SB(1, 1), b3 + hstep, voffB);
            PG8_WAIT_V(6); PG8_BAR; PG8_MMA(1, 1, At, B1); PG8_BAR;
        }
        if constexpr (!Epi::AFTER_DRAIN) { E(acc, cur, wr, wc, fr, fq); S.done(cur); }
        if (!has_next) break;
#pragma unroll
        for (int a = 0; a < 2; ++a)
#pragma unroll
            for (int b = 0; b < 2; ++b)
#pragma unroll
                for (int m = 0; m < 4; ++m)
#pragma unroll
                    for (int n = 0; n < 2; ++n) acc[a][b][m][n] = (f32x4){0.f, 0.f, 0.f, 0.f};
        cur = nxt; cA = nA; cB = nB; ++ui;
    }
    PG8_WAIT_V(0);
    if (wr == 0) PG8_BAR;
    PG8_BAR;
    if constexpr (Epi::AFTER_DRAIN) { E.fused(acc, cur, wr, wc, fr, fq, lds, wid, lane); S.done(cur); }
#undef PG8_SA
#undef PG8_SB
#undef PG8_STAGE
#undef PG8_LDA
#undef PG8_LDB
#undef PG8_MMA
#undef PG8_WAIT_V
#undef PG8_WAIT_L
#undef PG8_BAR
#undef PG8_SCHED
}
}
using pg8::bf16_t; using pg8::bf16x8; using pg8::f32x4; using pg8::u32x4; using pg8::cvt_pk_bf16;
typedef unsigned u32x2 __attribute__((ext_vector_type(2)));
#define LAS PG8_LAS

constexpr int T_ALL = 17408, T_P = 16384;
constexpr size_t MiB = (size_t)1 << 20;
constexpr size_t OFF_WRW = 0, OFF_WHG = 4 * MiB, OFF_WGA = 8 * MiB, OFF_WGB = 10 * MiB, OFF_WOA = 12 * MiB, OFF_WOB = 13 * MiB, OFF_WO = 14 * MiB, OFF_WUP = 16 * MiB, OFF_WDN = 24 * MiB;
constexpr size_t OFF_G = 8 * MiB;
constexpr size_t OFF_SM = 32 * MiB;
constexpr size_t SM_W2T = 0, SM_A2T = 65536, SM_G2T = 131072, SM_V1T = 294912, SM_V2T = 327680, SM_ROWSS = 393216, SM_BONUS = 786432, SM_PGH = 1376256;
constexpr size_t OFF_XB = 34 * MiB, OFF_V0 = 68 * MiB, OFF_A = 85 * MiB, OFF_B = 153 * MiB, SLOT = 17 * MiB;
constexpr size_t WS_NEED = 255 * MiB;
constexpr size_t O_SHP = 17825792, O_RWP = 17833088, O_HGP = 17964160, O_SHS = 18226304, O_RWS = 18343040, O_HGS = 20440192;

__device__ __forceinline__ int tidx() { int t = threadIdx.x; asm volatile("" : "+v"(t)); return t; }
__device__ __forceinline__ int bidx() { int b = blockIdx.x; asm volatile("" : "+s"(b)); return b; }
#define GAS __attribute__((address_space(1)))
__device__ __forceinline__ unsigned char* uptr(unsigned char* q) {
    const unsigned long long v = (unsigned long long)q; unsigned lo = __builtin_amdgcn_readfirstlane((unsigned)v), hi = __builtin_amdgcn_readfirstlane((unsigned)(v >> 32));
    asm volatile("" : "+s"(lo), "+s"(hi));
    return (unsigned char*)(GAS unsigned char*)(((unsigned long long)hi << 32) | lo); }
struct Params { const float* in[30]; float* out; unsigned char* ws; };
struct Ctx { unsigned char* ws; float* out; const unsigned long long* tbl; };
__device__ __forceinline__ const float* ldp(const unsigned long long* tbl, int i) {
    const unsigned long long v = *(const volatile unsigned long long*)(tbl + i);
    const unsigned lo = __builtin_amdgcn_readfirstlane((unsigned)v), hi = __builtin_amdgcn_readfirstlane((unsigned)(v >> 32));
    return (const float*)(GAS const float*)(((unsigned long long)hi << 32) | lo); }
#define INP(p, i) ldp((p).tbl, i)
constexpr size_t SM_TBL = 1703936, SM_BAR = 1769472;
#define XB_TMO      128
#define XB_XCNT(j)  (256  + 64 * (j))
#define XB_XSUB(j)  (1280 + 64 * (j))
#define XB_XGEN(j)  (2304 + 64 * (j))
#define XB_TOP      3328
#define XB_TOPGEN   3392
#define XCD_BAR_WORDS 3456
#define XB_SPIN_CAP (1u << 18)

__device__ __forceinline__ unsigned xb_ld(unsigned* p)              { return __hip_atomic_load(p, __ATOMIC_RELAXED, __HIP_MEMORY_SCOPE_AGENT); }
__device__ __forceinline__ unsigned xb_add(unsigned* p, unsigned v) { return __hip_atomic_fetch_add(p, v, __ATOMIC_RELAXED, __HIP_MEMORY_SCOPE_AGENT); }
__device__ __forceinline__ unsigned xb_xcc_id() { return (unsigned)__builtin_amdgcn_s_getreg((3 << 11) | 20) & 0xFu; }
#define XB_SPIN(cond, bar) do { unsigned _sp = 0; while (cond) { __builtin_amdgcn_s_sleep(1); \
    if ((++_sp & 255u) == 0u) { if (xb_ld(&(bar)[XB_TMO])) break; if (_sp > XB_SPIN_CAP) { atomicAdd(&(bar)[XB_TMO], 1u); break; } } } } while (0)

struct XcdBarrier {
    unsigned* bar; unsigned x;
    volatile LAS unsigned* st;
};

__device__ __forceinline__ XcdBarrier xcd_barrier_post(unsigned* bar, volatile LAS unsigned* st) {
    XcdBarrier b; b.bar = bar; b.x = xb_xcc_id(); b.st = st;
    if (threadIdx.x == 0) (void)xb_add(&bar[XB_XCNT(b.x)], 1u);
    return b;
}
__device__ __forceinline__ void xcd_barrier_complete(unsigned* bar, unsigned x, unsigned& nloc, unsigned& nx) {
    const unsigned G = gridDim.x * gridDim.y * gridDim.z;
    unsigned sum, cnt, mine, sp = 0u;
    for (;;) {
        sum = 0u; cnt = 0u; mine = 0u;
#pragma unroll
        for (unsigned j = 0; j < 16; ++j) { const unsigned c = xb_ld(&bar[XB_XCNT(j)]); sum += c; cnt += (c > 0u) ? 1u : 0u; mine = (j == x) ? c : mine; }
        if (sum == G) break;
        __builtin_amdgcn_s_sleep(1);
        if ((++sp & 255u) == 0u) { if (xb_ld(&bar[XB_TMO])) break; if (sp > XB_SPIN_CAP) { atomicAdd(&bar[XB_TMO], 1u); break; } }
    }
    nloc = mine > 0u ? mine : 1u; nx = cnt > 0u ? cnt : 1u;
}

__device__ __forceinline__ void xcd_barrier(const XcdBarrier& b) {
    asm volatile("s_waitcnt vmcnt(0)" ::: "memory");
    __syncthreads();
    if (threadIdx.x == 0) {
        unsigned* bar = b.bar;
        __builtin_amdgcn_s_waitcnt(0);
        unsigned nloc = b.st[0], nx = b.st[1];
        if (nloc == 0u) { xcd_barrier_complete(bar, b.x, nloc, nx); b.st[0] = nloc; b.st[1] = nx; }
        const unsigned old = xb_add(&bar[XB_XSUB(b.x)], 1u);
        const unsigned gen = old / nloc;
        if (old + 1u == (gen + 1u) * nloc) {
            __builtin_amdgcn_fence(__ATOMIC_RELEASE, "agent");
            asm volatile("s_waitcnt vmcnt(0)" ::: "memory");
            const unsigned og = xb_add(&bar[XB_TOP], 1u);
            const unsigned tg = og / nx;
            if (og + 1u == (tg + 1u) * nx) xb_add(&bar[XB_TOPGEN], 1u);
            else XB_SPIN(xb_ld(&bar[XB_TOPGEN]) == tg, bar);
            __builtin_amdgcn_fence(__ATOMIC_ACQUIRE, "agent");
            xb_add(&bar[XB_XGEN(b.x)], 1u);
            asm volatile("s_waitcnt vmcnt(0)" ::: "memory");
        } else {
            XB_SPIN(xb_ld(&bar[XB_XGEN(b.x)]) == gen, bar);
            __builtin_amdgcn_fence(__ATOMIC_ACQUIRE, "agent");
            asm volatile("s_waitcnt vmcnt(0)" ::: "memory");
        }
    }
    __syncthreads();
}


__device__ __forceinline__ float bf2f(unsigned short b) { return __uint_as_float((unsigned)b << 16); }
__device__ __forceinline__ unsigned short f2bf(float f) { unsigned u = __float_as_uint(f); u += 0x7FFFu + ((u >> 16) & 1u); return (unsigned short)(u >> 16); }
__device__ __forceinline__ float sigm(float x) { return __builtin_amdgcn_rcpf(1.0f + __expf(-x)); }
__device__ __forceinline__ float tanh_fast(float x) { return 1.0f - 2.0f * __builtin_amdgcn_rcpf(1.0f + __expf(2.0f * x)); }
__device__ __forceinline__ float rdl(float x, int i) { return __uint_as_float(__builtin_amdgcn_readlane(__float_as_uint(x), i)); }
__device__ __forceinline__ float wsum(float x) {
#pragma unroll
    for (int o = 32; o; o >>= 1) x += __shfl_xor(x, o);
    return x; }
__device__ __forceinline__ float lo16(unsigned w) { return __uint_as_float(w << 16); }
__device__ __forceinline__ float hi16(unsigned w) { return __uint_as_float(w & 0xffff0000u); }
__device__ __forceinline__ float rstd_of(const float* rowss, int row) { return rsqrtf(rowss[row] * (1.0f / 1024.0f) + 1e-6f); }

template <int MODE> struct EpiBf {
    static constexpr bool PERM = true, AFTER_DRAIN = false;
    bf16_t* O; int ldc; const float* rowss;
    __device__ __forceinline__ void operator()(const f32x4 (&acc)[2][2][4][2], const pg8::Unit& u, int wr, int wc, int fr, int fq) const {
        const int row0 = u.pm * 256 + wr * 64 + fr, col0 = u.pn * 256 + wc * 32 + 8 * fq;
#pragma unroll
        for (int ai = 0; ai < 2; ++ai)
#pragma unroll
            for (int m = 0; m < 4; ++m) {
                const int row = row0 + ai * 128 + m * 16;
                const float s = (MODE == 2) ? 1.0f : rstd_of(rowss, row);
                bf16_t* rowp = O + (size_t)row * ldc + col0;
#pragma unroll
                for (int bj = 0; bj < 2; ++bj) {
                    f32x4 v0 = acc[ai][bj][m][0] * s, v1 = acc[ai][bj][m][1] * s;
                    if (MODE == 1) {
#pragma unroll
                        for (int j = 0; j < 4; ++j) { const float a = fmaxf(v0[j], 0.f), b = fmaxf(v1[j], 0.f); v0[j] = a * a; v1[j] = b * b; } }
                    u32x4 w; w.x = cvt_pk_bf16(v0[0], v0[1]); w.y = cvt_pk_bf16(v0[2], v0[3]); w.z = cvt_pk_bf16(v1[0], v1[1]); w.w = cvt_pk_bf16(v1[2], v1[3]);
                    *(u32x4*)(rowp + bj * 128) = w; } }
    }
};
template <int ACC> struct EpiGate {
    static constexpr bool PERM = true, AFTER_DRAIN = false;
    bf16_t* M; const bf16_t* Tm; const float* rowss;
    __device__ __forceinline__ void operator()(const f32x4 (&acc)[2][2][4][2], const pg8::Unit& u, int wr, int wc, int fr, int fq) const {
        const int row0 = u.pm * 256 + wr * 64 + fr, col0 = u.pn * 256 + wc * 32 + 8 * fq;
#pragma unroll
        for (int ai = 0; ai < 2; ++ai)
#pragma unroll
            for (int m = 0; m < 4; ++m) {
                const int row = row0 + ai * 128 + m * 16;
                const float s = rstd_of(rowss, row);
#pragma unroll
                for (int bj = 0; bj < 2; ++bj) {
                    const size_t off = (size_t)row * 1024 + col0 + bj * 128;
                    const u32x4 tv = *(const u32x4*)(Tm + off);
                    u32x4 pv = (u32x4){0u, 0u, 0u, 0u};
                    if (ACC) pv = *(const u32x4*)(M + off);
                    const f32x4 a0 = acc[ai][bj][m][0] * s, a1 = acc[ai][bj][m][1] * s;
                    float o[8];
                    o[0] = sigm(a0[0]) * lo16(tv.x); o[1] = sigm(a0[1]) * hi16(tv.x); o[2] = sigm(a0[2]) * lo16(tv.y); o[3] = sigm(a0[3]) * hi16(tv.y);
                    o[4] = sigm(a1[0]) * lo16(tv.z); o[5] = sigm(a1[1]) * hi16(tv.z); o[6] = sigm(a1[2]) * lo16(tv.w); o[7] = sigm(a1[3]) * hi16(tv.w);
                    if (ACC) { o[0] += lo16(pv.x); o[1] += hi16(pv.x); o[2] += lo16(pv.y); o[3] += hi16(pv.y); o[4] += lo16(pv.z); o[5] += hi16(pv.z); o[6] += lo16(pv.w); o[7] += hi16(pv.w); }
                    u32x4 w; w.x = cvt_pk_bf16(o[0], o[1]); w.y = cvt_pk_bf16(o[2], o[3]); w.z = cvt_pk_bf16(o[4], o[5]); w.w = cvt_pk_bf16(o[6], o[7]);
                    *(u32x4*)(M + off) = w; } }
    }
};
struct EpiResid {
    static constexpr bool PERM = false, AFTER_DRAIN = false;
    float* X; bf16_t* XB; float* rowss_out; const float* Xp0; const float* Xs0;
    __device__ __forceinline__ void operator()(const f32x4 (&acc)[2][2][4][2], const pg8::Unit& u, int wr, int wc, int fr, int fq) const {
        const int row0 = u.pm * 256 + wr * 64 + fr, col0 = u.pn * 256 + wc * 32 + 4 * fq;
#pragma unroll
        for (int ai = 0; ai < 2; ++ai)
#pragma unroll
            for (int m = 0; m < 4; ++m) {
                const int row = row0 + ai * 128 + m * 16;
                float* xp = X + (size_t)row * 1024 + col0; bf16_t* bp = XB + (size_t)row * 1024 + col0;
                const float* xi = Xp0 ? (row < T_P ? Xp0 + (size_t)row * 1024 + col0 : Xs0 + (size_t)(row - T_P) * 1024 + col0) : xp;
                float ss = 0.f;
#pragma unroll
                for (int bj = 0; bj < 2; ++bj)
#pragma unroll
                    for (int n = 0; n < 2; ++n) {
                        f32x4 xv = *(const f32x4*)(xi + bj * 128 + n * 16) + acc[ai][bj][m][n];
                        *(f32x4*)(xp + bj * 128 + n * 16) = xv;
                        ss += (xv[0] * xv[0] + xv[1] * xv[1]) + (xv[2] * xv[2] + xv[3] * xv[3]);
                        u32x2 w; w.x = cvt_pk_bf16(xv[0], xv[1]); w.y = cvt_pk_bf16(xv[2], xv[3]);
                        *(u32x2*)(bp + bj * 128 + n * 16) = w; }
                ss += __shfl_xor(ss, 16); ss += __shfl_xor(ss, 32);
                if (fq == 0) atomicAdd(rowss_out + row, ss); }
    }
};
template <class Epi> __device__ __forceinline__ void run_gemm(LAS unsigned char* lds, const bf16_t* A, const bf16_t* Bt, int N, int K, const Epi& E, int Mrows = T_ALL) {
    pg8::StaticOrder S; S.init(Mrows, N, (int)gridDim.x, bidx());
    pg8::Gemm g; g.A = A; g.Bt = Bt; g.M = Mrows; g.N = N; g.K = K; g.ld = K;
    pg8::gemm_phase<Epi, pg8::StaticOrder, false>(lds, g, S, E, nullptr);
}


struct OneUnit { int pm, pn, valid;
    __device__ bool next(int i, pg8::Unit& u) const { if (i != 0 || !valid) return false; u.pm = pm; u.pn = pn; return true; }
    __device__ __forceinline__ void a_ready(const pg8::Unit&) const {}
    __device__ __forceinline__ void done(const pg8::Unit&) const {} };
struct EpiPartial {
    static constexpr bool PERM = false, AFTER_DRAIN = false;
    float* PART;
    __device__ __forceinline__ void operator()(const f32x4 (&acc)[2][2][4][2], const pg8::Unit& u, int wr, int wc, int fr, int fq) const {
        const int row0 = (u.pm - 64) * 256 + wr * 64 + fr, col0 = u.pn * 256 + wc * 32 + 4 * fq;
#pragma unroll
        for (int ai = 0; ai < 2; ++ai)
#pragma unroll
            for (int m = 0; m < 4; ++m) { float* xp = PART + (size_t)(row0 + ai * 128 + m * 16) * 1024 + col0;
#pragma unroll
                for (int bj = 0; bj < 2; ++bj)
#pragma unroll
                    for (int n = 0; n < 2; ++n) *(f32x4*)(xp + bj * 128 + n * 16) = acc[ai][bj][m][n]; }
    }
};
constexpr size_t OFF_PART = OFF_B + 4 * SLOT;
__device__ __forceinline__ void run_ffn_down(LAS unsigned char* lds, const bf16_t* HID, const bf16_t* WDN, const EpiResid& E, float* PART) {
    { pg8::StaticOrder S; S.init(T_P, 1024, (int)gridDim.x, bidx());
      pg8::Gemm g; g.A = HID; g.Bt = WDN; g.M = T_P; g.N = 1024; g.K = 4096; g.ld = 4096;
      pg8::gemm_phase<EpiResid, pg8::StaticOrder, false>(lds, g, S, E, nullptr); }
    { const int t = bidx(); OneUnit S; S.valid = t < 128; const int sl = t & 7, u = (t >> 3) & 15; S.pm = 64 + (u >> 2); S.pn = u & 3;
      pg8::Gemm g; g.A = HID + sl * 512; g.Bt = WDN + sl * 512; g.M = T_ALL; g.N = 1024; g.K = 512; g.ld = 4096;
      EpiPartial EA; EA.PART = PART + (size_t)sl * 1024 * 1024;
      pg8::gemm_phase<EpiPartial, OneUnit, false>(lds, g, S, EA, nullptr); }
}
constexpr size_t OFF_GPART = OFF_B + 2 * SLOT;
__device__ __forceinline__ void run_gate_sample_tasks(LAS unsigned char* lds, unsigned char* ws) {
    const int t = bidx(); OneUnit S; S.valid = t < 192;
    const bf16_t* A; const bf16_t* Bt; int ld, slot, u, sl;
    if (t < 32)       { u = t >> 1; sl = t & 1; A = (const bf16_t*)(ws + OFF_B); Bt = (const bf16_t*)(ws + OFF_WOA); ld = 512; slot = sl; }
    else if (t < 64)  { u = (t - 32) >> 1; sl = t & 1; A = (const bf16_t*)(ws + OFF_B + SLOT); Bt = (const bf16_t*)(ws + OFF_WOB); ld = 512; slot = 2 + sl; }
    else if (t < 128) { u = (t - 64) >> 2; sl = t & 3; A = (const bf16_t*)(ws + OFF_XB); Bt = (const bf16_t*)(ws + OFF_WGA); ld = 1024; slot = 4 + sl; }
    else              { u = ((t - 128) >> 2) & 15; sl = t & 3; A = (const bf16_t*)(ws + OFF_XB); Bt = (const bf16_t*)(ws + OFF_WGB); ld = 1024; slot = 8 + sl; }
    S.pm = 64 + (u >> 2); S.pn = u & 3;
    pg8::Gemm g; g.A = A + sl * 256; g.Bt = Bt + sl * 256; g.M = T_ALL; g.N = 1024; g.K = 256; g.ld = ld;
    EpiPartial EA; EA.PART = (float*)(ws + OFF_GPART) + (size_t)slot * 1024 * 1024;
    pg8::gemm_phase<EpiPartial, OneUnit, false>(lds, g, S, EA, nullptr);
}
__device__ __forceinline__ void run_wo_sample_tasks(LAS unsigned char* lds, unsigned char* ws) {
    const int t = bidx(); OneUnit S; S.valid = t < 64; const int u = (t >> 2) & 15, sl = t & 3; S.pm = 64 + (u >> 2); S.pn = u & 3;
    pg8::Gemm g; g.A = (const bf16_t*)(ws + OFF_A) + sl * 256; g.Bt = (const bf16_t*)(ws + OFF_WO) + sl * 256; g.M = T_ALL; g.N = 1024; g.K = 256; g.ld = 1024;
    EpiPartial EA; EA.PART = (float*)(ws + OFF_GPART) + (size_t)sl * 1024 * 1024;
    pg8::gemm_phase<EpiPartial, OneUnit, false>(lds, g, S, EA, nullptr);
}
__device__ void gate_combine(unsigned char* ws, const float* rs_mix) {
    const float* P = (const float*)(ws + OFF_GPART); bf16_t* TA = (bf16_t*)(ws + OFF_A);
    constexpr size_t MM = (size_t)1024 * 1024;
    for (int idx = bidx() * 512 + tidx(); idx < 131072; idx += gridDim.x * 512) {
        const int row = idx >> 7, c8 = (idx & 127) * 8; const size_t o = (size_t)row * 1024 + c8;
        const float s = rstd_of(rs_mix, T_P + row);
        float m[8];
#pragma unroll
        for (int hf = 0; hf < 2; ++hf) {
            const size_t oo = o + hf * 4;
            const float4 ta0 = *(const float4*)(P + oo), ta1 = *(const float4*)(P + MM + oo), tb0 = *(const float4*)(P + 2 * MM + oo), tb1 = *(const float4*)(P + 3 * MM + oo);
            float4 ga = *(const float4*)(P + 4 * MM + oo), gb = *(const float4*)(P + 8 * MM + oo);
#pragma unroll
            for (int j = 1; j < 4; ++j) { const float4 x = *(const float4*)(P + (4 + j) * MM + oo), y = *(const float4*)(P + (8 + j) * MM + oo);
                ga.x += x.x; ga.y += x.y; ga.z += x.z; ga.w += x.w; gb.x += y.x; gb.y += y.y; gb.z += y.z; gb.w += y.w; }
            m[hf * 4 + 0] = sigm(ga.x * s) * (ta0.x + ta1.x) + sigm(gb.x * s) * (tb0.x + tb1.x);
            m[hf * 4 + 1] = sigm(ga.y * s) * (ta0.y + ta1.y) + sigm(gb.y * s) * (tb0.y + tb1.y);
            m[hf * 4 + 2] = sigm(ga.z * s) * (ta0.z + ta1.z) + sigm(gb.z * s) * (tb0.z + tb1.z);
            m[hf * 4 + 3] = sigm(ga.w * s) * (ta0.w + ta1.w) + sigm(gb.w * s) * (tb0.w + tb1.w);
        }
        u32x4 w; w.x = cvt_pk_bf16(m[0], m[1]); w.y = cvt_pk_bf16(m[2], m[3]); w.z = cvt_pk_bf16(m[4], m[5]); w.w = cvt_pk_bf16(m[6], m[7]);
        *(u32x4*)(TA + (size_t)(T_P + row) * 1024 + c8) = w;
    }
}
__device__ void finalize_sample(const Ctx& p, float* rowss_out, size_t part_off, int nsl, const float* xs0) {
    unsigned char* ws = uptr(p.ws); bf16_t* XB = (bf16_t*)(ws + OFF_XB); const float* PART = (const float*)(ws + part_off);
    const int tid = tidx(); const int wave = __builtin_amdgcn_readfirstlane(tid >> 6), lane = tid & 63;
    for (int row = T_P + bidx() * 8 + wave; row < T_ALL; row += gridDim.x * 8) {
        float* src = p.out + (size_t)row * 1024; const float* rd = xs0 ? xs0 + (size_t)(row - T_P) * 1024 : src; const float* pr = PART + (size_t)(row - T_P) * 1024; float ss = 0.f;
#pragma unroll
        for (int i = 0; i < 4; ++i) { const int c = i * 256 + lane * 4; float4 v = *(const float4*)(rd + c);
            for (int sl = 0; sl < nsl; ++sl) { const float4 q = *(const float4*)(pr + (size_t)sl * 1024 * 1024 + c); v.x += q.x; v.y += q.y; v.z += q.z; v.w += q.w; }
            *(float4*)(src + c) = v;
            ss += v.x * v.x + v.y * v.y + v.z * v.z + v.w * v.w; u32x2 w; w.x = cvt_pk_bf16(v.x, v.y); w.y = cvt_pk_bf16(v.z, v.w); *(u32x2*)(XB + (size_t)row * 1024 + c) = w; }
        ss = wsum(ss); if (lane == 0) rowss_out[row] = ss;
    }
}
__device__ void conv_T(const float* __restrict__ src, int ld, int s0, int cnt, int K, const float* __restrict__ scale, bf16_t* __restrict__ dst, int d0, LAS unsigned char* lds, int vb, int nvb) {
    LAS float* ts = (LAS float*)lds;
    const int tid = tidx(); const int nkt = K / 256, ntile = (cnt / 32) * nkt;
    if (vb < 0) return;
    for (int tile = vb; tile < ntile; tile += nvb) {
        const int n0 = (tile / nkt) * 32, k0 = (tile % nkt) * 256;
        { const int kk = tid >> 3, nq = tid & 7; float4 v[4]; float sc[4];
#pragma unroll
          for (int r = 0; r < 4; ++r) { v[r] = *(const float4*)(src + (size_t)(k0 + r * 64 + kk) * ld + s0 + n0 + nq * 4); sc[r] = scale ? scale[k0 + r * 64 + kk] : 1.0f; }
#pragma unroll
          for (int r = 0; r < 4; ++r) { LAS float* q = ts + (nq * 4) * 257 + r * 64 + kk; q[0] = v[r].x * sc[r]; q[257] = v[r].y * sc[r]; q[514] = v[r].z * sc[r]; q[771] = v[r].w * sc[r]; } }
        __syncthreads();
        { const int n = tid >> 4, kq = tid & 15;
#pragma unroll
          for (int r = 0; r < 4; ++r) { const LAS float* q = ts + n * 257 + r * 64 + kq * 4; u32x2 w; w.x = cvt_pk_bf16(q[0], q[1]); w.y = cvt_pk_bf16(q[2], q[3]);
            *(u32x2*)(dst + (size_t)(d0 + n0 + n) * K + k0 + r * 64 + kq * 4) = w; } }
        __syncthreads();
    }
}
__device__ void conv_small(const float* __restrict__ src, int ld, int cnt, int K, bf16_t* __restrict__ dst, int vb, int nvb) {
    if (vb < 0) return;
    for (int i = vb * 512 + tidx(); i < cnt * K; i += nvb * 512) { const int c = i / K, j = i % K; dst[i] = f2bf(src[(size_t)j * ld + c]); }
}
__device__ void phase_convert_early(const Ctx& p, int l, LAS unsigned char* lds, int vb, int nvb) {
    unsigned char* ws = uptr(p.ws);
    const float* win = INP(p, 6) + (size_t)l * 1024 * 5920; const float* nm = INP(p, 5) + l * 1024;
    conv_T(win, 5920, 0, 1824, 1024, nm, (bf16_t*)(ws + OFF_WRW), 0, lds, vb, nvb);
    { u32x4* z = (u32x4*)(ws + OFF_WRW + (size_t)1824 * 1024 * 2); const int n = 224 * 1024 * 2 / 16;
      unsigned zz = 0u; asm volatile("" : "+v"(zz));
      if (vb >= 0) for (int i = vb * 512 + tidx(); i < n; i += nvb * 512) z[i] = (u32x4){zz, zz, zz, zz}; }
    conv_small(INP(p, 9) + (size_t)l * 64 * 512, 512, 512, 64, (bf16_t*)(ws + OFF_SM + SM_W2T), vb, nvb);
    conv_small(INP(p, 11) + (size_t)l * 64 * 512, 512, 512, 64, (bf16_t*)(ws + OFF_SM + SM_A2T), vb, nvb);
    conv_small(INP(p, 12) + (size_t)l * 160 * 512, 512, 512, 160, (bf16_t*)(ws + OFF_SM + SM_G2T), vb, nvb);
    if (l == 1) {
        conv_small(INP(p, 14), 32, 32, 512, (bf16_t*)(ws + OFF_SM + SM_V1T), vb, nvb);
        conv_small(INP(p, 15), 512, 512, 32, (bf16_t*)(ws + OFF_SM + SM_V2T), vb, nvb);
    }
}
__device__ void phase_convert_hg(const Ctx& p, int l, LAS unsigned char* lds, int vb, int nvb) {
    unsigned char* ws = uptr(p.ws);
    conv_T(INP(p, 6) + (size_t)l * 1024 * 5920, 5920, 1824, 2048, 1024, INP(p, 5) + l * 1024, (bf16_t*)(ws + OFF_WHG), 0, lds, vb, nvb);
}
__device__ void phase_convert_late(const Ctx& p, int l, LAS unsigned char* lds, int vb, int nvb) {
    unsigned char* ws = uptr(p.ws);
    const float* win = INP(p, 6) + (size_t)l * 1024 * 5920; const float* nm = INP(p, 5) + l * 1024;
    conv_T(win, 5920, 3872, 1024, 1024, nm, (bf16_t*)(ws + OFF_WGA), 0, lds, vb, nvb);
    conv_T(win, 5920, 4896, 1024, 1024, nm, (bf16_t*)(ws + OFF_WGB), 0, lds, vb, nvb);
    conv_T(INP(p, 23) + (size_t)l * 512 * 1024, 1024, 0, 1024, 512, nullptr, (bf16_t*)(ws + OFF_WOA), 0, lds, vb, nvb);
    conv_T(INP(p, 24) + (size_t)l * 512 * 1024, 1024, 0, 1024, 512, nullptr, (bf16_t*)(ws + OFF_WOB), 0, lds, vb, nvb);
    conv_T(INP(p, 25) + (size_t)l * 1024 * 1024, 1024, 0, 1024, 1024, nullptr, (bf16_t*)(ws + OFF_WO), 0, lds, vb, nvb);
    conv_T(INP(p, 27) + (size_t)l * 1024 * 4096, 4096, 0, 4096, 1024, INP(p, 26) + l * 1024, (bf16_t*)(ws + OFF_WUP), 0, lds, vb, nvb);
    conv_T(INP(p, 28) + (size_t)l * 4096 * 1024, 1024, 0, 1024, 4096, nullptr, (bf16_t*)(ws + OFF_WDN), 0, lds, vb, nvb);
}
__device__ void phase_x0(const Ctx& p) {
    const int tid = tidx(); const int wave = __builtin_amdgcn_readfirstlane(tid >> 6), lane = tid & 63;
    unsigned char* ws = uptr(p.ws);
    float* rowss = (float*)(ws + OFF_SM + SM_ROWSS); bf16_t* XB = (bf16_t*)(ws + OFF_XB);
    for (int row = bidx() * 8 + wave; row < T_ALL; row += gridDim.x * 8) {
        const float* src = row < T_P ? INP(p, 0) + (size_t)row * 1024 : INP(p, 1) + (size_t)(row - T_P) * 1024;
        float ss = 0.f;
#pragma unroll
        for (int i = 0; i < 4; ++i) { const int c = i * 256 + lane * 4; const float4 v = *(const float4*)(src + c);
            ss += v.x * v.x + v.y * v.y + v.z * v.z + v.w * v.w; u32x2 w; w.x = cvt_pk_bf16(v.x, v.y); w.y = cvt_pk_bf16(v.z, v.w); *(u32x2*)(XB + (size_t)row * 1024 + c) = w; }
        ss = wsum(ss); if (lane == 0) rowss[row] = ss;
    }
    for (int i = bidx() * 512 + tidx(); i < 4 * T_ALL; i += gridDim.x * 512) rowss[T_ALL + i] = 0.f;
}
__device__ __forceinline__ u32x2 pack4(float a, float b, float c, float d) { u32x2 w; w.x = cvt_pk_bf16(a, b); w.y = cvt_pk_bf16(c, d); return w; }
__device__ void phase_prep(const Ctx& p, int l, LAS unsigned char* lds) {
    constexpr int MXS = 1832, MIDS = 40;
    unsigned char* ws = uptr(p.ws);
    const bf16_t* PR = (const bf16_t*)(ws + OFF_A);
    LAS bf16_t* MX = (LAS bf16_t*)lds; LAS bf16_t* MID = (LAS bf16_t*)(lds + 32 * MXS * 2);
    const int tid = tidx(); const int wave = __builtin_amdgcn_readfirstlane(tid >> 6), lane = tid & 63, fr = lane & 15, fq = lane >> 4;
    const float* mu = INP(p, 7) + l * 1824;
    const bf16_t* w2T = (const bf16_t*)(ws + OFF_SM + SM_W2T); const bf16_t* a2T = (const bf16_t*)(ws + OFF_SM + SM_A2T); const bf16_t* g2T = (const bf16_t*)(ws + OFF_SM + SM_G2T);
    const bf16_t* v1T = (const bf16_t*)(ws + OFF_SM + SM_V1T); const bf16_t* v2T = (const bf16_t*)(ws + OFF_SM + SM_V2T);
    bf16_t* oR = (bf16_t*)(ws + OFF_B); bf16_t* oV = (bf16_t*)(l == 0 ? ws + OFF_V0 : ws + OFF_B + SLOT); bf16_t* oE = (bf16_t*)(ws + OFF_B + 2 * SLOT);
    bf16_t* oK = (bf16_t*)(ws + OFF_B + 3 * SLOT); bf16_t* oA = (bf16_t*)(ws + OFF_B + 4 * SLOT); bf16_t* oB = (bf16_t*)(ws + OFF_B + 5 * SLOT);
    bf16_t* oG = (bf16_t*)(ws + OFF_G); const bf16_t* V0 = (const bf16_t*)(ws + OFF_V0);
    float* bonus = (float*)(ws + OFF_SM + SM_BONUS);
    const float* w0 = INP(p, 8) + l * 512; const float* a0 = INP(p, 10) + l * 512; const float* kkp = INP(p, 16) + l * 512; const float* kap = INP(p, 17) + l * 512; const float* rkp = INP(p, 18) + l * 512;
    const float* v0p = INP(p, 13);
    for (int ti = bidx(); ti < T_ALL / 32; ti += gridDim.x) {
        const int t0 = ti * 32;
        if (tid < 456) {
            const int cgp = tid % 228, rh = tid / 228, c0 = cgp * 8, rstart = rh * 16;
            float prev[8], m8[8];
            { const float4 a = *(const float4*)(mu + c0), b = *(const float4*)(mu + c0 + 4); m8[0] = a.x; m8[1] = a.y; m8[2] = a.z; m8[3] = a.w; m8[4] = b.x; m8[5] = b.y; m8[6] = b.z; m8[7] = b.w; }
            const bool seq_start = (rh == 0) && (t0 >= T_P || (t0 % 8192) == 0);
            if (seq_start) {
                if (t0 >= T_P) { const float* sp = INP(p, 2) + ((size_t)l * 32 + (t0 - T_P) / 32) * 1824 + c0;
#pragma unroll
                    for (int j = 0; j < 8; ++j) prev[j] = sp[j]; }
                else {
#pragma unroll
                    for (int j = 0; j < 8; ++j) prev[j] = 0.f; }
            } else {
                const u32x4 w = *(const u32x4*)(PR + (size_t)(t0 + rstart - 1) * 2048 + c0);
                prev[0] = lo16(w.x); prev[1] = hi16(w.x); prev[2] = lo16(w.y); prev[3] = hi16(w.y); prev[4] = lo16(w.z); prev[5] = hi16(w.z); prev[6] = lo16(w.w); prev[7] = hi16(w.w);
            }
            const int fn = c0 < 1536 ? 0 : (c0 < 1600 ? 1 : (c0 < 1664 ? 0 : 2));
#pragma unroll 1
            for (int r8 = 0; r8 < 16; r8 += 8) {
            u32x4 wrow[8];
#pragma unroll
            for (int r = 0; r < 8; ++r) wrow[r] = *(const u32x4*)(PR + (size_t)(t0 + rstart + r8 + r) * 2048 + c0);
#pragma unroll
            for (int rr = 0; rr < 8; ++rr) {
                const int r = r8 + rr; const u32x4 w = wrow[rr];
                float cur[8], o[8];
                cur[0] = lo16(w.x); cur[1] = hi16(w.x); cur[2] = lo16(w.y); cur[3] = hi16(w.y); cur[4] = lo16(w.z); cur[5] = hi16(w.z); cur[6] = lo16(w.w); cur[7] = hi16(w.w);
#pragma unroll
                for (int j = 0; j < 8; ++j) { float x = cur[j] + (prev[j] - cur[j]) * m8[j]; if (fn == 1) x = tanh_fast(x); else if (fn == 2) x = sigm(x); o[j] = x; prev[j] = cur[j]; }
                u32x4 q; q.x = cvt_pk_bf16(o[0], o[1]); q.y = cvt_pk_bf16(o[2], o[3]); q.z = cvt_pk_bf16(o[4], o[5]); q.w = cvt_pk_bf16(o[6], o[7]);
                *(LAS u32x4*)(MX + (rstart + r) * MXS + c0) = q;
            }
            }
            if (rh == 1) {
                const bool last = t0 >= T_P || ((t0 + 32) % 8192) == 0;
                if (last) { float* dst = t0 >= T_P ? p.out + O_SHS + ((size_t)l * 32 + (t0 - T_P) / 32) * 1824 + c0 : p.out + O_SHP + ((size_t)l * 2 + t0 / 8192) * 1824 + c0;
#pragma unroll
                    for (int j = 0; j < 8; ++j) dst[j] = prev[j]; }
            }
        }
        __syncthreads();
        if (l == 1 && VRES && VRES != 2) {
            if (wave < 4) {
                const int tt = wave & 1, ot = wave >> 1; f32x4 acc = (f32x4){0.f, 0.f, 0.f, 0.f};
#pragma unroll 4
                for (int ks = 0; ks < 16; ++ks) {
                    const bf16x8 X = *(const bf16x8*)(v1T + (ot * 16 + fr) * 512 + ks * 32 + fq * 8);
                    const bf16x8 Y = *(const LAS bf16x8*)(MX + (tt * 16 + fr) * MXS + 1024 + ks * 32 + fq * 8);
                    acc = __builtin_amdgcn_mfma_f32_16x16x32_bf16(X, Y, acc, 0, 0, 0); }
                *(LAS u32x2*)(MID + (tt * 16 + fr) * MIDS + ot * 16 + 4 * fq) = pack4(acc[0], acc[1], acc[2], acc[3]);
            }
            __syncthreads();
        }
        const int h = wave;
        float ss[2] = {0.f, 0.f}, bon[2] = {0.f, 0.f};
#pragma unroll 1
        for (int ct = 0; ct < 4; ++ct) {
            const int crow = h * 64 + ct * 16 + fr, c = h * 64 + ct * 16 + 4 * fq;
            bf16x8 xw[2], xa[2], xg[5], xv;
#pragma unroll
            for (int ks = 0; ks < 2; ++ks) { xw[ks] = *(const bf16x8*)(w2T + crow * 64 + ks * 32 + fq * 8); xa[ks] = *(const bf16x8*)(a2T + crow * 64 + ks * 32 + fq * 8); }
#pragma unroll
            for (int ks = 0; ks < 5; ++ks) xg[ks] = *(const bf16x8*)(g2T + crow * 160 + ks * 32 + fq * 8);
            if (l == 1) xv = *(const bf16x8*)(v2T + crow * 32 + fq * 8); else xv = xw[0];
            const float4 w04 = *(const float4*)(w0 + c), a04 = *(const float4*)(a0 + c), kk_4 = *(const float4*)(kkp + c), ka4 = *(const float4*)(kap + c), rk4 = *(const float4*)(rkp + c);
            const float w0a[4] = {w04.x, w04.y, w04.z, w04.w}, a0a[4] = {a04.x, a04.y, a04.z, a04.w}, kka[4] = {kk_4.x, kk_4.y, kk_4.z, kk_4.w}, kaa[4] = {ka4.x, ka4.y, ka4.z, ka4.w}, rka[4] = {rk4.x, rk4.y, rk4.z, rk4.w};
            float v0a[4] = {0.f, 0.f, 0.f, 0.f};
            if (l == 1) { const float4 v04 = *(const float4*)(v0p + c); v0a[0] = v04.x; v0a[1] = v04.y; v0a[2] = v04.z; v0a[3] = v04.w; }
            u32x2 fwv[2] = {(u32x2){0u, 0u}, (u32x2){0u, 0u}};
            if (l == 1) { fwv[0] = *(const u32x2*)(V0 + (size_t)(t0 + fr) * 512 + c); fwv[1] = *(const u32x2*)(V0 + (size_t)(t0 + 16 + fr) * 512 + c); }
#pragma unroll
            for (int tt = 0; tt < 2; ++tt) {
                const LAS bf16_t* yrow = MX + (tt * 16 + fr) * MXS + fq * 8;
                f32x4 aW = (f32x4){0.f, 0.f, 0.f, 0.f}, aA = aW, aG = aW, aV = aW;
#pragma unroll
                for (int ks = 0; ks < 2; ++ks) { aW = __builtin_amdgcn_mfma_f32_16x16x32_bf16(xw[ks], *(const LAS bf16x8*)(yrow + 1536 + ks * 32), aW, 0, 0, 0);
                                                 aA = __builtin_amdgcn_mfma_f32_16x16x32_bf16(xa[ks], *(const LAS bf16x8*)(yrow + 1600 + ks * 32), aA, 0, 0, 0); }
#pragma unroll
                for (int ks = 0; ks < 5; ++ks) aG = __builtin_amdgcn_mfma_f32_16x16x32_bf16(xg[ks], *(const LAS bf16x8*)(yrow + 1664 + ks * 32), aG, 0, 0, 0);
                if (l == 1) aV = __builtin_amdgcn_mfma_f32_16x16x32_bf16(xv, *(const LAS bf16x8*)(MID + (tt * 16 + fr) * MIDS + fq * 8), aV, 0, 0, 0);
                const int j = tt * 16 + fr, t = t0 + j;
                LAS bf16_t* mrow = MX + j * MXS + c;
                const u32x2 rw = *(const LAS u32x2*)(mrow), kw = *(const LAS u32x2*)(mrow + 512), vw = *(const LAS u32x2*)(mrow + 1024);
                const float rr[4] = {lo16(rw.x), hi16(rw.x), lo16(rw.y), hi16(rw.y)}, kk4[4] = {lo16(kw.x), hi16(kw.x), lo16(kw.y), hi16(kw.y)};
                float vv[4] = {lo16(vw.x), hi16(vw.x), lo16(vw.y), hi16(vw.y)};
                if (l == 1) {
                    const u32x2 fw = fwv[tt]; const float vf[4] = {lo16(fw.x), hi16(fw.x), lo16(fw.y), hi16(fw.y)};
#pragma unroll
                    for (int e = 0; e < 4; ++e) { const float vg = sigm(v0a[e] + aV[e]); vv[e] = vv[e] + (vf[e] - vv[e]) * vg; }
                }
                float ew[4], kh[4], kr4[4], ag4[4];
#pragma unroll
                for (int e = 0; e < 4; ++e) {
                    ew[e] = 0.60653066f * sigm(w0a[e] + aW[e]);
                    const float a = sigm(a0a[e] + aA[e]); ag4[e] = a;
                    const float kr = kk4[e] * kka[e]; kr4[e] = kr; ss[tt] += kr * kr;
                    kh[e] = kk4[e] * (1.0f + (a - 1.0f) * kaa[e]);
                    bon[tt] += rr[e] * kh[e] * rka[e];
                }
                const size_t o = (size_t)t * 512 + c;
                *(u32x2*)(oR + o) = rw;
                *(u32x2*)(oV + o) = pack4(vv[0], vv[1], vv[2], vv[3]);
                *(u32x2*)(oE + o) = pack4(ew[0], ew[1], ew[2], ew[3]);
                *(u32x2*)(oK + o) = pack4(kh[0], kh[1], kh[2], kh[3]);
                *(u32x2*)(oG + o) = pack4(aG[0], aG[1], aG[2], aG[3]);
                *(LAS u32x2*)(mrow) = pack4(ag4[0], ag4[1], ag4[2], ag4[3]);
                *(LAS u32x2*)(mrow + 512) = pack4(kr4[0], kr4[1], kr4[2], kr4[3]);
            }
        }
#pragma unroll
        for (int tt = 0; tt < 2; ++tt) {
            float s1 = ss[tt], b1 = bon[tt];
            s1 += __shfl_xor(s1, 16); s1 += __shfl_xor(s1, 32); b1 += __shfl_xor(b1, 16); b1 += __shfl_xor(b1, 32);
            const float inv = rsqrtf(fmaxf(s1, 1e-24f));
            const int j = tt * 16 + fr, t = t0 + j;
#pragma unroll
            for (int ct = 0; ct < 4; ++ct) {
                const int c = h * 64 + ct * 16 + 4 * fq;
                const LAS bf16_t* mrow = MX + j * MXS + c;
                const u32x2 aw = *(const LAS u32x2*)(mrow), kw = *(const LAS u32x2*)(mrow + 512);
                const float ag4[4] = {lo16(aw.x), hi16(aw.x), lo16(aw.y), hi16(aw.y)}; float k4[4] = {lo16(kw.x) * inv, hi16(kw.x) * inv, lo16(kw.y) * inv, hi16(kw.y) * inv};
                const size_t o = (size_t)t * 512 + c;
                *(u32x2*)(oA + o) = pack4(-k4[0], -k4[1], -k4[2], -k4[3]);
                *(u32x2*)(oB + o) = pack4(k4[0] * ag4[0], k4[1] * ag4[1], k4[2] * ag4[2], k4[3] * ag4[3]);
            }
            if (fq == 0) bonus[(size_t)t * 8 + h] = b1;
        }
        __syncthreads();
    }
}

typedef float f2 __attribute__((ext_vector_type(2)));
__device__ __forceinline__ f2 pfma(f2 a, f2 b, f2 c) { return __builtin_elementwise_fma(a, b, c); }
template <bool ID> __device__ __forceinline__ void rwkv_scan(const bf16_t* __restrict__ R, const bf16_t* __restrict__ EW, const bf16_t* __restrict__ K, const bf16_t* __restrict__ V,
        const bf16_t* __restrict__ A, const bf16_t* __restrict__ B, unsigned base, int nsteps, f2 (&Sv)[32], f2 (&Si)[32], bf16_t* __restrict__ YH, bf16_t* __restrict__ QH, LAS float* L, int lane) {
    unsigned short q1[6], q2[6];
    { unsigned o = base; q1[0] = R[o]; q1[1] = EW[o]; q1[2] = K[o]; q1[3] = V[o]; q1[4] = A[o]; q1[5] = B[o];
      o = base + 512u; q2[0] = R[o]; q2[1] = EW[o]; q2[2] = K[o]; q2[3] = V[o]; q2[4] = A[o]; q2[5] = B[o]; }
    const LAS f32x4* pa = (const LAS f32x4*)L;
    float sav, sai;
    { L[lane] = bf2f(q1[4]);
      f2 av = {0.f, 0.f}, ai = {0.f, 0.f};
#pragma unroll
      for (int q = 0; q < 16; ++q) { const f32x4 a4 = pa[q]; const f2 a01 = {a4[0], a4[1]}, a23 = {a4[2], a4[3]};
          av = pfma(Sv[2 * q], a01, av); av = pfma(Sv[2 * q + 1], a23, av); if (ID) { ai = pfma(Si[2 * q], a01, ai); ai = pfma(Si[2 * q + 1], a23, ai); } }
      sav = av[0] + av[1]; sai = ai[0] + ai[1]; }
#pragma unroll 1
    for (int s = 0; s < nsteps; ++s) {
        L[lane] = bf2f(q2[4]); L[64 + lane] = __expf(-bf2f(q1[1])); L[128 + lane] = bf2f(q1[5]); L[192 + lane] = bf2f(q1[2]); L[256 + lane] = bf2f(q1[0]);
        const float v = bf2f(q1[3]);
#pragma unroll
        for (int j = 0; j < 6; ++j) q1[j] = q2[j];
        { const unsigned o = base + (unsigned)(s + 2 < nsteps ? s + 2 : nsteps - 1) * 512u; q2[0] = R[o]; q2[1] = EW[o]; q2[2] = K[o]; q2[3] = V[o]; q2[4] = A[o]; q2[5] = B[o]; }
        const f2 sav2 = {sav, sav}, sai2 = {sai, sai}, v2 = {v, v};
        f2 yv = {0.f, 0.f}, yi = {0.f, 0.f}, yv1 = {0.f, 0.f}, yi1 = {0.f, 0.f}, nv = {0.f, 0.f}, ni = {0.f, 0.f}, nv1 = {0.f, 0.f}, ni1 = {0.f, 0.f};
        f32x4 ca = pa[0], cw = pa[16], cb = pa[32], ck = pa[48], cr = pa[64];
#pragma unroll
        for (int q = 0; q < 16; ++q) {
            const f32x4 a4 = ca, w4 = cw, b4 = cb, k4 = ck, r4 = cr;
            if (q < 15) { ca = pa[1 + q]; cw = pa[17 + q]; cb = pa[33 + q]; ck = pa[49 + q]; cr = pa[65 + q]; }
            __builtin_amdgcn_sched_barrier(0);
            { const f2 a2 = {a4[0], a4[1]}, w2 = {w4[0], w4[1]}, b2 = {b4[0], b4[1]}, k2 = {k4[0], k4[1]}, r2 = {r4[0], r4[1]};
              f2 tv = sav2 * b2; tv = pfma(v2, k2, tv); Sv[2 * q] = pfma(Sv[2 * q], w2, tv); yv = pfma(Sv[2 * q], r2, yv); nv = pfma(Sv[2 * q], a2, nv);
              if (ID) { const f2 ti = sai2 * b2; Si[2 * q] = pfma(Si[2 * q], w2, ti); yi = pfma(Si[2 * q], r2, yi); ni = pfma(Si[2 * q], a2, ni); } }
            { const f2 a2 = {a4[2], a4[3]}, w2 = {w4[2], w4[3]}, b2 = {b4[2], b4[3]}, k2 = {k4[2], k4[3]}, r2 = {r4[2], r4[3]};
              f2 tv = sav2 * b2; tv = pfma(v2, k2, tv); Sv[2 * q + 1] = pfma(Sv[2 * q + 1], w2, tv); yv1 = pfma(Sv[2 * q + 1], r2, yv1); nv1 = pfma(Sv[2 * q + 1], a2, nv1);
              if (ID) { const f2 ti = sai2 * b2; Si[2 * q + 1] = pfma(Si[2 * q + 1], w2, ti); yi1 = pfma(Si[2 * q + 1], r2, yi1); ni1 = pfma(Si[2 * q + 1], a2, ni1); } }
        }
        sav = (nv[0] + nv[1]) + (nv1[0] + nv1[1]); sai = (ni[0] + ni[1]) + (ni1[0] + ni1[1]);
        const unsigned cbo = base + (unsigned)s * 512u;
        YH[cbo] = f2bf((yv[0] + yv[1]) + (yv1[0] + yv1[1])); if (ID) QH[cbo] = f2bf((yi[0] + yi[1]) + (yi1[0] + yi1[1]));
    }
}
__device__ void phase_rwkv_scan(const Ctx& p, int l, LAS unsigned char* lds) {
    unsigned char* ws = uptr(p.ws);
    const bf16_t* R = (const bf16_t*)(ws + OFF_B); const bf16_t* V = (const bf16_t*)(l == 0 ? ws + OFF_V0 : ws + OFF_B + SLOT); const bf16_t* EW = (const bf16_t*)(ws + OFF_B + 2 * SLOT);
    const bf16_t* K = (const bf16_t*)(ws + OFF_B + 3 * SLOT); const bf16_t* A = (const bf16_t*)(ws + OFF_B + 4 * SLOT); const bf16_t* B = (const bf16_t*)(ws + OFF_B + 5 * SLOT);
    bf16_t* YH = (bf16_t*)(ws + OFF_A); bf16_t* QH = (bf16_t*)(ws + OFF_A + SLOT); float* P = (float*)(ws + OFF_A + 34 * MiB); float* UC = (float*)(ws + OFF_A + 50 * MiB);
    const int tid = tidx(); const int wave = __builtin_amdgcn_readfirstlane(tid >> 6), lane = tid & 63;
    LAS float* L = (LAS float*)(lds + wave * 5120);
    if (wave < 4) {
        for (int item = bidx() * 4 + wave; item < 1024; item += gridDim.x * 4) {
            const int b = item >> 9, c = (item >> 3) & 63, h = item & 7;
            f2 Sv[32], Si[32]; const int li = tidx() & 63;
#pragma unroll
            for (int i = 0; i < 32; ++i) { Sv[i] = (f2){0.f, 0.f}; Si[i] = (f2){(2 * i == li) ? 1.f : 0.f, (2 * i + 1 == li) ? 1.f : 0.f}; }
            rwkv_scan<true>(R, EW, K, V, A, B, (unsigned)((b * 8192 + c * 128) * 512 + h * 64 + lane), 128, Sv, Si, YH, QH, L, lane);
            const int ln = tidx() & 63; int item2 = item; asm volatile("" : "+s"(item2));
            float* pp = P + (size_t)item2 * 4096 + ln * 64; float* up = UC + (size_t)item2 * 4096 + ln * 64;
#pragma unroll
            for (int i = 0; i < 32; i += 2) { *(float4*)(pp + 2 * i) = make_float4(Si[i][0], Si[i][1], Si[i + 1][0], Si[i + 1][1]); *(float4*)(up + 2 * i) = make_float4(Sv[i][0], Sv[i][1], Sv[i + 1][0], Sv[i + 1][1]); }
        }
    } else if (wave == 4) {
        for (int item = bidx(); item < 256; item += gridDim.x) {
            const int s = item >> 3, h = item & 7;
            const size_t so = (((size_t)l * 32 + s) * 8 + h) * 4096 + lane * 64;
            f2 Sv[32], Si[32];
            const float* sp = INP(p, 3) + so;
#pragma unroll
            for (int i = 0; i < 32; i += 2) { const float4 q = *(const float4*)(sp + 2 * i); Sv[i] = (f2){q.x, q.y}; Sv[i + 1] = (f2){q.z, q.w}; Si[i] = (f2){0.f, 0.f}; Si[i + 1] = (f2){0.f, 0.f}; }
            rwkv_scan<false>(R, EW, K, V, A, B, (unsigned)((T_P + s * 32) * 512 + h * 64 + lane), 32, Sv, Si, YH, QH, L, lane);
            float* op = p.out + O_RWS + so;
#pragma unroll
            for (int i = 0; i < 32; i += 2) *(float4*)(op + 2 * i) = make_float4(Sv[i][0], Sv[i][1], Sv[i + 1][0], Sv[i + 1][1]);
        }
    }
}
template <int CTRL> __device__ __forceinline__ float dpp_mov(float x) { return __uint_as_float(__builtin_amdgcn_update_dpp(0, __float_as_uint(x), CTRL, 0xF, 0xF, true)); }
__device__ __forceinline__ float wsum_fast(float x) {
    x += dpp_mov<0xB1>(x); x += dpp_mov<0x4E>(x); x += dpp_mov<0x141>(x); x += dpp_mov<0x140>(x);
    float t = rdl(x, 0); t += rdl(x, 16); t += rdl(x, 32); t += rdl(x, 48); return t; }
__device__ void phase_rwkv_chain(const Ctx& p, int l) {
    unsigned char* ws = uptr(p.ws);
    const float* P = (const float*)(ws + OFF_A + 34 * MiB); float* UC = (float*)(ws + OFF_A + 50 * MiB);
    const int tid = tidx(); const int wave = __builtin_amdgcn_readfirstlane(tid >> 6), lane = tid & 63;
    if (wave >= 4) return;
    for (int it = bidx() * 4 + wave; it < 1024; it += gridDim.x * 4) {
        const int b = it >> 9, h = (it >> 6) & 7, v = it & 63;
        const float* pb = P + (size_t)((b * 64) * 8 + h) * 4096 + lane;
        float* ub = UC + (size_t)((b * 64) * 8 + h) * 4096 + v * 64 + lane;
        float row = 0.f; float PA[64], PB[64];
#pragma unroll
        for (int i = 0; i < 64; ++i) PA[i] = pb[i * 64];
        float ucA = ub[0];
        for (int c = 0; c < 64; c += 2) {
            { const float* pc = pb + (size_t)(c + 1) * 32768;
#pragma unroll
              for (int i = 0; i < 64; ++i) PB[i] = pc[i * 64]; }
            const float ucB = ub[(size_t)(c + 1) * 32768];
            ub[(size_t)c * 32768] = row;
            { float n0 = ucA, n1 = 0.f;
#pragma unroll
              for (int i = 0; i < 64; i += 2) { n0 = fmaf(rdl(row, i), PA[i], n0); n1 = fmaf(rdl(row, i + 1), PA[i + 1], n1); }
              row = n0 + n1; }
            if (c + 2 < 64) { const float* pc = pb + (size_t)(c + 2) * 32768;
#pragma unroll
                for (int i = 0; i < 64; ++i) PA[i] = pc[i * 64];
                ucA = ub[(size_t)(c + 2) * 32768]; }
            ub[(size_t)(c + 1) * 32768] = row;
            { float n0 = ucB, n1 = 0.f;
#pragma unroll
              for (int i = 0; i < 64; i += 2) { n0 = fmaf(rdl(row, i), PB[i], n0); n1 = fmaf(rdl(row, i + 1), PB[i + 1], n1); }
              row = n0 + n1; }
        }
        p.out[O_RWP + (((size_t)l * 2 + b) * 8 + h) * 4096 + v * 64 + lane] = row;
    }
}
__device__ void phase_rwkv_fix(const Ctx& p, int l) {
    unsigned char* ws = uptr(p.ws);
    const bf16_t* YH = (const bf16_t*)(ws + OFF_A); const bf16_t* QH = (const bf16_t*)(ws + OFF_A + SLOT); const float* UC = (const float*)(ws + OFF_A + 50 * MiB);
    const bf16_t* V = (const bf16_t*)(l == 0 ? ws + OFF_V0 : ws + OFF_B + SLOT); const bf16_t* G = (const bf16_t*)(ws + OFF_G); const float* bonus = (const float*)(ws + OFF_SM + SM_BONUS);
    bf16_t* YA = (bf16_t*)(ws + OFF_B);
    const int tid = tidx(); const int wave = __builtin_amdgcn_readfirstlane(tid >> 6), lane = tid & 63, fr = lane & 15, fq = lane >> 4;
    const float* lnw = INP(p, 19) + l * 512; const float* lnb = INP(p, 20) + l * 512;
    for (int item = bidx() * 8 + wave; item < 4096 + 256; item += gridDim.x * 8) {
        const bool smp = item >= 4096;
        int h, t0, it = 0, ntile;
        if (!smp) { const int tq = item & 3; it = item >> 2; const int b = it >> 9, c = (it >> 3) & 63; h = it & 7; t0 = b * 8192 + c * 128 + tq * 32; ntile = 2; }
        else { const int si = item - 4096; h = si & 7; t0 = T_P + (si >> 3) * 32; ntile = 2; }
        bf16x8 X[4][2];
        if (!smp) {
#pragma unroll
            for (int vt = 0; vt < 4; ++vt)
#pragma unroll
                for (int ks = 0; ks < 2; ++ks) { const float* sp = UC + (size_t)it * 4096 + (vt * 16 + fr) * 64 + ks * 32 + fq * 8; const float4 a = *(const float4*)sp, b4 = *(const float4*)(sp + 4);
                    u32x4 w; w.x = cvt_pk_bf16(a.x, a.y); w.y = cvt_pk_bf16(a.z, a.w); w.z = cvt_pk_bf16(b4.x, b4.y); w.w = cvt_pk_bf16(b4.z, b4.w); X[vt][ks] = __builtin_bit_cast(bf16x8, w); }
        }
        float gw[4][4], gb[4][4];
#pragma unroll
        for (int vt = 0; vt < 4; ++vt) { const float4 a = *(const float4*)(lnw + h * 64 + vt * 16 + 4 * fq), b4 = *(const float4*)(lnb + h * 64 + vt * 16 + 4 * fq);
            gw[vt][0] = a.x; gw[vt][1] = a.y; gw[vt][2] = a.z; gw[vt][3] = a.w; gb[vt][0] = b4.x; gb[vt][1] = b4.y; gb[vt][2] = b4.z; gb[vt][3] = b4.w; }
        for (int tt = 0; tt < ntile; ++tt) {
            const int t = t0 + tt * 16 + fr; const size_t ob = (size_t)t * 512 + h * 64;
            float y[4][4];
            u32x2 yw[4], vw[4], gg[4];
#pragma unroll
            for (int vt = 0; vt < 4; ++vt) { yw[vt] = *(const u32x2*)(YH + ob + vt * 16 + 4 * fq); vw[vt] = *(const u32x2*)(V + ob + vt * 16 + 4 * fq); gg[vt] = *(const u32x2*)(G + ob + vt * 16 + 4 * fq); }
            const float bn = bonus[(size_t)t * 8 + h];
            if (!smp) {
                const bf16x8 Y0 = *(const bf16x8*)(QH + ob + fq * 8), Y1 = *(const bf16x8*)(QH + ob + 32 + fq * 8);
#pragma unroll
                for (int vt = 0; vt < 4; ++vt) { f32x4 acc = (f32x4){0.f, 0.f, 0.f, 0.f};
                    acc = __builtin_amdgcn_mfma_f32_16x16x32_bf16(X[vt][0], Y0, acc, 0, 0, 0); acc = __builtin_amdgcn_mfma_f32_16x16x32_bf16(X[vt][1], Y1, acc, 0, 0, 0);
                    y[vt][0] = acc[0] + lo16(yw[vt].x); y[vt][1] = acc[1] + hi16(yw[vt].x); y[vt][2] = acc[2] + lo16(yw[vt].y); y[vt][3] = acc[3] + hi16(yw[vt].y); }
            } else {
#pragma unroll
                for (int vt = 0; vt < 4; ++vt) { y[vt][0] = lo16(yw[vt].x); y[vt][1] = hi16(yw[vt].x); y[vt][2] = lo16(yw[vt].y); y[vt][3] = hi16(yw[vt].y); }
            }
            float sm = 0.f;
#pragma unroll
            for (int vt = 0; vt < 4; ++vt) sm += (y[vt][0] + y[vt][1]) + (y[vt][2] + y[vt][3]);
            sm += __shfl_xor(sm, 16); sm += __shfl_xor(sm, 32);
            const float mean = sm * (1.0f / 64.0f); float sq = 0.f;
#pragma unroll
            for (int vt = 0; vt < 4; ++vt)
#pragma unroll
                for (int e = 0; e < 4; ++e) { y[vt][e] -= mean; sq += y[vt][e] * y[vt][e]; }
            sq += __shfl_xor(sq, 16); sq += __shfl_xor(sq, 32);
            const float rs = rsqrtf(sq * (1.0f / 64.0f) + 64e-5f);
#pragma unroll
            for (int vt = 0; vt < 4; ++vt) {
                const float vv[4] = {lo16(vw[vt].x), hi16(vw[vt].x), lo16(vw[vt].y), hi16(vw[vt].y)}, g4[4] = {lo16(gg[vt].x), hi16(gg[vt].x), lo16(gg[vt].y), hi16(gg[vt].y)};
                float o[4];
#pragma unroll
                for (int e = 0; e < 4; ++e) o[e] = (y[vt][e] * rs * gw[vt][e] + gb[vt][e] + bn * vv[e]) * g4[e];
                *(u32x2*)(YA + ob + vt * 16 + 4 * fq) = pack4(o[0], o[1], o[2], o[3]);
            }
        }
    }
}
__device__ __forceinline__ float lb_of(const Ctx& p, int l, int c) { if (l == 0) return 0.f; const float* z = INP(p, 21); const float z0 = z[c], z1 = z[512 + c]; return __builtin_amdgcn_rcpf(1.0f + __expf(z0 - z1)); }
__device__ __forceinline__ void hgrn_scan(const bf16_t* __restrict__ PH, int t0, int nsteps, int h, int half, int kh, int lane, float lb, f2 (&S)[32], float& cp, bf16_t* __restrict__ OHp, float* __restrict__ ckp, LAS float* L) {
    const bf16_t* row = PH + (size_t)t0 * 2048 + h * 128 + kh * 64 + lane; const int voff = 1024 + (half - kh) * 64;
    unsigned short q1[3], q2[3], q3[3];
    { const bf16_t* r = row; q1[0] = r[0]; q1[1] = r[512]; q1[2] = r[voff];
      r = row + 2048; q2[0] = r[0]; q2[1] = r[512]; q2[2] = r[voff];
      r = row + 4096; q3[0] = r[0]; q3[1] = r[512]; q3[2] = r[voff]; }
    const LAS f32x4* pf = (const LAS f32x4*)L;
#pragma unroll 1
    for (int s = 0; s < nsteps; ++s) {
        const float ql = bf2f(q1[0]), fz = bf2f(q1[1]), v = bf2f(q1[2]);
#pragma unroll
        for (int j = 0; j < 3; ++j) { q1[j] = q2[j]; q2[j] = q3[j]; }
        { const bf16_t* r = row + (size_t)(s + 3 < nsteps ? s + 3 : nsteps - 1) * 2048; q3[0] = r[0]; q3[1] = r[512]; q3[2] = r[voff]; }
        const float fl = lb + (1.0f - lb) * sigm(fz);
        cp *= fl;
        if (ckp && (s & 31) == 31 && s < 127) ckp[(s >> 5) * 128 + lane] = cp;
        L[lane] = fl; L[64 + lane] = ql * sigm(ql);
        f32x4 F[2][4], Q[2][4];
#pragma unroll
        for (int i = 0; i < 4; ++i) { F[0][i] = pf[i]; Q[0][i] = pf[16 + i]; }
        const f2 v2 = {v, v}; f2 o2 = {0.f, 0.f}, o3 = {0.f, 0.f};
#pragma unroll
        for (int g = 0; g < 4; ++g) {
            if (g < 3) {
#pragma unroll
                for (int i = 0; i < 4; ++i) { F[(g + 1) & 1][i] = pf[(g + 1) * 4 + i]; Q[(g + 1) & 1][i] = pf[16 + (g + 1) * 4 + i]; } }
            __builtin_amdgcn_sched_barrier(0);
#pragma unroll
            for (int i = 0; i < 4; ++i) {
                const f32x4 f4 = F[g & 1][i], q4 = Q[g & 1][i]; const int idx = (g * 4 + i) * 2;
                const f2 f01 = {f4[0], f4[1]}, f23 = {f4[2], f4[3]}, q01 = {q4[0], q4[1]}, q23 = {q4[2], q4[3]};
                S[idx] = pfma(f01, S[idx] - v2, v2); o2 = pfma(S[idx], q01, o2);
                S[idx + 1] = pfma(f23, S[idx + 1] - v2, v2); o3 = pfma(S[idx + 1], q23, o3);
            }
        }
        OHp[(size_t)(t0 + s) * 512 + h * 128 + half * 64 + lane] = f2bf((o2[0] + o2[1]) + (o3[0] + o3[1]));
    }
}
constexpr size_t OFF_PGC = OFF_B + 3 * SLOT + 32 * MiB;
__device__ void phase_hgrn_scan(const Ctx& p, int l, LAS unsigned char* lds) {
    unsigned char* ws = uptr(p.ws);
    const bf16_t* PH = (const bf16_t*)(ws + OFF_A); bf16_t* OH0 = (bf16_t*)(ws + OFF_B + 2 * SLOT); bf16_t* OH1 = (bf16_t*)(ws + OFF_B + 5 * SLOT);
    float* UCH = (float*)(ws + OFF_B + 3 * SLOT); float* PGH = (float*)(ws + OFF_SM + SM_PGH); float* PGC = (float*)(ws + OFF_PGC);
    const int tid = tidx(); const int wave = __builtin_amdgcn_readfirstlane(tid >> 6), lane = tid & 63;
    LAS float* L = (LAS float*)(lds + wave * 1024);
    for (int item = bidx() * 8 + wave; item < 2048; item += gridDim.x * 8) {
        const int kh = item & 1, half = (item >> 1) & 1, h = (item >> 2) & 3, c = (item >> 4) & 63, b = item >> 10, idx = item >> 2;
        f2 S[32];
#pragma unroll
        for (int k = 0; k < 32; ++k) S[k] = (f2){0.f, 0.f};
        float cp = 1.f;
        hgrn_scan(PH, b * 8192 + c * 128, 128, h, half, kh, lane, lb_of(p, l, h * 128 + kh * 64 + lane), S, cp, kh ? OH1 : OH0, half == 0 ? PGC + (size_t)idx * 384 + kh * 64 : nullptr, L);
        float* up = UCH + (size_t)idx * 16384 + (size_t)(kh * 64) * 128 + half * 64 + lane;
#pragma unroll
        for (int k = 0; k < 32; ++k) { up[(2 * k) * 128] = S[k][0]; up[(2 * k + 1) * 128] = S[k][1]; }
        if (half == 0) PGH[idx * 128 + kh * 64 + lane] = cp;
    }
    if (wave < 2) {
        for (int item = bidx() * 2 + wave; item < 512; item += gridDim.x * 2) {
            const int kh = item & 1, half = (item >> 1) & 1, h = (item >> 2) & 3, s = item >> 4;
            const size_t so = (((size_t)l * 32 + s) * 4 + h) * 16384 + (size_t)(kh * 64) * 128 + half * 64 + lane;
            f2 S[32];
            const float* stp = INP(p, 4) + so;
#pragma unroll
            for (int k = 0; k < 32; ++k) S[k] = (f2){stp[(2 * k) * 128], stp[(2 * k + 1) * 128]};
            float cp = 1.f;
            hgrn_scan(PH, T_P + s * 32, 32, h, half, kh, lane, lb_of(p, l, h * 128 + kh * 64 + lane), S, cp, kh ? OH1 : OH0, nullptr, L);
#pragma unroll
            for (int k = 0; k < 32; ++k) { p.out[O_HGS + so + (2 * k) * 128] = S[k][0]; p.out[O_HGS + so + (2 * k + 1) * 128] = S[k][1]; }
        }
    }
}
__device__ void phase_hgrn_chain(const Ctx& p, int l) {
    unsigned char* ws = uptr(p.ws);
    float* UCH = (float*)(ws + OFF_B + 3 * SLOT); const float* PGH = (const float*)(ws + OFF_SM + SM_PGH);
    for (int gid = bidx() * 512 + tidx(); gid < 131072; gid += gridDim.x * 512) {
        const int b = gid >> 16, h = (gid >> 14) & 3, k = (gid >> 7) & 127, v = gid & 127;
        float s = 0.f;
        for (int c0 = 0; c0 < 64; c0 += 8) {
            float u[8], pg[8];
#pragma unroll
            for (int j = 0; j < 8; ++j) { const size_t idx = (size_t)(b * 64 + c0 + j) * 4 + h; u[j] = UCH[idx * 16384 + k * 128 + v]; pg[j] = PGH[idx * 128 + k]; }
#pragma unroll
            for (int j = 0; j < 8; ++j) { const size_t idx = (size_t)(b * 64 + c0 + j) * 4 + h; UCH[idx * 16384 + k * 128 + v] = s; s = fmaf(pg[j], s, u[j]); }
        }
        p.out[O_HGP + (((size_t)l * 2 + b) * 4 + h) * 16384 + k * 128 + v] = s;
    }
}
__device__ void phase_hgrn_fix(const Ctx& p, int l, LAS unsigned char* lds) {
    unsigned char* ws = uptr(p.ws);
    const bf16_t* PH = (const bf16_t*)(ws + OFF_A); const bf16_t* OH = (const bf16_t*)(ws + OFF_B + 2 * SLOT); const float* UCH = (const float*)(ws + OFF_B + 3 * SLOT);
    const float* PGC = (const float*)(ws + OFF_PGC); const bf16_t* OH1 = (const bf16_t*)(ws + OFF_B + 5 * SLOT);
    bf16_t* YB = (bf16_t*)(ws + OFF_B + SLOT);
    const int tid = tidx(); const int wave = __builtin_amdgcn_readfirstlane(tid >> 6), lane = tid & 63, fr = lane & 15, fq = lane >> 4;
    const float* nw = INP(p, 22) + l * 512;
    constexpr int QS = 136;
    LAS bf16_t* QT = (LAS bf16_t*)(lds + wave * 16384);
    for (int item = bidx() * 8 + wave; item < 2048; item += gridDim.x * 8) {
        const int tq = item & 3, idx = item >> 2, h = idx & 3, c = (idx >> 2) & 63, b = idx >> 8;
        const float lbl = lb_of(p, l, h * 128 + lane), lbh = lb_of(p, l, h * 128 + 64 + lane);
        const int tbase = b * 8192 + c * 128 + tq * 32;
        float rl = 1.f, rh = 1.f;
        if (tq) { rl = PGC[(size_t)idx * 384 + (tq - 1) * 128 + lane]; rh = PGC[(size_t)idx * 384 + (tq - 1) * 128 + 64 + lane]; }
        const bf16_t* row = PH + (size_t)tbase * 2048 + h * 128 + lane;
#pragma unroll 1
        for (int t8 = 0; t8 < 32; t8 += 8) {
            unsigned short rq[8][4];
#pragma unroll
            for (int j = 0; j < 8; ++j) { const bf16_t* r = row + (size_t)(t8 + j) * 2048; rq[j][0] = r[0]; rq[j][1] = r[64]; rq[j][2] = r[512]; rq[j][3] = r[576]; }
#pragma unroll
            for (int j = 0; j < 8; ++j) {
                const float ql = bf2f(rq[j][0]), qh = bf2f(rq[j][1]);
                rl *= lbl + (1.0f - lbl) * sigm(bf2f(rq[j][2])); rh *= lbh + (1.0f - lbh) * sigm(bf2f(rq[j][3]));
                QT[(t8 + j) * QS + lane] = f2bf(ql * sigm(ql) * rl); QT[(t8 + j) * QS + 64 + lane] = f2bf(qh * sigm(qh) * rh);
            }
        }
        f32x4 acc[8][2];
        const float* sb = UCH + (size_t)idx * 16384 + fr;
#pragma unroll
        for (int vt = 0; vt < 8; ++vt) {
            acc[vt][0] = (f32x4){0.f, 0.f, 0.f, 0.f}; acc[vt][1] = (f32x4){0.f, 0.f, 0.f, 0.f};
#pragma unroll
            for (int ks = 0; ks < 4; ++ks) {
                const float* sp = sb + (size_t)(ks * 32 + fq * 8) * 128 + vt * 16;
                u32x4 w; w.x = cvt_pk_bf16(sp[0], sp[128]); w.y = cvt_pk_bf16(sp[256], sp[384]); w.z = cvt_pk_bf16(sp[512], sp[640]); w.w = cvt_pk_bf16(sp[768], sp[896]);
                const bf16x8 X = __builtin_bit_cast(bf16x8, w);
                acc[vt][0] = __builtin_amdgcn_mfma_f32_16x16x32_bf16(X, *(const LAS bf16x8*)(QT + fr * QS + ks * 32 + fq * 8), acc[vt][0], 0, 0, 0);
                acc[vt][1] = __builtin_amdgcn_mfma_f32_16x16x32_bf16(X, *(const LAS bf16x8*)(QT + (16 + fr) * QS + ks * 32 + fq * 8), acc[vt][1], 0, 0, 0);
            }
        }
#pragma unroll
        for (int tt = 0; tt < 2; ++tt) {
            const int t = tbase + tt * 16 + fr;
            const bf16_t* op = OH + (size_t)t * 512 + h * 128 + 4 * fq; const bf16_t* op1 = OH1 + (size_t)t * 512 + h * 128 + 4 * fq; const bf16_t* gp = PH + (size_t)t * 2048 + 1536 + h * 128 + 4 * fq;
            float o[8][4]; float ss = 0.f;
#pragma unroll
            for (int vt = 0; vt < 8; ++vt) { const u32x2 ow = *(const u32x2*)(op + vt * 16), ox = *(const u32x2*)(op1 + vt * 16);
                o[vt][0] = acc[vt][tt][0] + (lo16(ow.x) + lo16(ox.x)); o[vt][1] = acc[vt][tt][1] + (hi16(ow.x) + hi16(ox.x)); o[vt][2] = acc[vt][tt][2] + (lo16(ow.y) + lo16(ox.y)); o[vt][3] = acc[vt][tt][3] + (hi16(ow.y) + hi16(ox.y));
                ss += (o[vt][0] * o[vt][0] + o[vt][1] * o[vt][1]) + (o[vt][2] * o[vt][2] + o[vt][3] * o[vt][3]); }
            ss += __shfl_xor(ss, 16); ss += __shfl_xor(ss, 32);
            const float rs = rsqrtf(ss * (1.0f / 128.0f) + 1e-6f);
#pragma unroll
            for (int vt = 0; vt < 8; ++vt) { const u32x2 gw = *(const u32x2*)(gp + vt * 16); const float4 n4 = *(const float4*)(nw + h * 128 + vt * 16 + 4 * fq);
                const float g4[4] = {lo16(gw.x), hi16(gw.x), lo16(gw.y), hi16(gw.y)}, nn[4] = {n4.x, n4.y, n4.z, n4.w}; float r[4];
#pragma unroll
                for (int e = 0; e < 4; ++e) r[e] = o[vt][e] * rs * nn[e] * g4[e] * sigm(g4[e]);
                *(u32x2*)(YB + (size_t)t * 512 + h * 128 + vt * 16 + 4 * fq) = pack4(r[0], r[1], r[2], r[3]); }
        }
    }
    if (wave == 0) {
        for (int item = bidx(); item < 128; item += gridDim.x) {
            const int s = item >> 2, h = item & 3;
            const float nw0 = nw[h * 128 + lane], nw1 = nw[h * 128 + 64 + lane];
#pragma unroll 4
            for (int tt = 0; tt < 32; ++tt) {
                const int t = T_P + s * 32 + tt;
                const float o0 = bf2f(OH[(size_t)t * 512 + h * 128 + lane]) + bf2f(OH1[(size_t)t * 512 + h * 128 + lane]), o1 = bf2f(OH[(size_t)t * 512 + h * 128 + 64 + lane]) + bf2f(OH1[(size_t)t * 512 + h * 128 + 64 + lane]);
                const float g0 = bf2f(PH[(size_t)t * 2048 + 1536 + h * 128 + lane]), g1 = bf2f(PH[(size_t)t * 2048 + 1536 + h * 128 + 64 + lane]);
                const float rs = rsqrtf(wsum_fast(o0 * o0 + o1 * o1) * (1.0f / 128.0f) + 1e-6f);
                YB[(size_t)t * 512 + h * 128 + lane] = f2bf(o0 * rs * nw0 * g0 * sigm(g0));
                YB[(size_t)t * 512 + h * 128 + 64 + lane] = f2bf(o1 * rs * nw1 * g1 * sigm(g1));
            }
        }
    }
}
__device__ void phase_final(const Ctx& p) {
    const int tid = tidx(); const int wave = __builtin_amdgcn_readfirstlane(tid >> 6), lane = tid & 63;
    const float* nf = INP(p, 29); const float* PART = (const float*)(uptr(p.ws) + OFF_PART);
    for (int row = bidx() * 8 + wave; row < T_ALL; row += gridDim.x * 8) {
        float* xp = p.out + (size_t)row * 1024; float4 v[4]; float ss = 0.f;
#pragma unroll
        for (int i = 0; i < 4; ++i) { v[i] = *(const float4*)(xp + i * 256 + lane * 4);
            if (row >= T_P) { const float* pr = PART + (size_t)(row - T_P) * 1024 + i * 256 + lane * 4;
#pragma unroll
                for (int sl = 0; sl < 8; ++sl) { const float4 q = *(const float4*)(pr + (size_t)sl * 1024 * 1024); v[i].x += q.x; v[i].y += q.y; v[i].z += q.z; v[i].w += q.w; } }
            ss += v[i].x * v[i].x + v[i].y * v[i].y + v[i].z * v[i].z + v[i].w * v[i].w; }
        const float s = rsqrtf(wsum(ss) * (1.0f / 1024.0f) + 1e-6f);
#pragma unroll
        for (int i = 0; i < 4; ++i) { const int c = i * 256 + lane * 4; const float4 w = *(const float4*)(nf + c);
            v[i].x *= s * w.x; v[i].y *= s * w.y; v[i].z *= s * w.z; v[i].w *= s * w.w; *(float4*)(xp + c) = v[i]; }
    }
}
#define VRES 1
#define GEMM_PRO unsigned char* ws = uptr(p.ws); float* rowss = (float*)(ws + OFF_SM + SM_ROWSS); bf16_t* XB = (bf16_t*)(ws + OFF_XB); \
    const float* rs_mix = rowss + (size_t)(2 * l) * T_ALL; float* rs_ffn = rowss + (size_t)(2 * l + 1) * T_ALL; float* rs_next = rowss + (size_t)(2 * l + 2) * T_ALL; (void)rs_mix; (void)rs_ffn; (void)rs_next; (void)XB
__global__ void __launch_bounds__(512, 2) mega_fwd(Params prm) {
    extern __shared__ __attribute__((aligned(16))) unsigned char lds_raw[];
    LAS unsigned char* lds = (LAS unsigned char*)lds_raw;
    cg::grid_group grid = cg::this_grid();
    Ctx p; p.ws = prm.ws; p.out = prm.out;
    { unsigned long long* tb = (unsigned long long*)(prm.ws + OFF_SM + SM_TBL + (size_t)blockIdx.x * 256);
      if (threadIdx.x == 0) {
#define TB(i) tb[i] = (unsigned long long)prm.in[i];
          TB(0) TB(1) TB(2) TB(3) TB(4) TB(5) TB(6) TB(7) TB(8) TB(9) TB(10) TB(11) TB(12) TB(13) TB(14) TB(15) TB(16) TB(17) TB(18) TB(19) TB(20) TB(21) TB(22) TB(23) TB(24) TB(25) TB(26) TB(27) TB(28) TB(29)
#undef TB
      }
      __threadfence_block(); __syncthreads();
      p.tbl = tb; }
    volatile LAS unsigned* xst = (volatile LAS unsigned*)(lds + 131072);
    if (threadIdx.x < 2) xst[threadIdx.x] = 0u;
    __syncthreads();
    XcdBarrier xb = xcd_barrier_post((unsigned*)(prm.ws + OFF_SM + SM_BAR), xst);
    grid.sync();
    phase_x0(p);
#pragma unroll 1
    for (int ph = 0; ph < 28; ++ph) {
        const int l = ph >= 14 ? 1 : 0, k = ph - 14 * l;
        switch (k) {
        case 0: if (l == 1) { GEMM_PRO; finalize_sample(p, rowss + (size_t)2 * T_ALL, OFF_PART, 8, nullptr); } else phase_convert_early(p, 0, lds, bidx(), (int)gridDim.x); break;
        case 1: { GEMM_PRO; EpiBf<0> E; E.O = (bf16_t*)(ws + OFF_A); E.ldc = 2048; E.rowss = rs_mix; run_gemm(lds, XB, (const bf16_t*)(ws + OFF_WRW), 2048, 1024, E);
                  { const int b = bidx(); phase_convert_hg(p, l, lds, b >= 32 ? b - 32 : -1, (int)gridDim.x - 32); } } break;
        case 2: phase_prep(p, l, lds); break;
        case 3: phase_rwkv_scan(p, l, lds); break;
        case 4: phase_rwkv_chain(p, l); break;
        case 5: phase_rwkv_fix(p, l); break;
        case 6: { GEMM_PRO; EpiBf<0> E; E.O = (bf16_t*)(ws + OFF_A); E.ldc = 2048; E.rowss = rs_mix; run_gemm(lds, XB, (const bf16_t*)(ws + OFF_WHG), 2048, 1024, E);
                  { const int b = bidx(); phase_convert_late(p, l, lds, b >= 32 ? b - 32 : -1, (int)gridDim.x - 32); } } break;
        case 7: phase_hgrn_scan(p, l, lds); break;
        case 8: phase_hgrn_chain(p, l); break;
        case 9: phase_hgrn_fix(p, l, lds); break;
        case 10: {
            GEMM_PRO; bf16_t* TA = (bf16_t*)(ws + OFF_A); bf16_t* TB = (bf16_t*)(ws + OFF_A + 34 * MiB);
            { EpiBf<2> E; E.O = TA; E.ldc = 1024; E.rowss = nullptr; run_gemm(lds, (const bf16_t*)(ws + OFF_B), (const bf16_t*)(ws + OFF_WOA), 1024, 512, E, T_P); }
            { EpiGate<0> E; E.M = TA; E.Tm = TA; E.rowss = rs_mix; run_gemm(lds, XB, (const bf16_t*)(ws + OFF_WGA), 1024, 1024, E, T_P); }
            { EpiBf<2> E; E.O = TB; E.ldc = 1024; E.rowss = nullptr; run_gemm(lds, (const bf16_t*)(ws + OFF_B + SLOT), (const bf16_t*)(ws + OFF_WOB), 1024, 512, E, T_P); }
            { EpiGate<1> E; E.M = TA; E.Tm = TB; E.rowss = rs_mix; run_gemm(lds, XB, (const bf16_t*)(ws + OFF_WGB), 1024, 1024, E, T_P); }
            run_gate_sample_tasks(lds, ws);
            xcd_barrier(xb);
            gate_combine(ws, rs_mix);
        } break;
        case 11: { GEMM_PRO; EpiResid E; E.X = p.out; E.XB = XB; E.rowss_out = rs_ffn; E.Xp0 = l == 0 ? INP(p, 0) : nullptr; E.Xs0 = l == 0 ? INP(p, 1) : nullptr;
                   run_gemm(lds, (const bf16_t*)(ws + OFF_A), (const bf16_t*)(ws + OFF_WO), 1024, 1024, E, T_P);
                   run_wo_sample_tasks(lds, ws);
                   xcd_barrier(xb);
                   finalize_sample(p, rs_ffn, OFF_GPART, 4, l == 0 ? INP(p, 1) : nullptr); } break;
        case 12: { GEMM_PRO; EpiBf<1> E; E.O = (bf16_t*)(ws + OFF_A); E.ldc = 4096; E.rowss = rs_ffn; run_gemm(lds, XB, (const bf16_t*)(ws + OFF_WUP), 4096, 1024, E);
                   if (l == 0) { const int b = bidx(); phase_convert_early(p, 1, lds, b >= 64 ? b - 64 : -1, (int)gridDim.x - 64); } } break;
        default: { GEMM_PRO; EpiResid E; E.X = p.out; E.XB = XB; E.rowss_out = rs_next; E.Xp0 = nullptr; E.Xs0 = nullptr; run_ffn_down(lds, (const bf16_t*)(ws + OFF_A), (const bf16_t*)(ws + OFF_WDN), E, (float*)(ws + OFF_PART)); } break;
        }
        xcd_barrier(xb);
    }
    phase_final(p);
}

extern "C" void kernel_launch(void* const* d_in, const int* in_sizes, int n_in, void* d_out, int out_size, void* d_ws, size_t ws_size, hipStream_t stream) {
    constexpr int LDS_BYTES = 131072 + 64;
    static int grid_blocks = 0;
    if (grid_blocks == 0) {
        int dev = 0, cus = 0, per_cu = 0;
        hipGetDevice(&dev);
        hipDeviceGetAttribute(&cus, hipDeviceAttributeMultiprocessorCount, dev);
        hipFuncSetAttribute((const void*)mega_fwd, hipFuncAttributeMaxDynamicSharedMemorySize, LDS_BYTES);
        hipOccupancyMaxActiveBlocksPerMultiprocessor(&per_cu, (const void*)mega_fwd, 512, LDS_BYTES);
        if (per_cu < 1) per_cu = 1;
        grid_blocks = cus;
        if (n_in != 30 || ws_size < WS_NEED) { fprintf(stderr, "kernel_launch: unexpected n_in %d / ws_size %zu\n", n_in, ws_size); }
    }
    if (hipMemsetAsync((unsigned char*)d_ws + OFF_SM + SM_BAR, 0, XCD_BAR_WORDS * 4, stream) != hipSuccess) fprintf(stderr, "memset failed\n");
    Params p{};
    for (int i = 0; i < 30; ++i) p.in[i] = (const float*)d_in[i];
    p.out = (float*)d_out; p.ws = (unsigned char*)d_ws;
    void* args[] = {&p};
    hipError_t e = hipLaunchCooperativeKernel((const void*)mega_fwd, dim3(grid_blocks), dim3(512), args, LDS_BYTES, stream);
    if (e != hipSuccess) fprintf(stderr, "cooperative launch failed: %s (grid %d)\n", hipGetErrorString(e), grid_blocks);
}
```
